# Optimizing an MI355X kernel written in HIP

```python
import math
import jax, jax.numpy as jnp
from jax import lax
import numpy as np

D_MODEL = 1024
BATCH = 16
SEQ = 256
DEPTH = 2
DEC_BATCH = 4
DEC_SEQ = 1024
PAST_LEN = 512

GRID_W = 64
Q_BLOCK = 128
ROPE_THETA = 10000.0
EPS = 1e-6
RWKV_GN_EPS = 64e-5
HA = 4
DH_A = 64
DV_A = 2 * DH_A
HB = 8
HKV_B = 2
DH_B = 64
HC = 4
DK_C = 128
DV_C = 128
HGRN_CHUNK = 32
HD = 8
DH_D = 64
W_LORA = 64
A_LORA = 64
G_LORA = 128
D_FF = 2816

N_EVEN = (DEPTH + 1) // 2
N_ODD = DEPTH // 2
D_A = HA * DV_A
D_B = HB * DH_B
D_C = HC * DV_C
D_D = HD * DH_D
EVEN_SIZES = (HA * 2 * DH_A, HA * 2 * DH_A, HA * DV_A, HB * DH_B, HKV_B * DH_B, HKV_B * DH_B)
EVEN_PROJ = sum(EVEN_SIZES)
HGRN_SIZES = (HC * DK_C, HC * DK_C, HC * DK_C, HC * DV_C, D_C)
HGRN_PROJ = sum(HGRN_SIZES)
RWKV_SIZES = (D_D, D_D, D_D, 2 * W_LORA, A_LORA, G_LORA)
RWKV_PROJ = sum(RWKV_SIZES)
ODD_PROJ = HGRN_PROJ + RWKV_PROJ
F32 = jnp.float32

kernel_name = 'hybrid_diffusion_prefix_trunk_step'


def split_last(x, sizes):
    outs, start = [], 0
    for n in sizes:
        outs.append(x[..., start:start + n])
        start += n
    return outs


def rms_norm(x, g):
    xf = x.astype(F32)
    y = xf * lax.rsqrt(jnp.mean(xf * xf, axis=-1, keepdims=True) + EPS)
    return (y * g.astype(F32)).astype(x.dtype)


def centred_conv3(x, w, b):
    xp = jnp.pad(x, ((0, 0), (1, 1), (0, 0)))
    return w[0] * xp[:, :-2] + w[1] * xp[:, 1:-1] + w[2] * xp[:, 2:] + b


def token_shift_mix(x, mu):
    xp = jnp.pad(x, ((0, 0), (1, 1), (0, 0)))
    return x + mu * (0.5 * (xp[:, :-2] + xp[:, 2:]) - x)


def grid_positions(rows):
    r = jnp.broadcast_to(jnp.arange(rows, dtype=jnp.int32)[:, None], (rows, GRID_W)).reshape(-1)
    c = jnp.broadcast_to(jnp.arange(GRID_W, dtype=jnp.int32)[None, :], (rows, GRID_W)).reshape(-1)
    return r, c


def rope_axis(x, pos):
    half = x.shape[-1] // 2
    freq = jnp.power(ROPE_THETA, -jnp.arange(half, dtype=F32) / half)
    ang = pos.astype(F32)[:, None] * freq[None, :]
    cos, sin = jnp.cos(ang)[:, None, :], jnp.sin(ang)[:, None, :]
    xf = x.astype(F32)
    x1, x2 = xf[..., :half], xf[..., half:]
    return jnp.concatenate([x1 * cos - x2 * sin, x1 * sin + x2 * cos], axis=-1).astype(x.dtype)


def rope_2d(x, rows, cols):
    d = x.shape[-1]
    return jnp.concatenate([rope_axis(x[..., :d // 2], rows), rope_axis(x[..., d // 2:], cols)], axis=-1)


def block_attend(q, k, v):
    b, g, r, s, d = q.shape
    nb = s // Q_BLOCK
    scale = d ** -0.5
    qb = jnp.moveaxis(q.reshape(b, g, r, nb, Q_BLOCK, d), 3, 0)

    def one_block(qi):
        sc = jnp.einsum('bgrqd,bgtd->bgrqt', qi, k).astype(F32) * scale
        p = jax.nn.softmax(sc, axis=-1).astype(v.dtype)
        return jnp.einsum('bgrqt,bgte->bgrqe', p, v)

    out = lax.map(one_block, qb)
    return jnp.moveaxis(out, 0, 3).reshape(b, g, r, s, v.shape[-1])


def even_mixer(h, P, i, lidx, pos, ctx):
    bsz, s, _ = h.shape
    qa, ka, va, qb, kb, vb = split_last(h @ P['ev_w_in'][i], EVEN_SIZES)
    qa = qa.reshape(bsz, s, 2 * HA, DH_A)
    ka = ka.reshape(bsz, s, 2 * HA, DH_A)
    qb = rms_norm(qb.reshape(bsz, s, HB, DH_B), P['b_q_norm_g'][i])
    kb = rms_norm(kb.reshape(bsz, s, HKV_B, DH_B), P['b_k_norm_g'][i])
    if pos is not None:
        qa, ka, qb, kb = [rope_2d(t, pos[0], pos[1]) for t in (qa, ka, qb, kb)]

    def heads_first(t):
        return jnp.transpose(t, (0, 2, 1, 3))

    own = (heads_first(ka.reshape(bsz, s, HA, 2 * DH_A)),
           heads_first(va.reshape(bsz, s, HA, DV_A)),
           heads_first(kb),
           heads_first(vb.reshape(bsz, s, HKV_B, DH_B)))
    if ctx is None:
        k_a, v_a, k_b, v_b = own
    else:
        k_a, v_a, k_b, v_b = [jnp.concatenate([cx, ow], axis=2) for cx, ow in zip(ctx, own)]

    qa = heads_first(qa.reshape(bsz, s, HA, 2 * DH_A))
    a1 = block_attend(qa[:, :, None, :, :DH_A], k_a[..., :DH_A], v_a)[:, :, 0]
    a2 = block_attend(qa[:, :, None, :, DH_A:], k_a[..., DH_A:], v_a)[:, :, 0]
    lam_init = 0.8 - 0.6 * math.exp(-0.3 * lidx)
    lq1, lk1, lq2, lk2 = P['a_lambda'][i].astype(F32)
    lam = jnp.exp(jnp.sum(lq1 * lk1)) - jnp.exp(jnp.sum(lq2 * lk2)) + lam_init
    oa = rms_norm(a1.astype(F32) - lam * a2.astype(F32), P['a_subln_g'][i]) * (1.0 - lam_init)
    oa = jnp.transpose(oa, (0, 2, 1, 3)).reshape(bsz, s, D_A).astype(h.dtype)

    qg = heads_first(qb).reshape(bsz, HKV_B, HB // HKV_B, s, DH_B)
    ob = block_attend(qg, k_b, v_b).reshape(bsz, HB, s, DH_B)
    ob = jnp.transpose(ob, (0, 2, 1, 3)).reshape(bsz, s, D_B)
    return jnp.concatenate([oa, ob], axis=-1) @ P['ev_w_out'][i], own


def hgrn_chunk_scan(q, k, logf, v, s0):
    b, s, h, dk = q.shape
    dv = v.shape[-1]
    nc, L = s // HGRN_CHUNK, HGRN_CHUNK

    def chunks(t):
        return jnp.moveaxis(t.reshape(b, nc, L, h, t.shape[-1]), 1, 0)

    causal = jnp.tril(jnp.ones((L, L), dtype=bool))[None, :, :, None, None]

    def step(state, inp):
        qc, kc, lfc, vc = inp
        cum = jnp.cumsum(lfc, axis=1)
        o_inter = jnp.einsum('bthk,bhkv->bthv', qc * jnp.exp(cum), state)
        diff = jnp.where(causal, cum[:, :, None] - cum[:, None, :], -jnp.inf)
        scores = jnp.einsum('bthk,bshk,btshk->bths', qc, kc, jnp.exp(diff))
        o_intra = jnp.einsum('bths,bshv->bthv', scores, vc)
        dec_end = jnp.exp(cum[:, -1:] - cum)
        state = state * jnp.exp(cum[:, -1])[..., None] + jnp.einsum('bshk,bshv->bhkv', kc * dec_end, vc)
        return state, o_inter + o_intra

    s_fin, o = lax.scan(step, s0, (chunks(q), chunks(k), chunks(logf), chunks(v)))
    return jnp.moveaxis(o, 0, 1).reshape(b, s, h, dv), s_fin


def hgrn_direction(q, f_logit, lb, v, s0, reverse):
    if reverse:
        q, f_logit, v = [jnp.flip(t, axis=1) for t in (q, f_logit, v)]
    f = lb + (1.0 - lb) * jax.nn.sigmoid(f_logit.astype(F32))
    o, s_fin = hgrn_chunk_scan(q.astype(F32), 1.0 - f, jnp.log(f), v.astype(F32), s0)
    if reverse:
        o = jnp.flip(o, axis=1)
    return o, s_fin


def rwkv_direction(r, w, kk, a, v, kt, s0, reverse):
    def step(state, inp):
        r_t, w_t, kk_t, a_t, v_t, k_t = inp
        sa = jnp.einsum('bhvk,bhk->bhv', state, -kk_t)
        state = (state * w_t[:, :, None, :] + sa[..., None] * (kk_t * a_t)[:, :, None, :]
                 + v_t[..., None] * k_t[:, :, None, :])
        return state, jnp.einsum('bhvk,bhk->bhv', state, r_t)

    xs = tuple(jnp.moveaxis(t.astype(F32), 1, 0) for t in (r, w, kk, a, v, kt))
    s_fin, o = lax.scan(step, s0, xs, reverse=reverse)
    return jnp.moveaxis(o, 0, 1), s_fin


def odd_mixer(h, P, i, lidx, ctx):
    bsz, s, _ = h.shape
    proj = h @ P['od_w_in'][i]
    if ctx is None:
        s_hgrn0 = jnp.zeros((bsz, 2, HC, DK_C, DV_C), F32)
        s_rwkv0 = jnp.zeros((bsz, 2, HD, DH_D, DH_D), F32)
    else:
        s_hgrn0, s_rwkv0 = ctx[0].astype(F32), ctx[1].astype(F32)

    def heads(t, nh):
        return t.reshape(bsz, s, nh, -1)

    q, f_fw, f_bw, v_c, g_c = split_last(proj[..., :HGRN_PROJ], HGRN_SIZES)
    lb_sm = jax.nn.softmax(P['hgrn_lb_logits'].astype(F32), axis=1)
    lb = (jnp.cumsum(lb_sm, axis=1)[:, lidx] - lb_sm[:, 0]).reshape(2, HC, DK_C)
    qh, vh = heads(jax.nn.silu(q), HC), heads(v_c, HC)
    oc_f, sc_f = hgrn_direction(qh, heads(f_fw, HC), lb[0], vh, s_hgrn0[:, 0], False)
    oc_b, sc_b = hgrn_direction(qh, heads(f_bw, HC), lb[1], vh, s_hgrn0[:, 1], True)
    o_c = rms_norm(oc_f + oc_b, P['hgrn_norm_g'][i]).reshape(bsz, s, D_C) * jax.nn.silu(g_c.astype(F32))

    pd = token_shift_mix(proj[..., HGRN_PROJ:], P['rwkv_mu'][i])
    r, k, v, wd, ad, gd = [t.astype(F32) for t in split_last(pd, RWKV_SIZES)]
    a = jax.nn.sigmoid(P['rwkv_a0'][i] + ad @ P['rwkv_a_up'][i])
    g = jax.nn.sigmoid(gd) @ P['rwkv_g_up'][i]
    kk = heads(k * P['rwkv_k_k'][i], HD)
    kk = kk / jnp.maximum(jnp.sqrt(jnp.sum(kk * kk, axis=-1, keepdims=True)), 1e-12)
    kt = heads(k * (1.0 + (a - 1.0) * P['rwkv_k_a'][i]), HD)
    rh, vh_d, ah = heads(r, HD), heads(v, HD), heads(a, HD)
    o_dirs, s_dirs = [], []
    for dr in range(2):
        z = P['rwkv_w0'][i, dr] + jnp.tanh(wd[..., dr * W_LORA:(dr + 1) * W_LORA]) @ P['rwkv_w_up'][i, dr]
        w = jnp.exp(-jnp.exp(-jax.nn.softplus(-z) - 0.5))
        o_dr, s_dr = rwkv_direction(rh, heads(w, HD), kk, ah, vh_d, kt, s_rwkv0[:, dr], dr == 1)
        o_dirs.append(o_dr)
        s_dirs.append(s_dr)
    o = o_dirs[0] + o_dirs[1]
    mu = jnp.mean(o, axis=-1, keepdims=True)
    var = jnp.mean(jnp.square(o - mu), axis=-1, keepdims=True)
    o = ((o - mu) * lax.rsqrt(var + RWKV_GN_EPS) * P['rwkv_ln_g'][i].reshape(HD, DH_D)
         + P['rwkv_ln_b'][i].reshape(HD, DH_D))
    o = o + jnp.sum(rh * kt * P['rwkv_r_k'][i].reshape(HD, DH_D), axis=-1, keepdims=True) * vh_d
    o_d = o.reshape(bsz, s, D_D) * g
    out = jnp.concatenate([o_c, o_d], axis=-1).astype(h.dtype) @ P['od_w_out'][i]
    return out, (jnp.stack([sc_f, sc_b], axis=1), jnp.stack(s_dirs, axis=1))


def conv_ffn(h, P, l):
    u = centred_conv3(h @ P['ffn_w_up'][l], P['ffn_conv_w'][l], P['ffn_conv_b'][l])
    val, gate = jnp.split(u, 2, axis=-1)
    return (jax.nn.silu(gate) * val) @ P['ffn_w_down'][l]


def run_trunk(x, cond, pos, ctx_in, P):
    collect = ([], [], [], [], [], [])
    for l in range(DEPTH):
        i = l // 2
        mod = jax.nn.silu(cond) @ P['ada_w'][l] + P['ada_b'][l]
        sh1, sc1, g1, sh2, sc2, g2 = jnp.split(mod[:, None, :], 6, axis=-1)
        h = rms_norm(x, P['norm_mix_g'][l]) * (1.0 + sc1) + sh1
        if l % 2 == 0:
            ctx = None if ctx_in is None else tuple(t[:, i] for t in ctx_in[:4])
            mix, own = even_mixer(h, P, i, l, pos, ctx)
            if ctx_in is None:
                for j in range(4):
                    collect[j].append(own[j])
        else:
            ctx = None if ctx_in is None else tuple(t[:, i] for t in ctx_in[4:])
            mix, fin = odd_mixer(h, P, i, l, ctx)
            if ctx_in is None:
                collect[4].append(fin[0].astype(x.dtype))
                collect[5].append(fin[1].astype(x.dtype))
        x = x + g1 * mix
        h = rms_norm(x, P['norm_ffn_g'][l]) * (1.0 + sc2) + sh2
        x = x + g2 * conv_ffn(h, P, l)
    y = rms_norm(x, P['final_norm_g'])
    new_ctx = None if ctx_in is not None else tuple(jnp.stack(cl, axis=1) for cl in collect)
    return y, new_ctx


def setup_inputs(seed: int = 0) -> dict:
    key = jax.random.key(seed)
    ks = iter(jax.random.split(key, 64))

    def nrm(shape, scale):
        return scale * jax.random.normal(next(ks), shape, F32)

    def gain(shape):
        return 1.0 + 0.05 * jax.random.normal(next(ks), shape, F32)

    d = D_MODEL
    return {
        'x_prompt': nrm((BATCH, SEQ, d), 1.0),
        'x_sample': nrm((DEC_BATCH, DEC_SEQ, d), 1.0),
        'cache_a_k': nrm((DEC_BATCH, N_EVEN, HA, PAST_LEN, 2 * DH_A), 1.0),
        'cache_a_v': nrm((DEC_BATCH, N_EVEN, HA, PAST_LEN, DV_A), 1.0),
        'cache_b_k': nrm((DEC_BATCH, N_EVEN, HKV_B, PAST_LEN, DH_B), 1.0),
        'cache_b_v': nrm((DEC_BATCH, N_EVEN, HKV_B, PAST_LEN, DH_B), 1.0),
        'state_hgrn': nrm((DEC_BATCH, N_ODD, 2, HC, DK_C, DV_C), 0.5),
        'state_rwkv': nrm((DEC_BATCH, N_ODD, 2, HD, DH_D, DH_D), 0.3),
        'c': nrm((DEC_BATCH, d), 1.0),
        'c_ctx': nrm((d,), 1.0),
        'ada_w': nrm((DEPTH, d, 6 * d), 0.3 * d ** -0.5),
        'ada_b': nrm((DEPTH, 6 * d), 0.02),
        'norm_mix_g': gain((DEPTH, d)),
        'norm_ffn_g': gain((DEPTH, d)),
        'final_norm_g': gain((d,)),
        'ev_w_in': nrm((N_EVEN, d, EVEN_PROJ), d ** -0.5),
        'ev_w_out': nrm((N_EVEN, D_A + D_B, d), (D_A + D_B) ** -0.5),
        'a_lambda': nrm((N_EVEN, 4, DH_A), 0.1),
        'a_subln_g': gain((N_EVEN, DV_A)),
        'b_q_norm_g': gain((N_EVEN, DH_B)),
        'b_k_norm_g': gain((N_EVEN, DH_B)),
        'od_w_in': nrm((N_ODD, d, ODD_PROJ), d ** -0.5),
        'od_w_out': nrm((N_ODD, D_C + D_D, d), (D_C + D_D) ** -0.5),
        'hgrn_lb_logits': nrm((2, DEPTH, HC * DK_C), 0.5),
        'hgrn_norm_g': gain((N_ODD, DV_C)),
        'rwkv_mu': jax.random.uniform(next(ks), (N_ODD, RWKV_PROJ), F32),
        'rwkv_w0': nrm((N_ODD, 2, D_D), 0.5),
        'rwkv_w_up': nrm((N_ODD, 2, W_LORA, D_D), 0.1),
        'rwkv_a0': nrm((N_ODD, D_D), 0.3),
        'rwkv_a_up': nrm((N_ODD, A_LORA, D_D), 0.1),
        'rwkv_g_up': nrm((N_ODD, G_LORA, D_D), G_LORA ** -0.5),
        'rwkv_k_k': 0.85 + nrm((N_ODD, D_D), 0.1),
        'rwkv_k_a': gain((N_ODD, D_D)),
        'rwkv_r_k': nrm((N_ODD, D_D), 0.1),
        'rwkv_ln_g': gain((N_ODD, D_D)),
        'rwkv_ln_b': nrm((N_ODD, D_D), 0.02),
        'ffn_w_up': nrm((DEPTH, d, 2 * D_FF), d ** -0.5),
        'ffn_conv_w': nrm((DEPTH, 3, 2 * D_FF), 0.2) + jnp.array([0.0, 1.0, 0.0], F32)[None, :, None],
        'ffn_conv_b': nrm((DEPTH, 2 * D_FF), 0.02),
        'ffn_w_down': nrm((DEPTH, D_FF, d), D_FF ** -0.5),
    }


def reference(x_prompt, x_sample, cache_a_k, cache_a_v, cache_b_k, cache_b_v, state_hgrn, state_rwkv,
              c, c_ctx, ada_w, ada_b, norm_mix_g, norm_ffn_g, final_norm_g,
              ev_w_in, ev_w_out, a_lambda, a_subln_g, b_q_norm_g, b_k_norm_g,
              od_w_in, od_w_out, hgrn_lb_logits, hgrn_norm_g,
              rwkv_mu, rwkv_w0, rwkv_w_up, rwkv_a0, rwkv_a_up, rwkv_g_up,
              rwkv_k_k, rwkv_k_a, rwkv_r_k, rwkv_ln_g, rwkv_ln_b,
              ffn_w_up, ffn_conv_w, ffn_conv_b, ffn_w_down):
    P = {
        'ada_w': ada_w, 'ada_b': ada_b, 'norm_mix_g': norm_mix_g, 'norm_ffn_g': norm_ffn_g,
        'final_norm_g': final_norm_g, 'ev_w_in': ev_w_in, 'ev_w_out': ev_w_out,
        'a_lambda': a_lambda, 'a_subln_g': a_subln_g, 'b_q_norm_g': b_q_norm_g, 'b_k_norm_g': b_k_norm_g,
        'od_w_in': od_w_in, 'od_w_out': od_w_out, 'hgrn_lb_logits': hgrn_lb_logits,
        'hgrn_norm_g': hgrn_norm_g, 'rwkv_mu': rwkv_mu, 'rwkv_w0': rwkv_w0, 'rwkv_w_up': rwkv_w_up,
        'rwkv_a0': rwkv_a0, 'rwkv_a_up': rwkv_a_up, 'rwkv_g_up': rwkv_g_up, 'rwkv_k_k': rwkv_k_k,
        'rwkv_k_a': rwkv_k_a, 'rwkv_r_k': rwkv_r_k, 'rwkv_ln_g': rwkv_ln_g, 'rwkv_ln_b': rwkv_ln_b,
        'ffn_w_up': ffn_w_up, 'ffn_conv_w': ffn_conv_w, 'ffn_conv_b': ffn_conv_b, 'ffn_w_down': ffn_w_down,
    }
    y_prompt, new_ctx = run_trunk(x_prompt, c_ctx[None, :], None, None, P)
    new_cache_a_k, new_cache_a_v, new_cache_b_k, new_cache_b_v, new_state_hgrn, new_state_rwkv = new_ctx
    ROWS = x_sample.shape[1] // GRID_W
    pos = grid_positions(ROWS)
    ctx_cached = (cache_a_k, cache_a_v, cache_b_k, cache_b_v, state_hgrn, state_rwkv)
    y_sample, _ = run_trunk(x_sample, c, pos, ctx_cached, P)
    return (y_prompt, y_sample, new_cache_a_k, new_cache_a_v, new_cache_b_k, new_cache_b_v, new_state_hgrn, new_state_rwkv)
```

```cpp
#include <hip/hip_runtime.h>
#include <hip/hip_cooperative_groups.h>
#include <cstdio>
#include <cstdint>
namespace cg = cooperative_groups;
#ifndef MK_N_LAUNCHES
#define MK_N_LAUNCHES 22
#endif
namespace pg8 {
#define PG8_LAS __attribute__((address_space(3)))
typedef unsigned short bf16_t;
typedef short bf16x8 __attribute__((ext_vector_type(8)));
typedef float f32x4 __attribute__((ext_vector_type(4)));
typedef unsigned u32x4 __attribute__((ext_vector_type(4)));
constexpr int BM = 256, BK = 64, HALF = 128, HTB = HALF * BK * 2  , STAGE_BYTES = 8 * HTB, NXCD = 8, WGM = 8;

__host__ __device__ __forceinline__ int lds_byte(int r, int c) { const int st = (r >> 4) * 2 + (c >> 5), rr = r & 15, cc = c & 31, ob = rr * 64 + cc * 2; return st * 1024 + (ob ^ (((ob >> 9) & 1) << 5)); }
__host__ __device__ __forceinline__ void stage_rc(int b, int& R, int& C) { const int st = b / 1024, sb = b % 1024, swz = sb ^ (((sb >> 9) & 1) << 5); R = (st >> 1) * 16 + swz / 64; C = (st & 1) * 32 + (swz % 64) / 2; }
__host__ __device__ __forceinline__ int perm32(int rho) { const int n = rho >> 4, i = rho & 15; return 8 * (i >> 2) + 4 * n + (i & 3); }

struct Unit { int pm, pn; };
struct Gemm { const bf16_t* A; const bf16_t* Bt; int M, N, K, ld, nNr; };

struct StaticOrder {
    int nM, nN, nwg, G, c;
    __host__ __device__ void init(int M, int N, int G_, int c_) { nM = M / BM; nN = N / BM; nwg = nM * nN; G = G_; c = c_; }
    __host__ __device__ bool next(int i, Unit& u) const {
        const long L = (long)i * G + c; if (L >= nwg) return false;
        int wgid = (int)L; { const int q = nwg / NXCD, r = nwg % NXCD, xcd = wgid % NXCD, off = wgid / NXCD; wgid = (xcd < r ? xcd * (q + 1) : r * (q + 1) + (xcd - r) * q) + off; }
        const int nig = WGM * nN, gid = wgid / nig, fm = gid * WGM, gsz = (nM - fm) < WGM ? (nM - fm) : WGM;
        u.pm = fm + ((wgid % nig) % gsz); u.pn = (wgid % nig) / gsz; return true;
    }
    __device__ __forceinline__ void a_ready(const Unit&) const {}
    __device__ __forceinline__ void done(const Unit&) const {}
};

template <class Epi, class Sched, bool STAMP = false>
__device__ __forceinline__ void gemm_phase(PG8_LAS unsigned char* lds, const Gemm g, const Sched& S, const Epi& E, unsigned long long* stamps) {
    const int tid = threadIdx.x, wid = __builtin_amdgcn_readfirstlane(tid >> 6), lane = tid & 63, wr = wid >> 2, wc = wid & 3, fr = lane & 15, fq = lane >> 4;
    const int K = g.K, nt = K / BK;
    int ts_lo = 0, ts_hi = 0, nts = 0; const unsigned long long rt_entry = 0ull;
#define PG8_STAMP() do { if (STAMP && wid == 0 && nts < 64) { const unsigned long long _c = (unsigned long long)clock64(); \
        ts_lo = (lane == nts) ? (int)(unsigned)_c : ts_lo; ts_hi = (lane == nts) ? (int)(unsigned)(_c >> 32) : ts_hi; ++nts; } } while (0)
    PG8_STAMP();
    unsigned voffA[2], voffB[2];
#pragma unroll
    for (int i = 0; i < 2; ++i) { int R, C; stage_rc(tid * 16 + i * 8192, R, C); const int Rb = Epi::PERM ? ((R & ~31) + perm32(R & 31)) : R;
        voffA[i] = (unsigned)(R * g.ld + C) * 2u; voffB[i] = (unsigned)(Rb * g.ld + C) * 2u; }
    const size_t kstep = (size_t)(BK * 2);
    const size_t hstep = (size_t)HALF * g.ld * 2;
    const size_t tstep = 2 * hstep;
    const unsigned ldsw = (unsigned)wid * 1024u;
    const int aoff = lds_byte(wr * 64 + fr, fq * 8), boff = lds_byte(wc * 32 + fr, fq * 8);
#define PG8_SA(b, h) (((b) * 2 + (h)) * HTB)
#define PG8_SB(b, h) ((4 + (b) * 2 + (h)) * HTB)
#define PG8_STAGE(bufoff, gbase, voff) do { _Pragma("unroll") for (int _i = 0; _i < 2; ++_i) \
        __builtin_amdgcn_global_load_lds((const unsigned*)((const char*)(gbase) + (voff)[_i]), (PG8_LAS unsigned*)(lds + (bufoff) + ldsw + _i * 8192), 16, 0, 0); } while (0)
#define PG8_LDA(dst, b, h) do { _Pragma("unroll") for (int m = 0; m < 4; ++m) _Pragma("unroll") for (int k = 0; k < 2; ++k) dst[m][k] = *(const PG8_LAS bf16x8*)(lds + PG8_SA(b, h) + aoff + m * 2048 + k * 1024); } while (0)
#define PG8_LDB(dst, b, h) do { _Pragma("unroll") for (int n = 0; n < 2; ++n) _Pragma("unroll") for (int k = 0; k < 2; ++k) dst[n][k] = *(const PG8_LAS bf16x8*)(lds + PG8_SB(b, h) + boff + n * 2048 + k * 1024); } while (0)
#define PG8_MMA(ai, bj, At, Bt) do { __builtin_amdgcn_s_setprio(1); _Pragma("unroll") for (int m = 0; m < 4; ++m) _Pragma("unroll") for (int n = 0; n < 2; ++n) _Pragma("unroll") for (int k = 0; k < 2; ++k) \
        acc[ai][bj][m][n] = __builtin_amdgcn_mfma_f32_16x16x32_bf16(Bt[n][k], At[m][k], acc[ai][bj][m][n], 0, 0, 0); __builtin_amdgcn_s_setprio(0); } while (0)
#define PG8_WAIT_V(n) asm volatile("s_waitcnt vmcnt(" #n ")" ::: "memory")
#define PG8_WAIT_L(n) asm volatile("s_waitcnt lgkmcnt(" #n ")" ::: "memory")
#define PG8_BAR __builtin_amdgcn_s_barrier()
#define PG8_SCHED __builtin_amdgcn_sched_barrier(0)
    Unit cur, nxt; int ui = 0;
    if (!S.next(0, cur)) return;
    f32x4 acc[2][2][4][2];
#pragma unroll
    for (int a = 0; a < 2; ++a)
#pragma unroll
        for (int b = 0; b < 2; ++b)
#pragma unroll
            for (int m = 0; m < 4; ++m)
#pragma unroll
                for (int n = 0; n < 2; ++n) acc[a][b][m][n] = (f32x4){0.f, 0.f, 0.f, 0.f};
    bf16x8 At[4][2], B0[2][2], B1[2][2];
    const char* cA = (const char*)g.A + (size_t)cur.pm * tstep + (size_t)(cur.pn / g.nNr) * K * 2; const char* cB = (const char*)g.Bt + (size_t)(cur.pn % g.nNr) * tstep + (size_t)(cur.pn / g.nNr) * K * 2;
    S.a_ready(cur);
    PG8_STAGE(PG8_SB(0, 0), cB, voffB); PG8_STAGE(PG8_SA(0, 0), cA, voffA); PG8_STAGE(PG8_SB(0, 1), cB + hstep, voffB); PG8_STAGE(PG8_SA(0, 1), cA + hstep, voffA);
    if (wr == 1) PG8_BAR;
    PG8_WAIT_V(4); PG8_BAR;
    PG8_STAGE(PG8_SB(1, 0), cB + kstep, voffB); PG8_STAGE(PG8_SA(1, 0), cA + kstep, voffA); PG8_STAGE(PG8_SB(1, 1), cB + hstep + kstep, voffB);
    PG8_WAIT_V(6); PG8_BAR;
    PG8_STAMP();
    for (;;) {
        const bool has_next = S.next(ui + 1, nxt);
        const char* nA = has_next ? (const char*)g.A + (size_t)nxt.pm * tstep + (size_t)(nxt.pn / g.nNr) * K * 2 : cA; const char* nB = has_next ? (const char*)g.Bt + (size_t)(nxt.pn % g.nNr) * tstep + (size_t)(nxt.pn / g.nNr) * K * 2 : cB;
        for (int t = 0; t < nt; t += 2) {
            const bool last = (t == nt - 2);
            const char* a1 = cA + (size_t)(t + 1) * kstep;
            const char* a2 = last ? nA : cA + (size_t)(t + 2) * kstep; const char* b2 = last ? nB : cB + (size_t)(t + 2) * kstep;
            const char* a3 = a2 + kstep; const char* b3 = b2 + kstep;
            if (last && has_next) S.a_ready(nxt);
            PG8_LDB(B0, 0, 0); PG8_SCHED; PG8_LDA(At, 0, 0); PG8_STAGE(PG8_SA(1, 1), a1 + hstep, voffA);
            PG8_WAIT_L(8); PG8_BAR; PG8_WAIT_L(0); PG8_MMA(0, 0, At, B0); PG8_BAR; PG8_SCHED;
            PG8_LDB(B1, 0, 1); PG8_STAGE(PG8_SB(0, 0), b2, voffB);
            PG8_BAR; PG8_WAIT_L(0); PG8_MMA(0, 1, At, B1); PG8_BAR;
            PG8_LDA(At, 0, 1); PG8_STAGE(PG8_SA(0, 0), a2, voffA);
            PG8_BAR; PG8_WAIT_L(0); PG8_MMA(1, 0, At, B0); PG8_BAR; PG8_SCHED;
            PG8_STAGE(PG8_SB(0, 1), b2 + hstep, voffB);
            PG8_WAIT_V(6); PG8_BAR; PG8_MMA(1, 1, At, B1); PG8_BAR;
            PG8_LDB(B0, 1, 0); PG8_SCHED; PG8_LDA(At, 1, 0); PG8_STAGE(PG8_SA(0, 1), a2 + hstep, voffA);
            PG8_WAIT_L(8); PG8_BAR; PG8_WAIT_L(0); PG8_MMA(0, 0, At, B0); PG8_BAR; PG8_SCHED;
            PG8_LDB(B1, 1, 1); PG8_STAGE(PG8_SB(1, 0), b3, voffB);
            PG8_BAR; PG8_WAIT_L(0); PG8_MMA(0, 1, At, B1); PG8_BAR;
            PG8_LDA(At, 1, 1); PG8_STAGE(PG8_SA(1, 0), a3, voffA);
            PG8_BAR; PG8_WAIT_L(0); PG8_MMA(1, 0, At, B0); PG8_BAR; PG8_SCHED;
            PG8_STAGE(PG8_SB(1, 1), b3 + hstep, voffB);
            PG8_WAIT_V(6); PG8_BAR; PG8_MMA(1, 1, At, B1); PG8_BAR;
        }
        PG8_STAMP();
        if constexpr (!Epi::AFTER_DRAIN) { E(acc, cur, wr, wc, fr, fq); S.done(cur); }
        PG8_STAMP();
        if (!has_next) break;
#pragma unroll
        for (int a = 0; a < 2; ++a)
#pragma unroll
            for (int b = 0; b < 2; ++b)
#pragma unroll
                for (int m = 0; m < 4; ++m)
#pragma unroll
                    for (int n = 0; n < 2; ++n) acc[a][b][m][n] = (f32x4){0.f, 0.f, 0.f, 0.f};
        cur = nxt; cA = nA; cB = nB; ++ui;
    }
    PG8_WAIT_V(0);
    if (wr == 0) PG8_BAR;
    PG8_BAR;
    if constexpr (Epi::AFTER_DRAIN) { E.fused(acc, cur, wr, wc, fr, fq, lds, wid, lane); S.done(cur); }
    PG8_STAMP();
    if (STAMP && wid == 0) { stamps[lane] = lane < nts ? (((unsigned long long)(unsigned)ts_hi << 32) | (unsigned)ts_lo) : 0ull;
        if (lane == 62) stamps[62] = rt_entry; }
#undef PG8_STAMP
#undef PG8_SA
#undef PG8_SB
#undef PG8_STAGE
#undef PG8_LDA
#undef PG8_LDB
#undef PG8_MMA
#undef PG8_WAIT_V
#undef PG8_WAIT_L
#undef PG8_BAR
#undef PG8_SCHED
}
}

using pg8::f32x4; using pg8::bf16x8;
typedef unsigned short bf16;
typedef unsigned u32x4 __attribute__((ext_vector_type(4)));
typedef unsigned u32x2 __attribute__((ext_vector_type(2)));
typedef float f32x2 __attribute__((ext_vector_type(2)));

constexpr size_t MiB = 1ull << 20;
constexpr int NTOK = 8192, NCTX = 4096, DM = 1024, DFF = 2816;
constexpr size_t WS_MOD = 0, WS_LAM = 256 * 1024, WS_LB = 256 * 1024 + 256, WS_QCTR = 256 * 1024 + 8192;
constexpr size_t WS_ODIN = 1 * MiB, WS_ODOUT = 10 * MiB, WS_UP1 = 12 * MiB, WS_DOWN1 = 23 * MiB, WS_LORA = 28 * MiB + 512 * 1024;
constexpr size_t WS_EVIN = 30 * MiB, WS_EVOUT = 34 * MiB + 512 * 1024, WS_UP0 = 36 * MiB + 512 * 1024, WS_DOWN0 = 47 * MiB + 512 * 1024;
constexpr size_t WS_H = 53 * MiB;
constexpr size_t WS_PROJ = 69 * MiB, WS_QA = 141 * MiB, WS_QB = 149 * MiB, WS_KAC = 157 * MiB, WS_VATC = 161 * MiB, WS_KBC = 165 * MiB, WS_VBTC = 166 * MiB,
                 WS_KAS = 167 * MiB, WS_VATS = 173 * MiB, WS_KBS = 179 * MiB, WS_VBTS = 180 * MiB + 512 * 1024, WS_CAT = 182 * MiB;
constexpr size_t WS_U = 69 * MiB, WS_ACT = 157 * MiB;
constexpr size_t WS_KK = 53 * MiB, WS_KKA = 61 * MiB, WS_HG = 69 * MiB, WS_PR = 149 * MiB, WS_K1 = 178 * MiB,
                 WS_OCF = 149 * MiB, WS_OCB = 157 * MiB, WS_ODF = 165 * MiB, WS_ODB = 173 * MiB,
                 WS_KT = 186 * MiB, WS_WF = 194 * MiB, WS_WB = 210 * MiB, WS_G = 226 * MiB, WS_CAT2 = 234 * MiB,
                 WS_R = 30 * MiB, WS_V1 = 38 * MiB, WS_AP = 46 * MiB;
constexpr size_t O_AK = 8388608, O_AV = 10485760, O_BK = 12582912, O_BV = 13107200, O_SH = 13631488, O_SR = 15728640;

struct Args { const float* in[40]; float* out; unsigned char* ws; int ph_lo, ph_hi; };

typedef __bf16 bf16x2_t __attribute__((ext_vector_type(2)));
__device__ __forceinline__ unsigned pk2(float lo, float hi) { f32x2 v = {lo, hi}; bf16x2_t r = __builtin_convertvector(v, bf16x2_t); return __builtin_bit_cast(unsigned, r); }
__device__ __forceinline__ float bflo(unsigned w) { return __uint_as_float(w << 16); }
__device__ __forceinline__ float bfhi(unsigned w) { return __uint_as_float(w & 0xffff0000u); }
__device__ __forceinline__ float bf2f(bf16 b) { return __uint_as_float(((unsigned)b) << 16); }
__device__ __forceinline__ bf16 f2bf(float f) { return (bf16)(pk2(f, 0.f) & 0xffffu); }
__device__ __forceinline__ float sigm(float x) { return 1.f / (1.f + __expf(-x)); }
__device__ __forceinline__ float silu(float x) { return x / (1.f + __expf(-x)); }
__device__ __forceinline__ float wave_sum(float v) {
#pragma unroll
    for (int o = 1; o < 64; o <<= 1) v += __shfl_xor(v, o);
    return v;
}
__device__ __forceinline__ int cond_of(int t) { return t < NCTX ? 0 : 1 + ((t - NCTX) >> 10); }
__device__ __forceinline__ int opq(int x) { asm volatile("" : "+v"(x)); return x; }
#define LDSWAIT() asm volatile("s_waitcnt lgkmcnt(0)" ::: "memory")

__device__ __forceinline__ void tr_item(const float* W, int ldw, bf16* WT, int ldo, float* scr, int lane) {
#pragma unroll 8
    for (int i = 0; i < 32; ++i) { const int kk = 2 * i + (lane >> 5); scr[kk * 33 + (lane & 31)] = W[(size_t)kk * ldw + (lane & 31)]; }
    LDSWAIT();
    const int c = lane & 7;
#pragma unroll
    for (int j = 0; j < 4; ++j) { const int n = (lane >> 3) + 8 * j; const float* s = scr + (8 * c) * 33 + n;
        u32x4 o; o.x = pk2(s[0 * 33], s[1 * 33]); o.y = pk2(s[2 * 33], s[3 * 33]); o.z = pk2(s[4 * 33], s[5 * 33]); o.w = pk2(s[6 * 33], s[7 * 33]);
        *(u32x4*)(WT + (size_t)n * ldo + 8 * c) = o; }
    LDSWAIT();
}
__device__ __forceinline__ void tr_mat(const float* W, int N, bf16* WT, int ldo, int r, float* scr, int lane) {
    const int nblk = N / 32, kb = r / nblk, nb = r % nblk;
    tr_item(W + (size_t)kb * 64 * N + nb * 32, N, WT + (size_t)nb * 32 * ldo + kb * 64, ldo, scr, lane);
}

__device__ __forceinline__ void phase0(const Args& a, unsigned char* lds) {
    const int tid = opq((int)threadIdx.x), lane = tid & 63, wave = tid >> 6;
    const int gw = blockIdx.x * 8 + wave, NGW = gridDim.x * 8, gt = blockIdx.x * 512 + tid, NGT = gridDim.x * 512;
    unsigned char* ws = a.ws;
    {
        float* cs = (float*)lds;
        float* red = cs + 5120;
        float* MOD = (float*)(ws + WS_MOD);
        if (blockIdx.x < 384) {
            for (int i = tid; i < 5120; i += 512) { const int cb = i >> 10, k = i & 1023; const float x = cb == 0 ? a.in[9][k] : a.in[8][(cb - 1) * 1024 + k]; cs[i] = silu(x); }
        }
        __syncthreads();
        for (int it = blockIdx.x; it < 384; it += gridDim.x) {
            const int l = it / 192, cgp = it % 192, col = cgp * 32 + (lane & 31), kp = wave * 2 + (lane >> 5);
            const float* W = a.in[10] + (size_t)l * 1024 * 6144 + col;
            float acc0 = 0.f, acc1 = 0.f, acc2 = 0.f, acc3 = 0.f, acc4 = 0.f;
#pragma unroll 8
            for (int kk = 0; kk < 64; ++kk) { const int k = kp * 64 + kk; const float w = W[(size_t)k * 6144];
                acc0 += cs[k] * w; acc1 += cs[1024 + k] * w; acc2 += cs[2048 + k] * w; acc3 += cs[3072 + k] * w; acc4 += cs[4096 + k] * w; }
            red[(kp * 5 + 0) * 32 + (lane & 31)] = acc0; red[(kp * 5 + 1) * 32 + (lane & 31)] = acc1; red[(kp * 5 + 2) * 32 + (lane & 31)] = acc2;
            red[(kp * 5 + 3) * 32 + (lane & 31)] = acc3; red[(kp * 5 + 4) * 32 + (lane & 31)] = acc4;
            __syncthreads();
            if (tid < 160) { const int cb = tid >> 5, c = tid & 31; float s = 0.f;
#pragma unroll
                for (int p = 0; p < 16; ++p) s += red[(p * 5 + cb) * 32 + c];
                MOD[(size_t)(l * 5 + cb) * 6144 + cgp * 32 + c] = s + a.in[11][l * 6144 + cgp * 32 + c]; }
            __syncthreads();
        }
    }
    {
        float* scr = (float*)(lds + 32768 + wave * 8448);
        constexpr int I_EVIN = 16 * 72, I_EVOUT = 16 * 32, I_UP = 16 * 176, I_DOWN = 44 * 32, I_ODIN = 16 * 138, I_ODOUT = 16 * 32, I_CAV = 16 * 32, I_CBV = 8 * 16;
        constexpr int TOTAL = I_EVIN + I_EVOUT + 2 * I_UP + 2 * I_DOWN + I_ODIN + I_ODOUT + I_CAV + I_CBV;
        for (int it = gw; it < TOTAL; it += NGW) {
            int r = it;
            if (r < I_EVIN) { tr_mat(a.in[15], 2304, (bf16*)(ws + WS_EVIN), 1024, r, scr, lane); continue; } r -= I_EVIN;
            if (r < I_EVOUT) { tr_mat(a.in[16], 1024, (bf16*)(ws + WS_EVOUT), 1024, r, scr, lane); continue; } r -= I_EVOUT;
            if (r < I_UP) { tr_mat(a.in[36], 5632, (bf16*)(ws + WS_UP0), 1024, r, scr, lane); continue; } r -= I_UP;
            if (r < I_UP) { tr_mat(a.in[36] + (size_t)1024 * 5632, 5632, (bf16*)(ws + WS_UP1), 1024, r, scr, lane); continue; } r -= I_UP;
            if (r < I_DOWN) { tr_mat(a.in[39], 1024, (bf16*)(ws + WS_DOWN0), 2816, r, scr, lane); continue; } r -= I_DOWN;
            if (r < I_DOWN) { tr_mat(a.in[39] + (size_t)2816 * 1024, 1024, (bf16*)(ws + WS_DOWN1), 2816, r, scr, lane); continue; } r -= I_DOWN;
            if (r < I_ODIN) { tr_mat(a.in[21], 4416, (bf16*)(ws + WS_ODIN), 1024, r, scr, lane); continue; } r -= I_ODIN;
            if (r < I_ODOUT) { tr_mat(a.in[22], 1024, (bf16*)(ws + WS_ODOUT), 1024, r, scr, lane); continue; } r -= I_ODOUT;
            if (r < I_CAV) { const int bh = r / 32, rr = r % 32; tr_mat(a.in[3] + (size_t)bh * 512 * 128, 128, (bf16*)(ws + WS_VATS) + (size_t)bh * 128 * 1536, 1536, rr, scr, lane); continue; } r -= I_CAV;
            { const int bg = r / 16, rr = r % 16; tr_mat(a.in[5] + (size_t)bg * 512 * 64, 64, (bf16*)(ws + WS_VBTS) + (size_t)bg * 64 * 1536, 1536, rr, scr, lane); }
        }
    }
    {
        u32x4* z = (u32x4*)((bf16*)(ws + WS_ODIN) + (size_t)4416 * 1024);
        for (int i = gt; i < 192 * 1024 / 8; i += NGT) z[i] = (u32x4){0u, 0u, 0u, 0u};
    }
    {
        bf16* L = (bf16*)(ws + WS_LORA);
        for (int i = gt; i < 2048 * 384; i += NGT) { const int n = i / 384, k = i % 384; float v = 0.f;
            if (n < 512) { if (k < 64) v = a.in[27][(size_t)k * 512 + n]; }
            else if (n < 1024) { if (k >= 64 && k < 128) v = a.in[27][(size_t)(64 + (k - 64)) * 512 + (n - 512)]; }
            else if (n < 1536) { if (k >= 128 && k < 192) v = a.in[29][(size_t)(k - 128) * 512 + (n - 1024)]; }
            else { if (k >= 192 && k < 320) v = a.in[30][(size_t)(k - 192) * 512 + (n - 1536)]; }
            L[i] = f2bf(v); }
    }
    {
        const f32x4* s = (const f32x4*)a.in[2]; bf16* KA = (bf16*)(ws + WS_KAS);
        for (int i = gt; i < 4 * 4 * 512 * 128 / 4; i += NGT) { const int e0 = i * 4, bh = e0 >> 16, rem = e0 & 65535; const f32x4 v = s[i];
            u32x2 o; o.x = pk2(v.x, v.y); o.y = pk2(v.z, v.w); *(u32x2*)(KA + (size_t)bh * 1536 * 128 + rem) = o; }
        const f32x4* s2 = (const f32x4*)a.in[4]; bf16* KB = (bf16*)(ws + WS_KBS);
        for (int i = gt; i < 4 * 2 * 512 * 64 / 4; i += NGT) { const int e0 = i * 4, bg = e0 >> 15, rem = e0 & 32767; const f32x4 v = s2[i];
            u32x2 o; o.x = pk2(v.x, v.y); o.y = pk2(v.z, v.w); *(u32x2*)(KB + (size_t)bg * 1536 * 64 + rem) = o; }
    }
#if defined(RUN_UPTO) && RUN_UPTO < 14
    for (int i = gt; i < 3145728; i += NGT) a.out[O_SH + i] = 0.f;
#endif
    if (blockIdx.x == 0) {
        if (wave == 0) {
            const float* L = a.in[17];
            const float s1 = wave_sum(L[lane] * L[64 + lane]), s2 = wave_sum(L[128 + lane] * L[192 + lane]);
            if (lane == 0) { *(float*)(ws + WS_LAM) = __expf(s1) - __expf(s2) + 0.2f; ((unsigned*)(ws + WS_QCTR))[0] = 0u; }
        }
        float* LB = (float*)(ws + WS_LB);
        for (int i = tid; i < 1024; i += 512) { const int dr = i >> 9, c = i & 511; const float l0 = a.in[23][(dr * 2 + 0) * 512 + c], l1 = a.in[23][(dr * 2 + 1) * 512 + c];
            const float m = fmaxf(l0, l1), e0 = __expf(l0 - m), e1 = __expf(l1 - m), s0 = e0 / (e0 + e1), s1 = e1 / (e0 + e1); LB[i] = (s0 + s1) - s0; }
    }
}

template <int MODE>
__device__ __forceinline__ void norm_phase(const Args& a, const float* g, int l, int shoff, int scoff) {
    const int lane = opq((int)threadIdx.x) & 63, wave = opq((int)threadIdx.x) >> 6, gw = blockIdx.x * 8 + wave, NGW = gridDim.x * 8;
    float* X = a.out; bf16* H = (bf16*)(a.ws + WS_H); const float* MOD = (const float*)(a.ws + WS_MOD) + (size_t)l * 5 * 6144;
    for (int t = gw; t < NTOK; t += NGW) {
        const float* src = MODE == 0 ? (t < NCTX ? a.in[0] + (size_t)t * DM : a.in[1] + (size_t)(t - NCTX) * DM) : X + (size_t)t * DM;
        f32x4 v[4]; float ss = 0.f;
#pragma unroll
        for (int j = 0; j < 4; ++j) { v[j] = *(const f32x4*)(src + 256 * j + lane * 4); ss += (v[j].x * v[j].x + v[j].y * v[j].y) + (v[j].z * v[j].z + v[j].w * v[j].w); }
        const float rstd = rsqrtf(wave_sum(ss) * (1.f / DM) + 1e-6f);
        const float* md = MOD + (size_t)cond_of(t) * 6144;
#pragma unroll
        for (int j = 0; j < 4; ++j) { const int col = 256 * j + lane * 4; const f32x4 gg = *(const f32x4*)(g + col);
            if (MODE == 2) { *(f32x4*)(X + (size_t)t * DM + col) = v[j] * rstd * gg; }
            else { const f32x4 sc = *(const f32x4*)(md + scoff + col), sh = *(const f32x4*)(md + shoff + col);
                const f32x4 h = (v[j] * rstd * gg) * (sc + 1.f) + sh;
                u32x2 o; o.x = pk2(h.x, h.y); o.y = pk2(h.z, h.w); *(u32x2*)(H + (size_t)t * DM + col) = o;
                if (MODE == 0) *(f32x4*)(X + (size_t)t * DM + col) = v[j]; } }
    }
}

#define EPI_LOOP(...) \
    _Pragma("unroll") for (int ai = 0; ai < 2; ++ai) _Pragma("unroll") for (int m = 0; m < 4; ++m) { const int row = u.pm * 256 + ai * 128 + wr * 64 + m * 16 + fr; \
    _Pragma("unroll") for (int bj = 0; bj < 2; ++bj) _Pragma("unroll") for (int n = 0; n < 2; ++n) { const int cl = bj * 128 + wc * 32 + n * 16 + 4 * fq; const f32x4 v = acc[ai][bj][m][n]; __VA_ARGS__ } asm volatile("" ::: "memory"); }

struct EpiF32 {
    static constexpr bool PERM = false, AFTER_DRAIN = false;
    float* C; int ldc;
    __device__ __forceinline__ void operator()(const f32x4 (&acc)[2][2][4][2], const pg8::Unit& u, int wr, int wc, int fr, int fq) const {
        EPI_LOOP({ *(f32x4*)(C + (size_t)row * ldc + u.pn * 256 + cl) = v; })
    }
};
struct EpiBf16 {
    static constexpr bool PERM = false, AFTER_DRAIN = false;
    bf16* O; int ldc;
    __device__ __forceinline__ void operator()(const f32x4 (&acc)[2][2][4][2], const pg8::Unit& u, int wr, int wc, int fr, int fq) const {
        EPI_LOOP({ u32x2 o; o.x = pk2(v.x, v.y); o.y = pk2(v.z, v.w); *(u32x2*)(O + (size_t)row * ldc + u.pn * 256 + cl) = o; })
    }
};
struct EpiResid {
    static constexpr bool PERM = false, AFTER_DRAIN = false;
    float* X; const float* gate; int nsplit;
    __device__ __forceinline__ void operator()(const f32x4 (&acc)[2][2][4][2], const pg8::Unit& u, int wr, int wc, int fr, int fq) const {
        const float* gt_ = gate + (size_t)cond_of(u.pm * 256) * 6144; const int pn = u.pn & 3;
        EPI_LOOP({ const int col = pn * 256 + cl; const f32x4 gg = *(const f32x4*)(gt_ + col); float* p = X + (size_t)row * DM + col;
            if (nsplit == 1) { const f32x4 x = *(const f32x4*)p; *(f32x4*)p = x + gg * v; }
            else { atomicAdd(p + 0, gg.x * v.x); atomicAdd(p + 1, gg.y * v.y); atomicAdd(p + 2, gg.z * v.z); atomicAdd(p + 3, gg.w * v.w); } })
    }
};
struct EpiOdIn {
    static constexpr bool PERM = false, AFTER_DRAIN = false;
    float* HG; bf16* PR; const float* LB;
    __device__ __forceinline__ void operator()(const f32x4 (&acc)[2][2][4][2], const pg8::Unit& u, int wr, int wc, int fr, int fq) const {
        const int pn = u.pn;
        if (pn < 10) { const int kind = pn >> 1;
            EPI_LOOP({ const int col = pn * 256 + cl; f32x4 o = v;
                if (kind == 0) { o.x = silu(v.x); o.y = silu(v.y); o.z = silu(v.z); o.w = silu(v.w); }
                else if (kind <= 2) { const f32x4 lb = *(const f32x4*)(LB + (col - 512));
                    o.x = lb.x + (1.f - lb.x) * sigm(v.x); o.y = lb.y + (1.f - lb.y) * sigm(v.y); o.z = lb.z + (1.f - lb.z) * sigm(v.z); o.w = lb.w + (1.f - lb.w) * sigm(v.w); }
                *(f32x4*)(HG + (size_t)row * 2560 + col) = o; })
        } else {
            EPI_LOOP({ const int col = (pn - 10) * 256 + cl; if (col < 1856) { u32x2 o; o.x = pk2(v.x, v.y); o.y = pk2(v.z, v.w); *(u32x2*)(PR + (size_t)row * 1856 + col) = o; } })
        }
    }
};
struct EpiLora {
    static constexpr bool PERM = false, AFTER_DRAIN = false;
    float* WF; float* WB; const bf16* KK; const bf16* K1; bf16* KKA; bf16* KT; bf16* G; const float* w0; const float* a0; const float* k_a;
    __device__ __forceinline__ void operator()(const f32x4 (&acc)[2][2][4][2], const pg8::Unit& u, int wr, int wc, int fr, int fq) const {
        const int pn = u.pn, kind = pn >> 1;
        if (kind <= 1) { float* W = kind == 0 ? WF : WB;
            EPI_LOOP({ const int c = (pn & 1) * 256 + cl; const f32x4 z0 = *(const f32x4*)(w0 + kind * 512 + c); f32x4 o;
                o.x = __expf(-0.60653066f * sigm(v.x + z0.x)); o.y = __expf(-0.60653066f * sigm(v.y + z0.y)); o.z = __expf(-0.60653066f * sigm(v.z + z0.z)); o.w = __expf(-0.60653066f * sigm(v.w + z0.w));
                *(f32x4*)(W + (size_t)row * 512 + c) = o; })
        } else if (kind == 2) {
            EPI_LOOP({ const int c = (pn & 1) * 256 + cl; const f32x4 z0 = *(const f32x4*)(a0 + c), ka = *(const f32x4*)(k_a + c);
                const u32x2 kkw = *(const u32x2*)(KK + (size_t)row * 512 + c), k1w = *(const u32x2*)(K1 + (size_t)row * 512 + c);
                const float a0_ = sigm(v.x + z0.x), a1_ = sigm(v.y + z0.y), a2_ = sigm(v.z + z0.z), a3_ = sigm(v.w + z0.w);
                u32x2 o1; o1.x = pk2(bflo(kkw.x) * a0_, bfhi(kkw.x) * a1_); o1.y = pk2(bflo(kkw.y) * a2_, bfhi(kkw.y) * a3_);
                u32x2 o2; o2.x = pk2(bflo(k1w.x) * (1.f + (a0_ - 1.f) * ka.x), bfhi(k1w.x) * (1.f + (a1_ - 1.f) * ka.y)); o2.y = pk2(bflo(k1w.y) * (1.f + (a2_ - 1.f) * ka.z), bfhi(k1w.y) * (1.f + (a3_ - 1.f) * ka.w));
                *(u32x2*)(KKA + (size_t)row * 512 + c) = o1; *(u32x2*)(KT + (size_t)row * 512 + c) = o2; })
        } else {
            EPI_LOOP({ const int c = (pn & 1) * 256 + cl; u32x2 o; o.x = pk2(v.x, v.y); o.y = pk2(v.z, v.w); *(u32x2*)(G + (size_t)row * 512 + c) = o; })
        }
    }
};
template <class Epi>
__device__ __forceinline__ void run_gemm(unsigned char* lds, const bf16* A, const bf16* Bt, int Nunits256, int K, int ld, int nNr, const Epi& E) {
    pg8::Gemm g{A, Bt, NTOK, Nunits256 * 256, K, ld, nNr};
    pg8::StaticOrder S; S.init(NTOK, Nunits256 * 256, (int)gridDim.x, (int)blockIdx.x);
    pg8::gemm_phase<Epi, pg8::StaticOrder, false>((PG8_LAS unsigned char*)lds, g, S, E, nullptr);
}

__device__ __forceinline__ void rope4(f32x4& v, const float (&cs)[4], const float (&sn)[4], int lane) {
    float p[4], o[4]; const float x[4] = {v.x, v.y, v.z, v.w};
#pragma unroll
    for (int j = 0; j < 4; ++j) p[j] = __shfl_xor(x[j], 4);
#pragma unroll
    for (int j = 0; j < 4; ++j) o[j] = (lane & 4) ? (p[j] * sn[j] + x[j] * cs[j]) : (x[j] * cs[j] - p[j] * sn[j]);
    v = (f32x4){o[0], o[1], o[2], o[3]};
}
__device__ __forceinline__ void qkv_post(const Args& a, unsigned char* lds) {
    const int tid = opq((int)threadIdx.x), lane = tid & 63, wave = tid >> 6, gw = blockIdx.x * 8 + wave, NGW = gridDim.x * 8;
    unsigned char* ws = a.ws; const float* PROJ = (const float*)(ws + WS_PROJ);
    bf16* QA = (bf16*)(ws + WS_QA); bf16* QB = (bf16*)(ws + WS_QB);
    for (int t = gw; t < NTOK; t += NGW) {
        const float* row = PROJ + (size_t)t * 2304;
        const bool smp = t >= NCTX; const int b = smp ? ((t - NCTX) >> 10) : (t >> 8), s = smp ? ((t - NCTX) & 1023) : (t & 255);
        const int T = smp ? 1536 : 256, tpos = smp ? 512 + s : s;
        float cs[4], sn[4];
        { const float pos = (float)((lane & 8) ? (s & 63) : (s >> 6));
#pragma unroll
          for (int j = 0; j < 4; ++j) { const float fr_ = __expf(-(float)(4 * (lane & 3) + j) * (9.210340372f / 16.f)); const float ang = pos * fr_; cs[j] = __cosf(ang); sn[j] = __sinf(ang); } }
        const int hh = lane >> 4, cc4 = (lane & 15) * 4;
#pragma unroll
        for (int c = 0; c < 9; ++c) {
            f32x4 v = *(const f32x4*)(row + c * 256 + lane * 4);
            if (c < 2) {
                if (smp) rope4(v, cs, sn, lane);
                v = v * 0.125f; u32x2 o; o.x = pk2(v.x, v.y); o.y = pk2(v.z, v.w); *(u32x2*)(QA + (size_t)t * 512 + c * 256 + lane * 4) = o;
            } else if (c < 4) {
                if (smp) rope4(v, cs, sn, lane);
                const int col = (c - 2) * 256 + lane * 4, h = col >> 7, cc = col & 127;
                bf16* KA = (bf16*)(ws + (smp ? WS_KAS : WS_KAC));
                u32x2 o; o.x = pk2(v.x, v.y); o.y = pk2(v.z, v.w); *(u32x2*)(KA + ((size_t)(b * 4 + h) * T + tpos) * 128 + cc) = o;
                if (!smp) *(f32x4*)(a.out + O_AK + ((size_t)(b * 4 + h) * 256 + s) * 128 + cc) = v;
            } else if (c < 6) {
                const int col = (c - 4) * 256 + lane * 4, h = col >> 7, cc = col & 127;
                if (!smp) *(f32x4*)(a.out + O_AV + ((size_t)(b * 4 + h) * 256 + s) * 128 + cc) = v;
            } else {
                float ss = (v.x * v.x + v.y * v.y) + (v.z * v.z + v.w * v.w);
                ss += __shfl_xor(ss, 1); ss += __shfl_xor(ss, 2); ss += __shfl_xor(ss, 4); ss += __shfl_xor(ss, 8);
                const float rs = rsqrtf(ss * (1.f / 64.f) + 1e-6f);
                const f32x4 gg = *(const f32x4*)((c < 8 ? a.in[19] : a.in[20]) + cc4);
                f32x4 nv = v * rs * gg;
                if (smp) rope4(nv, cs, sn, lane);
                if (c < 8) { nv = nv * 0.125f; u32x2 o; o.x = pk2(nv.x, nv.y); o.y = pk2(nv.z, nv.w); *(u32x2*)(QB + (size_t)t * 512 + (c - 6) * 256 + lane * 4) = o; }
                else if (hh < 2) {
                    bf16* KB = (bf16*)(ws + (smp ? WS_KBS : WS_KBC));
                    u32x2 o; o.x = pk2(nv.x, nv.y); o.y = pk2(nv.z, nv.w); *(u32x2*)(KB + ((size_t)(b * 2 + hh) * T + tpos) * 64 + cc4) = o;
                    if (!smp) *(f32x4*)(a.out + O_BK + ((size_t)(b * 2 + hh) * 256 + s) * 64 + cc4) = nv;
                } else {
                    if (!smp) *(f32x4*)(a.out + O_BV + ((size_t)(b * 2 + (hh - 2)) * 256 + s) * 64 + cc4) = v;
                }
            }
        }
    }
    float* scr = (float*)(lds + wave * 8448);
    for (int it = gw; it < 128 * 20; it += NGW) {
        const int tb = it / 20, nb = it % 20; const bool smp = tb >= 64;
        const int b = smp ? ((tb - 64) >> 4) : (tb >> 2), s0 = smp ? ((tb - 64) & 15) * 64 : (tb & 3) * 64, T = smp ? 1536 : 256, tpos = smp ? 512 + s0 : s0;
        if (nb < 16) { const int h = nb >> 2, e0 = (nb & 3) * 32;
            bf16* dst = (bf16*)(ws + (smp ? WS_VATS : WS_VATC)) + ((size_t)(b * 4 + h) * 128 + e0) * T + tpos;
            tr_item(PROJ + (size_t)tb * 64 * 2304 + 1024 + nb * 32, 2304, dst, T, scr, lane);
        } else { const int n2 = nb - 16, g = n2 >> 1, e0 = (n2 & 1) * 32;
            bf16* dst = (bf16*)(ws + (smp ? WS_VBTS : WS_VBTC)) + ((size_t)(b * 2 + g) * 64 + e0) * T + tpos;
            tr_item(PROJ + (size_t)tb * 64 * 2304 + 2176 + n2 * 32, 2304, dst, T, scr, lane);
        }
    }
}

template <int DV, int LDK, bool SHK>
__device__ __forceinline__ void attn_core(unsigned char* lds, const bf16* Qw, int qc0, int qc1, const bf16* Kg, const bf16* VTg, int T, f32x4 (&O)[2][DV / 16], float (&linv)[2]) {
    constexpr int KSTR = LDK * 2 + 16, VSTR = 144, VOFF = 64 * KSTR, NKC = 64 * LDK / 8 / 512, NVC = DV * 8 / 512, KCPR = LDK / 8;
    const int tid = opq((int)threadIdx.x), lane = tid & 63, fr = lane & 15, fq = lane >> 4;
    bf16x8 qf[2][2];
#pragma unroll
    for (int ks = 0; ks < 2; ++ks) { qf[0][ks] = *(const bf16x8*)(Qw + (size_t)fr * 512 + qc0 + ks * 32 + fq * 8); qf[1][ks] = *(const bf16x8*)(Qw + (size_t)fr * 512 + qc1 + ks * 32 + fq * 8); }
#pragma unroll
    for (int s = 0; s < 2; ++s)
#pragma unroll
        for (int e = 0; e < DV / 16; ++e) O[s][e] = (f32x4){0.f, 0.f, 0.f, 0.f};
    float mrun[2] = {-1e30f, -1e30f}, lsum[2] = {0.f, 0.f};
    u32x4 kreg[NKC], vreg[NVC];
    const int ntile = T / 64;
#define ATT_LOAD(t0) do { _Pragma("unroll") for (int i = 0; i < NKC; ++i) { const int c = tid + i * 512, r = c / KCPR, cc = c % KCPR; kreg[i] = *(const u32x4*)(Kg + (size_t)((t0) + r) * LDK + cc * 8); } \
        _Pragma("unroll") for (int i = 0; i < NVC; ++i) { const int c = tid + i * 512, e = c >> 3, cc = c & 7; vreg[i] = *(const u32x4*)(VTg + (size_t)e * T + (t0) + cc * 8); } } while (0)
    ATT_LOAD(0);
    for (int it = 0; it < ntile; ++it) {
        __syncthreads();
#pragma unroll
        for (int i = 0; i < NKC; ++i) { const int c = tid + i * 512, r = c / KCPR, cc = c % KCPR; *(u32x4*)(lds + r * KSTR + cc * 16) = kreg[i]; }
#pragma unroll
        for (int i = 0; i < NVC; ++i) { const int c = tid + i * 512, e = c >> 3, cc = c & 7; *(u32x4*)(lds + VOFF + e * VSTR + cc * 16) = vreg[i]; }
        __syncthreads();
        if (it + 1 < ntile) ATT_LOAD((it + 1) * 64);
        f32x4 sc[2][4];
#pragma unroll
        for (int kt = 0; kt < 4; ++kt) {
            sc[0][kt] = (f32x4){0.f, 0.f, 0.f, 0.f}; sc[1][kt] = (f32x4){0.f, 0.f, 0.f, 0.f};
#pragma unroll
            for (int ks = 0; ks < 2; ++ks) {
                const bf16x8 a0 = *(const bf16x8*)(lds + (kt * 16 + fr) * KSTR + (ks * 32 + fq * 8) * 2);
                sc[0][kt] = __builtin_amdgcn_mfma_f32_16x16x32_bf16(a0, qf[0][ks], sc[0][kt], 0, 0, 0);
                if (SHK) sc[1][kt] = __builtin_amdgcn_mfma_f32_16x16x32_bf16(a0, qf[1][ks], sc[1][kt], 0, 0, 0);
                else { const bf16x8 a1 = *(const bf16x8*)(lds + (kt * 16 + fr) * KSTR + (64 + ks * 32 + fq * 8) * 2);
                    sc[1][kt] = __builtin_amdgcn_mfma_f32_16x16x32_bf16(a1, qf[1][ks], sc[1][kt], 0, 0, 0); }
            }
        }
        bf16x8 pb[2][2];
#pragma unroll
        for (int s = 0; s < 2; ++s) {
            float mt = -1e30f;
#pragma unroll
            for (int kt = 0; kt < 4; ++kt) mt = fmaxf(fmaxf(fmaxf(sc[s][kt].x, sc[s][kt].y), fmaxf(sc[s][kt].z, sc[s][kt].w)), mt);
            mt = fmaxf(mt, __shfl_xor(mt, 16)); mt = fmaxf(mt, __shfl_xor(mt, 32));
            const float mnew = fmaxf(mrun[s], mt), alpha = __expf(mrun[s] - mnew); mrun[s] = mnew;
            float ps = 0.f;
#pragma unroll
            for (int kt = 0; kt < 4; ++kt) { sc[s][kt].x = __expf(sc[s][kt].x - mnew); sc[s][kt].y = __expf(sc[s][kt].y - mnew); sc[s][kt].z = __expf(sc[s][kt].z - mnew); sc[s][kt].w = __expf(sc[s][kt].w - mnew);
                ps += (sc[s][kt].x + sc[s][kt].y) + (sc[s][kt].z + sc[s][kt].w); }
            lsum[s] = lsum[s] * alpha + ps;
#pragma unroll
            for (int e = 0; e < DV / 16; ++e) O[s][e] = O[s][e] * alpha;
#pragma unroll
            for (int k2 = 0; k2 < 2; ++k2) { u32x4 w; w.x = pk2(sc[s][2 * k2].x, sc[s][2 * k2].y); w.y = pk2(sc[s][2 * k2].z, sc[s][2 * k2].w); w.z = pk2(sc[s][2 * k2 + 1].x, sc[s][2 * k2 + 1].y); w.w = pk2(sc[s][2 * k2 + 1].z, sc[s][2 * k2 + 1].w);
                pb[s][k2] = __builtin_bit_cast(bf16x8, w); }
        }
#pragma unroll
        for (int e = 0; e < DV / 16; ++e)
#pragma unroll
            for (int k2 = 0; k2 < 2; ++k2) {
                const unsigned char* vp = lds + VOFF + (e * 16 + fr) * VSTR + (k2 * 32 + fq * 4) * 2;
                const u32x2 lo = *(const u32x2*)vp, hi = *(const u32x2*)(vp + 32);
                const u32x4 w = {lo.x, lo.y, hi.x, hi.y}; const bf16x8 av = __builtin_bit_cast(bf16x8, w);
                O[0][e] = __builtin_amdgcn_mfma_f32_16x16x32_bf16(av, pb[0][k2], O[0][e], 0, 0, 0);
                O[1][e] = __builtin_amdgcn_mfma_f32_16x16x32_bf16(av, pb[1][k2], O[1][e], 0, 0, 0);
            }
    }
#undef ATT_LOAD
#pragma unroll
    for (int s = 0; s < 2; ++s) { float l = lsum[s]; l += __shfl_xor(l, 16); l += __shfl_xor(l, 32); linv[s] = 1.f / l; }
    __syncthreads();
}
__device__ __forceinline__ void attn_phase(const Args& a, unsigned char* lds) {
    unsigned char* ws = a.ws; const int tid = opq((int)threadIdx.x), lane = tid & 63, wave = tid >> 6, fr = lane & 15, fq = lane >> 4;
    const bf16* QA = (const bf16*)(ws + WS_QA); const bf16* QB = (const bf16*)(ws + WS_QB); bf16* CAT = (bf16*)(ws + WS_CAT);
    const float lam = *(const float*)(ws + WS_LAM);
    for (int u = blockIdx.x; u < 512; u += gridDim.x) {
        const bool isA = (u < 128) || (u >= 384), smp = u < 256;
        int idx = u < 128 ? u : (u < 256 ? u - 128 : (u < 384 ? u - 256 : u - 384));
        const int T = smp ? 1536 : 256;
        int b, hx, pair = 0, qb;
        if (smp) { b = idx >> 5; qb = idx & 7; if (isA) hx = (idx >> 3) & 3; else { hx = (idx >> 4) & 1; pair = (idx >> 3) & 1; } }
        else { b = idx >> 3; if (isA) { hx = (idx >> 1) & 3; qb = idx & 1; } else { hx = (idx >> 2) & 1; pair = (idx >> 1) & 1; qb = idx & 1; } }
        const int tok0 = (smp ? NCTX + b * 1024 : b * 256) + qb * 128 + wave * 16;
        if (isA) {
            const bf16* Kg = (const bf16*)(ws + (smp ? WS_KAS : WS_KAC)) + (size_t)(b * 4 + hx) * T * 128;
            const bf16* Vg = (const bf16*)(ws + (smp ? WS_VATS : WS_VATC)) + (size_t)(b * 4 + hx) * 128 * T;
            f32x4 O[2][8]; float li[2];
            attn_core<128, 128, false>(lds, QA + (size_t)tok0 * 512, hx * 128, hx * 128 + 64, Kg, Vg, T, O, li);
            float ss = 0.f;
#pragma unroll
            for (int e = 0; e < 8; ++e) { O[0][e] = O[0][e] * li[0] - (O[1][e] * li[1]) * lam; ss += (O[0][e].x * O[0][e].x + O[0][e].y * O[0][e].y) + (O[0][e].z * O[0][e].z + O[0][e].w * O[0][e].w); }
            ss += __shfl_xor(ss, 16); ss += __shfl_xor(ss, 32);
            const float rs = rsqrtf(ss * (1.f / 128.f) + 1e-6f) * 0.8f;
#pragma unroll
            for (int e = 0; e < 8; ++e) { const int ec = e * 16 + fq * 4; const f32x4 gg = *(const f32x4*)(a.in[18] + ec); const f32x4 y = O[0][e] * rs * gg;
                u32x2 o; o.x = pk2(y.x, y.y); o.y = pk2(y.z, y.w); *(u32x2*)(CAT + (size_t)(tok0 + fr) * 1024 + hx * 128 + ec) = o; }
        } else {
            const bf16* Kg = (const bf16*)(ws + (smp ? WS_KBS : WS_KBC)) + (size_t)(b * 2 + hx) * T * 64;
            const bf16* Vg = (const bf16*)(ws + (smp ? WS_VBTS : WS_VBTC)) + (size_t)(b * 2 + hx) * 64 * T;
            const int hq0 = hx * 4 + pair * 2;
            f32x4 O[2][4]; float li[2];
#if defined(DBG_SKIP_B)
            if (DBG_SKIP_B == 1 ? smp : !smp) {
#pragma unroll
            for (int s = 0; s < 2; ++s) { li[s] = 0.f;
#pragma unroll
                for (int e = 0; e < 4; ++e) O[s][e] = (f32x4){0.f, 0.f, 0.f, 0.f}; }
            } else
#endif
            attn_core<64, 64, true>(lds, QB + (size_t)tok0 * 512, hq0 * 64, (hq0 + 1) * 64, Kg, Vg, T, O, li);
#pragma unroll
            for (int s = 0; s < 2; ++s)
#pragma unroll
                for (int e = 0; e < 4; ++e) { const f32x4 y = O[s][e] * li[s]; u32x2 o; o.x = pk2(y.x, y.y); o.y = pk2(y.z, y.w);
                    *(u32x2*)(CAT + (size_t)(tok0 + fr) * 1024 + 512 + (hq0 + s) * 64 + e * 16 + fq * 4) = o; }
        }
    }
}

__device__ __forceinline__ void conv_phase(const Args& a, int l) {
    const int gt = blockIdx.x * 512 + opq((int)threadIdx.x), NGT = gridDim.x * 512;
    const bf16* U = (const bf16*)(a.ws + WS_U); bf16* ACT = (bf16*)(a.ws + WS_ACT);
    const float* cw = a.in[37] + (size_t)l * 3 * 5632; const float* cb = a.in[38] + (size_t)l * 5632;
    for (int g = gt; g < 512 * 352; g += NGT) {
        const int run = g / 352, ch = g % 352, j0 = ch * 8, t0 = run * 16;
        const int S = t0 < NCTX ? 256 : 1024, s0 = t0 < NCTX ? (t0 & 255) : ((t0 - NCTX) & 1023);
        float w0v[8], w1v[8], w2v[8], bv[8], w0g[8], w1g[8], w2g[8], bg[8];
#pragma unroll
        for (int k = 0; k < 8; ++k) { w0v[k] = cw[j0 + k]; w1v[k] = cw[5632 + j0 + k]; w2v[k] = cw[2 * 5632 + j0 + k]; bv[k] = cb[j0 + k];
            w0g[k] = cw[DFF + j0 + k]; w1g[k] = cw[5632 + DFF + j0 + k]; w2g[k] = cw[2 * 5632 + DFF + j0 + k]; bg[k] = cb[DFF + j0 + k]; }
        const u32x4 zero = {0u, 0u, 0u, 0u};
        u32x4 pv = zero, pg = zero, cv, cg_;
        if (s0 > 0) { pv = *(const u32x4*)(U + (size_t)(t0 - 1) * 5632 + j0); pg = *(const u32x4*)(U + (size_t)(t0 - 1) * 5632 + DFF + j0); }
        cv = *(const u32x4*)(U + (size_t)t0 * 5632 + j0); cg_ = *(const u32x4*)(U + (size_t)t0 * 5632 + DFF + j0);
        for (int i = 0; i < 16; ++i) {
            const int t = t0 + i; u32x4 nv = zero, ng = zero;
            if (s0 + i + 1 < S) { nv = *(const u32x4*)(U + (size_t)(t + 1) * 5632 + j0); ng = *(const u32x4*)(U + (size_t)(t + 1) * 5632 + DFF + j0); }
            float o[8];
#pragma unroll
            for (int k = 0; k < 4; ++k) {
                const float vl = w0v[2 * k] * bflo(pv[k]) + w1v[2 * k] * bflo(cv[k]) + w2v[2 * k] * bflo(nv[k]) + bv[2 * k];
                const float vh = w0v[2 * k + 1] * bfhi(pv[k]) + w1v[2 * k + 1] * bfhi(cv[k]) + w2v[2 * k + 1] * bfhi(nv[k]) + bv[2 * k + 1];
                const float gl = w0g[2 * k] * bflo(pg[k]) + w1g[2 * k] * bflo(cg_[k]) + w2g[2 * k] * bflo(ng[k]) + bg[2 * k];
                const float gh = w0g[2 * k + 1] * bfhi(pg[k]) + w1g[2 * k + 1] * bfhi(cg_[k]) + w2g[2 * k + 1] * bfhi(ng[k]) + bg[2 * k + 1];
                o[2 * k] = silu(gl) * vl; o[2 * k + 1] = silu(gh) * vh; }
            u32x4 w; w.x = pk2(o[0], o[1]); w.y = pk2(o[2], o[3]); w.z = pk2(o[4], o[5]); w.w = pk2(o[6], o[7]);
            *(u32x4*)(ACT + (size_t)t * DFF + j0) = w;
            pv = cv; pg = cg_; cv = nv; cg_ = ng;
        }
    }
}

__device__ __forceinline__ void prep1_phase(const Args& a) {
    const int lane = opq((int)threadIdx.x) & 63, wave = opq((int)threadIdx.x) >> 6, gw = blockIdx.x * 8 + wave, NGW = gridDim.x * 8;
    unsigned char* ws = a.ws; const bf16* PR = (const bf16*)(ws + WS_PR);
    bf16* R = (bf16*)(ws + WS_R); bf16* K1 = (bf16*)(ws + WS_K1); bf16* V1 = (bf16*)(ws + WS_V1); bf16* KK = (bf16*)(ws + WS_KK); bf16* AP = (bf16*)(ws + WS_AP);
    const float* mu = a.in[25]; const float* k_k = a.in[31];
    for (int t = gw; t < NTOK; t += NGW) {
        const int S = t < NCTX ? 256 : 1024, s = t < NCTX ? (t & 255) : ((t - NCTX) & 1023);
        const bool hp = s > 0, hn = s + 1 < S;
#pragma unroll
        for (int it = 0; it < 4; ++it) {
            const int c = it * 64 + lane; if (c >= 232) break;
            const int col = c * 8; const u32x4 zero = {0u, 0u, 0u, 0u};
            const u32x4 x = *(const u32x4*)(PR + (size_t)t * 1856 + col);
            const u32x4 xp = hp ? *(const u32x4*)(PR + (size_t)(t - 1) * 1856 + col) : zero;
            const u32x4 xn = hn ? *(const u32x4*)(PR + (size_t)(t + 1) * 1856 + col) : zero;
            float pd[8];
#pragma unroll
            for (int k = 0; k < 4; ++k) { const float m0 = mu[col + 2 * k], m1 = mu[col + 2 * k + 1];
                const float c0 = bflo(x[k]), c1 = bfhi(x[k]);
                pd[2 * k] = c0 + m0 * (0.5f * (bflo(xp[k]) + bflo(xn[k])) - c0); pd[2 * k + 1] = c1 + m1 * (0.5f * (bfhi(xp[k]) + bfhi(xn[k])) - c1); }
            u32x4 w; w.x = pk2(pd[0], pd[1]); w.y = pk2(pd[2], pd[3]); w.z = pk2(pd[4], pd[5]); w.w = pk2(pd[6], pd[7]);
            if (it == 0) { *(u32x4*)(R + (size_t)t * 512 + col) = w; }
            else if (it == 1) { const int kc = col - 512; *(u32x4*)(K1 + (size_t)t * 512 + kc) = w;
                float q[8], ss = 0.f;
#pragma unroll
                for (int k = 0; k < 8; ++k) { q[k] = pd[k] * k_k[kc + k]; ss += q[k] * q[k]; }
                ss += __shfl_xor(ss, 1); ss += __shfl_xor(ss, 2); ss += __shfl_xor(ss, 4);
                const float inv = 1.f / fmaxf(sqrtf(ss), 1e-12f);
                u32x4 o; o.x = pk2(q[0] * inv, q[1] * inv); o.y = pk2(q[2] * inv, q[3] * inv); o.z = pk2(q[4] * inv, q[5] * inv); o.w = pk2(q[6] * inv, q[7] * inv);
                *(u32x4*)(KK + (size_t)t * 512 + kc) = o; }
            else if (it == 2) { *(u32x4*)(V1 + (size_t)t * 512 + (col - 1024)) = w; }
            else { const int ac = col - 1536;
                float o[8];
#pragma unroll
                for (int k = 0; k < 8; ++k) { const float x_ = pd[k]; o[k] = ac < 128 ? (1.f - 2.f / (1.f + __expf(2.f * x_))) : (ac < 192 ? x_ : sigm(x_)); }
                u32x4 ow; ow.x = pk2(o[0], o[1]); ow.y = pk2(o[2], o[3]); ow.z = pk2(o[4], o[5]); ow.w = pk2(o[6], o[7]);
                *(u32x4*)(AP + (size_t)t * 384 + ac) = ow; }
        }
        if (lane < 8) *(u32x4*)(AP + (size_t)t * 384 + 320 + lane * 8) = (u32x4){0u, 0u, 0u, 0u};
    }
}

__device__ __forceinline__ void hgrn_job(const Args& a, unsigned char* lds, int job) {
    const int tid = opq((int)threadIdx.x); unsigned char* ws = a.ws;
    const bool smp = job < 128; const int j = smp ? job : job - 128;
    const int b = j >> 5, h = (j >> 3) & 3, dir = (j >> 2) & 1, sl = j & 3;
    const int tok0 = smp ? NCTX + b * 1024 : b * 256, S = smp ? 1024 : 256;
    const int ksl = tid & 15, el = tid >> 4, e = sl * 32 + el, k0 = ksl * 8;
    const float* HG = (const float*)(ws + WS_HG); bf16* OC = (bf16*)(ws + (dir ? WS_OCB : WS_OCF));
    float St[8];
    if (smp) {
#pragma unroll
        for (int i = 0; i < 8; ++i) St[i] = a.in[6][((size_t)((b * 2 + dir) * 4 + h) * 128 + k0 + i) * 128 + e];
    } else {
#pragma unroll
        for (int i = 0; i < 8; ++i) St[i] = 0.f;
    }
    float* sF = (float*)lds; float* sQ = sF + 2048; float* sV = sQ + 2048; float* sO = sV + 512;
    const int ltok = tid >> 5, lk = (tid & 31) * 4, vtok = tid >> 5, vev = tid & 31;
    f32x4 rf, rq; float rv;
#define HG_LOAD(ch) do { const int p_ = (ch) * 16 + ltok; const int s_ = dir ? S - 1 - p_ : p_; const float* r_ = HG + (size_t)(tok0 + s_) * 2560; \
        rf = *(const f32x4*)(r_ + 512 + dir * 512 + h * 128 + lk); rq = *(const f32x4*)(r_ + h * 128 + lk); rv = r_[1536 + h * 128 + sl * 32 + vev]; } while (0)
    HG_LOAD(0);
    const int nch = S / 16;
    for (int ch = 0; ch < nch; ++ch) {
        __syncthreads();
        *(f32x4*)(sF + ltok * 128 + lk) = rf; *(f32x4*)(sQ + ltok * 128 + lk) = rq; sV[vtok * 32 + vev] = rv;
        __syncthreads();
        if (ch + 1 < nch) HG_LOAD(ch + 1);
#pragma unroll 4
        for (int tl = 0; tl < 16; ++tl) {
            const f32x4 f0 = *(const f32x4*)(sF + tl * 128 + k0), f1 = *(const f32x4*)(sF + tl * 128 + k0 + 4);
            const f32x4 q0 = *(const f32x4*)(sQ + tl * 128 + k0), q1 = *(const f32x4*)(sQ + tl * 128 + k0 + 4);
            const float v = sV[tl * 32 + el];
            const float f[8] = {f0.x, f0.y, f0.z, f0.w, f1.x, f1.y, f1.z, f1.w}, q[8] = {q0.x, q0.y, q0.z, q0.w, q1.x, q1.y, q1.z, q1.w};
            float o = 0.f;
#pragma unroll
            for (int i = 0; i < 8; ++i) { St[i] = fmaf(f[i], St[i] - v, v); o = fmaf(q[i], St[i], o); }
            o += __shfl_xor(o, 1); o += __shfl_xor(o, 2); o += __shfl_xor(o, 4); o += __shfl_xor(o, 8);
            if (ksl == 0) sO[tl * 32 + el] = o;
        }
        __syncthreads();
        { const int p_ = ch * 16 + vtok; const int s_ = dir ? S - 1 - p_ : p_; OC[(size_t)(tok0 + s_) * 512 + h * 128 + sl * 32 + vev] = f2bf(sO[vtok * 32 + vev]); }
    }
#undef HG_LOAD
    if (!smp) {
#pragma unroll
        for (int i = 0; i < 8; ++i) a.out[O_SH + ((size_t)((b * 2 + dir) * 4 + h) * 128 + k0 + i) * 128 + e] = St[i];
    }
    __syncthreads();
}
__device__ __forceinline__ void rwkv_job(const Args& a, unsigned char* lds, int job) {
    const int tid = opq((int)threadIdx.x); unsigned char* ws = a.ws;
    const bool smp = job < 64; const int j = smp ? job : job - 64;
    const int b = j >> 4, h = (j >> 1) & 7, dir = j & 1;
    const int tok0 = smp ? NCTX + b * 1024 : b * 256, S = smp ? 1024 : 256;
    const int ksl = tid & 7, k0 = ksl * 8, rv_ = tid >> 3;
    const bf16* KK = (const bf16*)(ws + WS_KK); const bf16* KKA = (const bf16*)(ws + WS_KKA); const bf16* KT = (const bf16*)(ws + WS_KT);
    const bf16* R = (const bf16*)(ws + WS_R); const bf16* V1 = (const bf16*)(ws + WS_V1); const float* W = (const float*)(ws + (dir ? WS_WB : WS_WF));
    bf16* OD = (bf16*)(ws + (dir ? WS_ODB : WS_ODF));
    float St[8];
    if (smp) {
#pragma unroll
        for (int i = 0; i < 8; ++i) St[i] = a.in[7][((size_t)((b * 2 + dir) * 8 + h) * 64 + rv_) * 64 + k0 + i];
    } else {
#pragma unroll
        for (int i = 0; i < 8; ++i) St[i] = 0.f;
    }
    float* sKK = (float*)lds; float* sW = sKK + 1024; float* sKA = sW + 1024; float* sKT = sKA + 1024; float* sR = sKT + 1024; float* sV = sR + 1024; float* sO = sV + 1024;
    const int ltok = tid >> 5, lc = (tid & 31) * 2;
    unsigned rkk, rka, rkt, rr, rvv; f32x2 rw;
#define RW_LOAD(ch) do { const int p_ = (ch) * 16 + ltok; const int s_ = dir ? S - 1 - p_ : p_; const size_t o_ = (size_t)(tok0 + s_) * 512 + h * 64 + lc; \
        rkk = *(const unsigned*)(KK + o_); rka = *(const unsigned*)(KKA + o_); rkt = *(const unsigned*)(KT + o_); rr = *(const unsigned*)(R + o_); rvv = *(const unsigned*)(V1 + o_); rw = *(const f32x2*)(W + o_); } while (0)
    RW_LOAD(0);
    const int nch = S / 16;
    for (int ch = 0; ch < nch; ++ch) {
        __syncthreads();
        { const int o_ = ltok * 64 + lc; *(f32x2*)(sKK + o_) = (f32x2){bflo(rkk), bfhi(rkk)}; *(f32x2*)(sKA + o_) = (f32x2){bflo(rka), bfhi(rka)}; *(f32x2*)(sKT + o_) = (f32x2){bflo(rkt), bfhi(rkt)};
          *(f32x2*)(sR + o_) = (f32x2){bflo(rr), bfhi(rr)}; *(f32x2*)(sV + o_) = (f32x2){bflo(rvv), bfhi(rvv)}; *(f32x2*)(sW + o_) = rw; }
        __syncthreads();
        if (ch + 1 < nch) RW_LOAD(ch + 1);
#pragma unroll 2
        for (int tl = 0; tl < 16; ++tl) {
            const int o_ = tl * 64 + k0;
            const f32x4 kk0 = *(const f32x4*)(sKK + o_), kk1 = *(const f32x4*)(sKK + o_ + 4), w0 = *(const f32x4*)(sW + o_), w1 = *(const f32x4*)(sW + o_ + 4);
            const f32x4 ka0 = *(const f32x4*)(sKA + o_), ka1 = *(const f32x4*)(sKA + o_ + 4), kt0 = *(const f32x4*)(sKT + o_), kt1 = *(const f32x4*)(sKT + o_ + 4);
            const f32x4 r0 = *(const f32x4*)(sR + o_), r1 = *(const f32x4*)(sR + o_ + 4);
            const float vv = sV[tl * 64 + rv_];
            const float kk[8] = {kk0.x, kk0.y, kk0.z, kk0.w, kk1.x, kk1.y, kk1.z, kk1.w}, w[8] = {w0.x, w0.y, w0.z, w0.w, w1.x, w1.y, w1.z, w1.w};
            const float ka[8] = {ka0.x, ka0.y, ka0.z, ka0.w, ka1.x, ka1.y, ka1.z, ka1.w}, kt[8] = {kt0.x, kt0.y, kt0.z, kt0.w, kt1.x, kt1.y, kt1.z, kt1.w};
            const float r[8] = {r0.x, r0.y, r0.z, r0.w, r1.x, r1.y, r1.z, r1.w};
            float sa = 0.f;
#pragma unroll
            for (int i = 0; i < 8; ++i) sa = fmaf(St[i], kk[i], sa);
            sa += __shfl_xor(sa, 1); sa += __shfl_xor(sa, 2); sa += __shfl_xor(sa, 4); sa = -sa;
            float o = 0.f;
#pragma unroll
            for (int i = 0; i < 8; ++i) { St[i] = fmaf(St[i], w[i], fmaf(sa, ka[i], vv * kt[i])); o = fmaf(St[i], r[i], o); }
            o += __shfl_xor(o, 1); o += __shfl_xor(o, 2); o += __shfl_xor(o, 4);
            if (ksl == 0) sO[tl * 64 + rv_] = o;
        }
        __syncthreads();
        { const int p_ = ch * 16 + ltok; const int s_ = dir ? S - 1 - p_ : p_; *(unsigned*)(OD + (size_t)(tok0 + s_) * 512 + h * 64 + lc) = pk2(sO[ltok * 64 + lc], sO[ltok * 64 + lc + 1]); }
    }
#undef RW_LOAD
    if (!smp) {
#pragma unroll
        for (int i = 0; i < 8; ++i) a.out[O_SR + ((size_t)((b * 2 + dir) * 8 + h) * 64 + rv_) * 64 + k0 + i] = St[i];
    }
    __syncthreads();
}
__device__ __forceinline__ void scan_phase(const Args& a, unsigned char* lds) {
    unsigned* qc = (unsigned*)(a.ws + WS_QCTR); int* sj = (int*)(lds + 65536);
    for (;;) {
        if (opq((int)threadIdx.x) == 0) *sj = (int)atomicAdd(qc, 1u);
        __syncthreads();
        const int job = *sj;
        __syncthreads();
        if (job >= 960) break;
        if (job < 64) rwkv_job(a, lds, job);
        else if (job < 192) hgrn_job(a, lds, job - 64);
        else if (job < 448) rwkv_job(a, lds, 64 + (job - 192));
        else hgrn_job(a, lds, 128 + (job - 448));
    }
}

__device__ __forceinline__ void post1_phase(const Args& a) {
    const int lane = opq((int)threadIdx.x) & 63, wave = opq((int)threadIdx.x) >> 6, gw = blockIdx.x * 8 + wave, NGW = gridDim.x * 8;
    unsigned char* ws = a.ws;
    const bf16* OCF = (const bf16*)(ws + WS_OCF); const bf16* OCB = (const bf16*)(ws + WS_OCB); const bf16* ODF = (const bf16*)(ws + WS_ODF); const bf16* ODB = (const bf16*)(ws + WS_ODB);
    const float* HG = (const float*)(ws + WS_HG); const bf16* R = (const bf16*)(ws + WS_R); const bf16* KT = (const bf16*)(ws + WS_KT); const bf16* V1 = (const bf16*)(ws + WS_V1); const bf16* G = (const bf16*)(ws + WS_G);
    bf16* CAT = (bf16*)(ws + WS_CAT2);
    const int col = lane * 8;
    for (int t = gw; t < NTOK; t += NGW) {
        {
            const u32x4 xa = *(const u32x4*)(OCF + (size_t)t * 512 + col), xb = *(const u32x4*)(OCB + (size_t)t * 512 + col);
            float x[8], ss = 0.f;
#pragma unroll
            for (int k = 0; k < 4; ++k) { x[2 * k] = bflo(xa[k]) + bflo(xb[k]); x[2 * k + 1] = bfhi(xa[k]) + bfhi(xb[k]); }
#pragma unroll
            for (int k = 0; k < 8; ++k) ss += x[k] * x[k];
            ss += __shfl_xor(ss, 1); ss += __shfl_xor(ss, 2); ss += __shfl_xor(ss, 4); ss += __shfl_xor(ss, 8);
            const float rs = rsqrtf(ss * (1.f / 128.f) + 1e-6f);
            const float* gn = a.in[24] + (col & 127); const float* gc = HG + (size_t)t * 2560 + 2048 + col;
            float y[8];
#pragma unroll
            for (int k = 0; k < 8; ++k) y[k] = x[k] * rs * gn[k] * silu(gc[k]);
            u32x4 w; w.x = pk2(y[0], y[1]); w.y = pk2(y[2], y[3]); w.z = pk2(y[4], y[5]); w.w = pk2(y[6], y[7]);
            *(u32x4*)(CAT + (size_t)t * 1024 + col) = w;
        }
        {
            const u32x4 xa = *(const u32x4*)(ODF + (size_t)t * 512 + col), xb = *(const u32x4*)(ODB + (size_t)t * 512 + col);
            const u32x4 rw = *(const u32x4*)(R + (size_t)t * 512 + col), kw = *(const u32x4*)(KT + (size_t)t * 512 + col), vw = *(const u32x4*)(V1 + (size_t)t * 512 + col), gw_ = *(const u32x4*)(G + (size_t)t * 512 + col);
            float x[8], r[8], kt[8], v[8], g[8], sm = 0.f, bs = 0.f;
#pragma unroll
            for (int k = 0; k < 4; ++k) { x[2 * k] = bflo(xa[k]) + bflo(xb[k]); x[2 * k + 1] = bfhi(xa[k]) + bfhi(xb[k]); r[2 * k] = bflo(rw[k]); r[2 * k + 1] = bfhi(rw[k]);
                kt[2 * k] = bflo(kw[k]); kt[2 * k + 1] = bfhi(kw[k]); v[2 * k] = bflo(vw[k]); v[2 * k + 1] = bfhi(vw[k]); g[2 * k] = bflo(gw_[k]); g[2 * k + 1] = bfhi(gw_[k]); }
            const float* rk = a.in[33] + col; const float* lg = a.in[34] + col; const float* lbb = a.in[35] + col;
#pragma unroll
            for (int k = 0; k < 8; ++k) { sm += x[k]; bs += r[k] * kt[k] * rk[k]; }
            sm += __shfl_xor(sm, 1); sm += __shfl_xor(sm, 2); sm += __shfl_xor(sm, 4);
            bs += __shfl_xor(bs, 1); bs += __shfl_xor(bs, 2); bs += __shfl_xor(bs, 4);
            const float mean = sm * (1.f / 64.f); float vs = 0.f;
#pragma unroll
            for (int k = 0; k < 8; ++k) { const float d = x[k] - mean; vs += d * d; }
            vs += __shfl_xor(vs, 1); vs += __shfl_xor(vs, 2); vs += __shfl_xor(vs, 4);
            const float rs = rsqrtf(vs * (1.f / 64.f) + 64e-5f);
            float y[8];
#pragma unroll
            for (int k = 0; k < 8; ++k) y[k] = ((x[k] - mean) * rs * lg[k] + lbb[k] + bs * v[k]) * g[k];
            u32x4 w; w.x = pk2(y[0], y[1]); w.y = pk2(y[2], y[3]); w.z = pk2(y[4], y[5]); w.w = pk2(y[6], y[7]);
            *(u32x4*)(CAT + (size_t)t * 1024 + 512 + col) = w;
        }
    }
}

constexpr int LDS_BYTES = 131072, NPHASE = 21;
#ifdef DBG_USE_H
#define DBG_A5 H
#else
#define DBG_A5 (const bf16*)(ws + WS_CAT)
#endif
__global__ void __launch_bounds__(512, 2) trunk_fwd(Args a) {
    extern __shared__ __attribute__((aligned(16))) unsigned char lds[];
    cg::grid_group grid = cg::this_grid();
    unsigned char* ws = a.ws;
    const float* MOD = (const float*)(ws + WS_MOD);
    bf16* H = (bf16*)(ws + WS_H);
#ifdef ONLY_PHASE
#define PH(k) if ((k) == ONLY_PHASE)
#else
#define PH(k) if (a.ph_lo <= (k) && (k) < a.ph_hi)
#endif
#define SEAM(k) if (a.ph_lo <= (k) && (k) + 1 < a.ph_hi) grid.sync();
    PH(0) { phase0(a, lds); } SEAM(0)
    PH(1) { norm_phase<0>(a, a.in[12], 0, 0, 1024); } SEAM(1)
    PH(2) { EpiF32 E{(float*)(ws + WS_PROJ), 2304}; run_gemm(lds, H, (const bf16*)(ws + WS_EVIN), 9, 1024, 1024, 9, E); } SEAM(2)
    PH(3) { qkv_post(a, lds); } SEAM(3)
    PH(4) { attn_phase(a, lds); } SEAM(4)
#ifdef DBG_COPY_CAT
    PH(5) { const bf16* C_ = (const bf16*)(ws + WS_CAT); for (int i = blockIdx.x * 512 + opq((int)threadIdx.x); i < NTOK * 1024; i += gridDim.x * 512) {
#if DBG_COPY_CAT == 2
        const int t_ = i >> 10, c_ = i & 1023; a.out[i] = bf2f(c_ < 512 ? ((const bf16*)(ws + WS_QB))[t_ * 512 + c_] : ((const bf16*)(ws + WS_KBS))[(size_t)t_ * 96 + (c_ - 512) % 96]);
#elif DBG_COPY_CAT == 3
        const int t_ = i >> 10, c_ = i & 1023; a.out[i] = bf2f(c_ < 512 ? ((const bf16*)(ws + WS_VBTS))[t_ * 96 + c_ % 96] : ((const bf16*)(ws + WS_KBC))[(size_t)t_ * 64 + (c_ - 512) % 64]) + bf2f(((const bf16*)(ws + WS_VBTC))[(size_t)t_ * 64 + c_ % 64]);
#else
        a.out[i] = bf2f(C_[i]);
#endif
    } } SEAM(5)
#else
    PH(5) { EpiResid E{a.out, MOD + 2048, 1}; run_gemm(lds, DBG_A5, (const bf16*)(ws + WS_EVOUT), 4, 1024, 1024, 4, E); } SEAM(5)
#endif
    PH(6) { norm_phase<1>(a, a.in[13], 0, 3072, 4096); } SEAM(6)
    PH(7) { EpiBf16 E{(bf16*)(ws + WS_U), 5632}; run_gemm(lds, H, (const bf16*)(ws + WS_UP0), 22, 1024, 1024, 22, E); } SEAM(7)
    PH(8) { conv_phase(a, 0); } SEAM(8)
    PH(9) { EpiResid E{a.out, MOD + 5120, 1}; run_gemm(lds, (const bf16*)(ws + WS_ACT), (const bf16*)(ws + WS_DOWN0), 4, 2816, 2816, 4, E); } SEAM(9)
    PH(10) { norm_phase<1>(a, a.in[12] + 1024, 1, 0, 1024); } SEAM(10)
    PH(11) { EpiOdIn E{(float*)(ws + WS_HG), (bf16*)(ws + WS_PR), (const float*)(ws + WS_LB)}; run_gemm(lds, H, (const bf16*)(ws + WS_ODIN), 18, 1024, 1024, 18, E); } SEAM(11)
    PH(12) { prep1_phase(a); } SEAM(12)
    PH(13) { EpiLora E{(float*)(ws + WS_WF), (float*)(ws + WS_WB), (const bf16*)(ws + WS_KK), (const bf16*)(ws + WS_K1), (bf16*)(ws + WS_KKA), (bf16*)(ws + WS_KT), (bf16*)(ws + WS_G), a.in[26], a.in[28], a.in[32]};
             run_gemm(lds, (const bf16*)(ws + WS_AP), (const bf16*)(ws + WS_LORA), 8, 384, 384, 8, E); } SEAM(13)
    PH(14) { scan_phase(a, lds); } SEAM(14)
    PH(15) { post1_phase(a); } SEAM(15)
    PH(16) { EpiResid E{a.out, MOD + 5 * 6144 + 2048, 1}; run_gemm(lds, (const bf16*)(ws + WS_CAT2), (const bf16*)(ws + WS_ODOUT), 4, 1024, 1024, 4, E); } SEAM(16)
    PH(17) { norm_phase<1>(a, a.in[13] + 1024, 1, 3072, 4096); } SEAM(17)
    PH(18) { EpiBf16 E{(bf16*)(ws + WS_U), 5632}; run_gemm(lds, H, (const bf16*)(ws + WS_UP1), 22, 1024, 1024, 22, E); } SEAM(18)
    PH(19) { conv_phase(a, 1); } SEAM(19)
    PH(20) { EpiResid E{a.out, MOD + 5 * 6144 + 5120, 1}; run_gemm(lds, (const bf16*)(ws + WS_ACT), (const bf16*)(ws + WS_DOWN1), 4, 2816, 2816, 4, E); } SEAM(20)
    PH(21) { norm_phase<2>(a, a.in[14], 0, 0, 0); }
#undef PH
#undef SEAM
}

extern "C" void kernel_launch(void* const* d_in, const int* in_sizes, int n_in, void* d_out, int out_size, void* d_ws, size_t ws_size, hipStream_t stream) {
    static int grid = 0;
    if (grid == 0) {
        int dev = 0, cus = 0, per_cu = 0;
        if (n_in != 40 || out_size != 16777216 || ws_size < 256 * MiB) { fprintf(stderr, "kernel_launch: unexpected shapes n_in %d out %d ws %zu\n", n_in, out_size, ws_size); grid = -1; return; }
        (void)hipGetDevice(&dev); (void)hipDeviceGetAttribute(&cus, hipDeviceAttributeMultiprocessorCount, dev);
        if (hipFuncSetAttribute((const void*)trunk_fwd, hipFuncAttributeMaxDynamicSharedMemorySize, LDS_BYTES) != hipSuccess) { fprintf(stderr, "kernel_launch: hipFuncSetAttribute failed\n"); grid = -1; return; }
        if (hipOccupancyMaxActiveBlocksPerMultiprocessor(&per_cu, (const void*)trunk_fwd, 512, LDS_BYTES) != hipSuccess || per_cu < 1) { fprintf(stderr, "kernel_launch: occupancy query says %d\n", per_cu); per_cu = 1; }
        (void)hipGetLastError();
        grid = cus * (per_cu > 1 ? 1 : per_cu);
        if (grid <= 0) grid = 256;
    }
    if (grid < 0) return;
    Args a{};
    for (int i = 0; i < 40; ++i) a.in[i] = (const float*)d_in[i];
    a.out = (float*)d_out; a.ws = (unsigned char*)d_ws;
#if MK_N_LAUNCHES == 1
    a.ph_lo = 0; a.ph_hi = NPHASE + 1;
    void* args[] = {&a};
    hipError_t e = hipLaunchCooperativeKernel((const void*)trunk_fwd, dim3(grid), dim3(512), args, LDS_BYTES, stream);
    if (e != hipSuccess) fprintf(stderr, "kernel_launch: cooperative launch failed: %s (grid %d)\n", hipGetErrorString(e), grid);
#else
#ifndef RUN_UPTO
#define RUN_UPTO NPHASE
#endif
    for (int p = 0; p <= RUN_UPTO; ++p) { a.ph_lo = p; a.ph_hi = p + 1; hipLaunchKernelGGL(trunk_fwd, dim3(grid), dim3(512), LDS_BYTES, stream, a); }
#endif
}
```

```cpp
#include <hip/hip_runtime.h>
#include <hip/hip_cooperative_groups.h>
#include <cstdio>
#include <cstdint>
namespace cg = cooperative_groups;
#ifndef MK_N_LAUNCHES
#define MK_N_LAUNCHES 1
#endif
namespace pg8 {
#define PG8_LAS __attribute__((address_space(3)))
typedef unsigned short bf16_t;
typedef short bf16x8 __attribute__((ext_vector_type(8)));
typedef float f32x4 __attribute__((ext_vector_type(4)));
typedef unsigned u32x4 __attribute__((ext_vector_type(4)));
constexpr int BM = 256, BK = 64, HALF = 128, HTB = HALF * BK * 2  , STAGE_BYTES = 8 * HTB, NXCD = 8, WGM = 8;

__host__ __device__ __forceinline__ int lds_byte(int r, int c) { const int st = (r >> 4) * 2 + (c >> 5), rr = r & 15, cc = c & 31, ob = rr * 64 + cc * 2; return st * 1024 + (ob ^ (((ob >> 9) & 1) << 5)); }
__host__ __device__ __forceinline__ void stage_rc(int b, int& R, int& C) { const int st = b / 1024, sb = b % 1024, swz = sb ^ (((sb >> 9) & 1) << 5); R = (st >> 1) * 16 + swz / 64; C = (st & 1) * 32 + (swz % 64) / 2; }
__host__ __device__ __forceinline__ int perm32(int rho) { const int n = rho >> 4, i = rho & 15; return 8 * (i >> 2) + 4 * n + (i & 3); }

struct Unit { int pm, pn; };
struct Gemm { const bf16_t* A; const bf16_t* Bt; int M, N, K, ld, nNr; };

struct StaticOrder {
    int nM, nN, nwg, G, c;
    __host__ __device__ void init(int M, int N, int G_, int c_) { nM = M / BM; nN = N / BM; nwg = nM * nN; G = G_; c = c_; }
    __host__ __device__ bool next(int i, Unit& u) const {
        const long L = (long)i * G + c; if (L >= nwg) return false;
        int wgid = (int)L; { const int q = nwg / NXCD, r = nwg % NXCD, xcd = wgid % NXCD, off = wgid / NXCD; wgid = (xcd < r ? xcd * (q + 1) : r * (q + 1) + (xcd - r) * q) + off; }
        const int nig = WGM * nN, gid = wgid / nig, fm = gid * WGM, gsz = (nM - fm) < WGM ? (nM - fm) : WGM;
        u.pm = fm + ((wgid % nig) % gsz); u.pn = (wgid % nig) / gsz; return true;
    }
    __device__ __forceinline__ void a_ready(const Unit&) const {}
    __device__ __forceinline__ void done(const Unit&) const {}
};

template <class Epi, class Sched, bool STAMP = false>
__device__ __forceinline__ void gemm_phase(PG8_LAS unsigned char* lds, const Gemm g, const Sched& S, const Epi& E, unsigned long long* stamps) {
    const int tid = threadIdx.x, wid = __builtin_amdgcn_readfirstlane(tid >> 6), lane = tid & 63, wr = wid >> 2, wc = wid & 3, fr = lane & 15, fq = lane >> 4;
    const int K = g.K, nt = K / BK;
    int ts_lo = 0, ts_hi = 0, nts = 0; const unsigned long long rt_entry = 0ull;
#define PG8_STAMP() do { if (STAMP && wid == 0 && nts < 64) { const unsigned long long _c = (unsigned long long)clock64(); \
        ts_lo = (lane == nts) ? (int)(unsigned)_c : ts_lo; ts_hi = (lane == nts) ? (int)(unsigned)(_c >> 32) : ts_hi; ++nts; } } while (0)
    PG8_STAMP();
    unsigned voffA[2], voffB[2];
#pragma unroll
    for (int i = 0; i < 2; ++i) { int R, C; stage_rc(tid * 16 + i * 8192, R, C); const int Rb = Epi::PERM ? ((R & ~31) + perm32(R & 31)) : R;
        voffA[i] = (unsigned)(R * g.ld + C) * 2u; voffB[i] = (unsigned)(Rb * g.ld + C) * 2u; }
    const size_t kstep = (size_t)(BK * 2);
    const size_t hstep = (size_t)HALF * g.ld * 2;
    const size_t tstep = 2 * hstep;
    const unsigned ldsw = (unsigned)wid * 1024u;
    const int aoff = lds_byte(wr * 64 + fr, fq * 8), boff = lds_byte(wc * 32 + fr, fq * 8);
#define PG8_SA(b, h) (((b) * 2 + (h)) * HTB)
#define PG8_SB(b, h) ((4 + (b) * 2 + (h)) * HTB)
#define PG8_STAGE(bufoff, gbase, voff) do { _Pragma("unroll") for (int _i = 0; _i < 2; ++_i) \
        __builtin_amdgcn_global_load_lds((const unsigned*)((const char*)(gbase) + (voff)[_i]), (PG8_LAS unsigned*)(lds + (bufoff) + ldsw + _i * 8192), 16, 0, 0); } while (0)
#define PG8_LDA(dst, b, h) do { _Pragma("unroll") for (int m = 0; m < 4; ++m) _Pragma("unroll") for (int k = 0; k < 2; ++k) dst[m][k] = *(const PG8_LAS bf16x8*)(lds + PG8_SA(b, h) + aoff + m * 2048 + k * 1024); } while (0)
#define PG8_LDB(dst, b, h) do { _Pragma("unroll") for (int n = 0; n < 2; ++n) _Pragma("unroll") for (int k = 0; k < 2; ++k) dst[n][k] = *(const PG8_LAS bf16x8*)(lds + PG8_SB(b, h) + boff + n * 2048 + k * 1024); } while (0)
#define PG8_MMA(ai, bj, At, Bt) do { __builtin_amdgcn_s_setprio(1); _Pragma("unroll") for (int m = 0; m < 4; ++m) _Pragma("unroll") for (int n = 0; n < 2; ++n) _Pragma("unroll") for (int k = 0; k < 2; ++k) \
        acc[ai][bj][m][n] = __builtin_amdgcn_mfma_f32_16x16x32_bf16(Bt[n][k], At[m][k], acc[ai][bj][m][n], 0, 0, 0); __builtin_amdgcn_s_setprio(0); } while (0)
#define PG8_WAIT_V(n) asm volatile("s_waitcnt vmcnt(" #n ")" ::: "memory")
#define PG8_WAIT_L(n) asm volatile("s_waitcnt lgkmcnt(" #n ")" ::: "memory")
#define PG8_BAR __builtin_amdgcn_s_barrier()
#define PG8_SCHED __builtin_amdgcn_sched_barrier(0)
    Unit cur, nxt; int ui = 0;
    if (!S.next(0, cur)) return;
    f32x4 acc[2][2][4][2];
#pragma unroll
    for (int a = 0; a < 2; ++a)
#pragma unroll
        for (int b = 0; b < 2; ++b)
#pragma unroll
            for (int m = 0; m < 4; ++m)
#pragma unroll
                for (int n = 0; n < 2; ++n) acc[a][b][m][n] = (f32x4){0.f, 0.f, 0.f, 0.f};
    bf16x8 At[4][2], B0[2][2], B1[2][2];
    const char* cA = (const char*)g.A + (size_t)cur.pm * tstep + (size_t)(cur.pn / g.nNr) * K * 2; const char* cB = (const char*)g.Bt + (size_t)(cur.pn % g.nNr) * tstep + (size_t)(cur.pn / g.nNr) * K * 2;
    S.a_ready(cur);
    PG8_STAGE(PG8_SB(0, 0), cB, voffB); PG8_STAGE(PG8_SA(0, 0), cA, voffA); PG8_STAGE(PG8_SB(0, 1), cB + hstep, voffB); PG8_STAGE(PG8_SA(0, 1), cA + hstep, voffA);
    if (wr == 1) PG8_BAR;
    PG8_WAIT_V(4); PG8_BAR;
    PG8_STAGE(PG8_SB(1, 0), cB + kstep, voffB); PG8_STAGE(PG8_SA(1, 0), cA + kstep, voffA); PG8_STAGE(PG8_SB(1, 1), cB + hstep + kstep, voffB);
    PG8_WAIT_V(6); PG8_BAR;
    PG8_STAMP();
    for (;;) {
        const bool has_next = S.next(ui + 1, nxt);
        const char* nA = has_next ? (const char*)g.A + (size_t)nxt.pm * tstep + (size_t)(nxt.pn / g.nNr) * K * 2 : cA; const char* nB = has_next ? (const char*)g.Bt + (size_t)(nxt.pn % g.nNr) * tstep + (size_t)(nxt.pn / g.nNr) * K * 2 : cB;
        for (int t = 0; t < nt; t += 2) {
            const bool last = (t == nt - 2);
            const char* a1 = cA + (size_t)(t + 1) * kstep;
            const char* a2 = last ? nA : cA + (size_t)(t + 2) * kstep; const char* b2 = last ? nB : cB + (size_t)(t + 2) * kstep;
            const char* a3 = a2 + kstep; const char* b3 = b2 + kstep;
            if (last && has_next) S.a_ready(nxt);
            PG8_LDB(B0, 0, 0); PG8_SCHED; PG8_LDA(At, 0, 0); PG8_STAGE(PG8_SA(1, 1), a1 + hstep, voffA);
            PG8_WAIT_L(8); PG8_BAR; PG8_WAIT_L(0); PG8_MMA(0, 0, At, B0); PG8_BAR; PG8_SCHED;
            PG8_LDB(B1, 0, 1); PG8_STAGE(PG8_SB(0, 0), b2, voffB);
            PG8_BAR; PG8_WAIT_L(0); PG8_MMA(0, 1, At, B1); PG8_BAR;
            PG8_LDA(At, 0, 1); PG8_STAGE(PG8_SA(0, 0), a2, voffA);
            PG8_BAR; PG8_WAIT_L(0); PG8_MMA(1, 0, At, B0); PG8_BAR; PG8_SCHED;
            PG8_STAGE(PG8_SB(0, 1), b2 + hstep, voffB);
            PG8_WAIT_V(6); PG8_BAR; PG8_MMA(1, 1, At, B1); PG8_BAR;
            PG8_LDB(B0, 1, 0); PG8_SCHED; PG8_LDA(At, 1, 0); PG8_STAGE(PG8_SA(0, 1), a2 + hstep, voffA);
            PG8_WAIT_L(8); PG8_BAR; PG8_WAIT_L(0); PG8_MMA(0, 0, At, B0); PG8_BAR; PG8_SCHED;
            PG8_LDB(B1, 1, 1); PG8_STAGE(PG8_SB(1, 0), b3, voffB);
            PG8_BAR; PG8_WAIT_L(0); PG8_MMA(0, 1, At, B1); PG8_BAR;
            PG8_LDA(At, 1, 1); PG8_STAGE(PG8_SA(1, 0), a3, voffA);
            PG8_BAR; PG8_WAIT_L(0); PG8_MMA(1, 0, At, B0); PG8_BAR; PG8_SCHED;
            PG8_STAGE(PG8_SB(1, 1), b3 + hstep, voffB);
            PG8_WAIT_V(6); PG8_BAR; PG8_MMA(1, 1, At, B1); PG8_BAR;
        }
        PG8_STAMP();
        if constexpr (!Epi::AFTER_DRAIN) { E(acc, cur, wr, wc, fr, fq); S.done(cur); }
        PG8_STAMP();
        if (!has_next) break;
#pragma unroll
        for (int a = 0; a < 2; ++a)
#pragma unroll
            for (int b = 0; b < 2; ++b)
#pragma unroll
                for (int m = 0; m < 4; ++m)
#pragma unroll
                    for (int n = 0; n < 2; ++n) acc[a][b][m][n] = (f32x4){0.f, 0.f, 0.f, 0.f};
        cur = nxt; cA = nA; cB = nB; ++ui;
    }
    PG8_WAIT_V(0);
    if (wr == 0) PG8_BAR;
    PG8_BAR;
    if constexpr (Epi::AFTER_DRAIN) { E.fused(acc, cur, wr, wc, fr, fq, lds, wid, lane); S.done(cur); }
    PG8_STAMP();
    if (STAMP && wid == 0) { stamps[lane] = lane < nts ? (((unsigned long long)(unsigned)ts_hi << 32) | (unsigned)ts_lo) : 0ull;
        if (lane == 62) stamps[62] = rt_entry; }
#undef PG8_STAMP
#undef PG8_SA
#undef PG8_SB
#undef PG8_STAGE
#undef PG8_LDA
#undef PG8_LDB
#undef PG8_MMA
#undef PG8_WAIT_V
#undef PG8_WAIT_L
#undef PG8_BAR
#undef PG8_SCHED
}
}

using pg8::f32x4; using pg8::bf16x8;
typedef unsigned short bf16;
typedef unsigned u32x4 __attribute__((ext_vector_type(4)));
typedef unsigned u32x2 __attribute__((ext_vector_type(2)));
typedef float f32x2 __attribute__((ext_vector_type(2)));

constexpr size_t MiB = 1ull << 20;
constexpr int NTOK = 8192, NCTX = 4096, DM = 1024, DFF = 2816;
constexpr size_t WS_MOD = 0, WS_LAM = 256 * 1024, WS_LB = 256 * 1024 + 256, WS_QCTR = 256 * 1024 + 8192;
constexpr size_t WS_ODIN = 1 * MiB, WS_ODOUT = 10 * MiB, WS_UP1 = 12 * MiB, WS_DOWN1 = 23 * MiB, WS_LORA = 28 * MiB + 512 * 1024;
constexpr size_t WS_EVIN = 30 * MiB, WS_EVOUT = 34 * MiB + 512 * 1024, WS_UP0 = 36 * MiB + 512 * 1024, WS_DOWN0 = 47 * MiB + 512 * 1024;
constexpr size_t WS_H = 53 * MiB;
constexpr size_t WS_PROJ = 69 * MiB, WS_QA = 141 * MiB, WS_QB = 149 * MiB, WS_KAC = 157 * MiB, WS_VATC = 161 * MiB, WS_KBC = 165 * MiB, WS_VBTC = 166 * MiB,
                 WS_KAS = 167 * MiB, WS_VATS = 173 * MiB, WS_KBS = 179 * MiB, WS_VBTS = 180 * MiB + 512 * 1024, WS_CAT = 182 * MiB;
constexpr size_t WS_U = 69 * MiB, WS_ACT = 157 * MiB, WS_TMP = 69 * MiB;
constexpr size_t WS_KK = 53 * MiB, WS_KKA = 61 * MiB, WS_HG = 69 * MiB, WS_PR = 149 * MiB, WS_K1 = 178 * MiB,
                 WS_OCF = 149 * MiB, WS_OCB = 157 * MiB, WS_ODF = 165 * MiB, WS_ODB = 173 * MiB,
                 WS_KT = 186 * MiB, WS_WF = 194 * MiB, WS_WB = 210 * MiB, WS_G = 226 * MiB, WS_CAT2 = 234 * MiB,
                 WS_R = 30 * MiB, WS_V1 = 38 * MiB, WS_AP = 46 * MiB;
constexpr size_t O_AK = 8388608, O_AV = 10485760, O_BK = 12582912, O_BV = 13107200, O_SH = 13631488, O_SR = 15728640;

struct Args { const float* in[40]; float* out; unsigned char* ws; int ph_lo, ph_hi; };

typedef __bf16 bf16x2_t __attribute__((ext_vector_type(2)));
__device__ __forceinline__ unsigned pk2(float lo, float hi) { f32x2 v = {lo, hi}; bf16x2_t r = __builtin_convertvector(v, bf16x2_t); return __builtin_bit_cast(unsigned, r); }
__device__ __forceinline__ float bflo(unsigned w) { return __uint_as_float(w << 16); }
__device__ __forceinline__ float bfhi(unsigned w) { return __uint_as_float(w & 0xffff0000u); }
__device__ __forceinline__ float bf2f(bf16 b) { return __uint_as_float(((unsigned)b) << 16); }
__device__ __forceinline__ bf16 f2bf(float f) { return (bf16)(pk2(f, 0.f) & 0xffffu); }
__device__ __forceinline__ float sigm(float x) { return 1.f / (1.f + __expf(-x)); }
__device__ __forceinline__ float silu(float x) { return x / (1.f + __expf(-x)); }
__device__ __forceinline__ float wave_sum(float v) {
#pragma unroll
    for (int o = 1; o < 64; o <<= 1) v += __shfl_xor(v, o);
    return v;
}
__device__ __forceinline__ int cond_of(int t) { return t < NCTX ? 0 : 1 + ((t - NCTX) >> 10); }
__device__ __forceinline__ int opq(int x) { asm volatile("" : "+v"(x)); return x; }
#define LDSWAIT() asm volatile("s_waitcnt lgkmcnt(0)" ::: "memory")

__device__ __forceinline__ void tr_item(const float* W, int ldw, bf16* WT, int ldo, float* scr, int lane) {
#pragma unroll 8
    for (int i = 0; i < 32; ++i) { const int kk = 2 * i + (lane >> 5); scr[kk * 33 + (lane & 31)] = W[(size_t)kk * ldw + (lane & 31)]; }
    LDSWAIT();
    const int c = lane & 7;
#pragma unroll
    for (int j = 0; j < 4; ++j) { const int n = (lane >> 3) + 8 * j; const float* s = scr + (8 * c) * 33 + n;
        u32x4 o; o.x = pk2(s[0 * 33], s[1 * 33]); o.y = pk2(s[2 * 33], s[3 * 33]); o.z = pk2(s[4 * 33], s[5 * 33]); o.w = pk2(s[6 * 33], s[7 * 33]);
        *(u32x4*)(WT + (size_t)n * ldo + 8 * c) = o; }
    LDSWAIT();
}
__device__ __forceinline__ void tr_mat(const float* W, int N, bf16* WT, int ldo, int r, float* scr, int lane) {
    const int nblk = N / 32, kb = r / nblk, nb = r % nblk;
    tr_item(W + (size_t)kb * 64 * N + nb * 32, N, WT + (size_t)nb * 32 * ldo + kb * 64, ldo, scr, lane);
}

__device__ __forceinline__ void tr_range(const Args& a, unsigned char* ldsbase, int lo, int hi, int w, int nw) {
    unsigned char* ws = a.ws; const int lane = opq((int)threadIdx.x) & 63, wave = opq((int)threadIdx.x) >> 6;
    float* scr = (float*)(ldsbase + wave * 8448);
    constexpr int I_EVIN = 16 * 72, I_EVOUT = 16 * 32, I_UP = 16 * 176, I_DOWN = 44 * 32, I_ODIN = 16 * 138, I_ODOUT = 16 * 32, I_CAV = 16 * 32;
    for (int it = lo + w; it < hi; it += nw) {
        int r = it;
        if (r < I_EVIN) { tr_mat(a.in[15], 2304, (bf16*)(ws + WS_EVIN), 1024, r, scr, lane); continue; } r -= I_EVIN;
        if (r < I_EVOUT) { tr_mat(a.in[16], 1024, (bf16*)(ws + WS_EVOUT), 1024, r, scr, lane); continue; } r -= I_EVOUT;
        if (r < I_UP) { tr_mat(a.in[36], 5632, (bf16*)(ws + WS_UP0), 1024, r, scr, lane); continue; } r -= I_UP;
        if (r < I_UP) { tr_mat(a.in[36] + (size_t)1024 * 5632, 5632, (bf16*)(ws + WS_UP1), 1024, r, scr, lane); continue; } r -= I_UP;
        if (r < I_DOWN) { tr_mat(a.in[39], 1024, (bf16*)(ws + WS_DOWN0), 2816, r, scr, lane); continue; } r -= I_DOWN;
        if (r < I_DOWN) { tr_mat(a.in[39] + (size_t)2816 * 1024, 1024, (bf16*)(ws + WS_DOWN1), 2816, r, scr, lane); continue; } r -= I_DOWN;
        if (r < I_ODIN) { tr_mat(a.in[21], 4416, (bf16*)(ws + WS_ODIN), 1024, r, scr, lane); continue; } r -= I_ODIN;
        if (r < I_ODOUT) { tr_mat(a.in[22], 1024, (bf16*)(ws + WS_ODOUT), 1024, r, scr, lane); continue; } r -= I_ODOUT;
        if (r < I_CAV) { const int bh = r / 32, rr = r % 32; tr_mat(a.in[3] + (size_t)bh * 512 * 128, 128, (bf16*)(ws + WS_VATS) + (size_t)bh * 128 * 1536, 1536, rr, scr, lane); continue; } r -= I_CAV;
        { const int bg = r / 16, rr = r % 16; tr_mat(a.in[5] + (size_t)bg * 512 * 64, 64, (bf16*)(ws + WS_VBTS) + (size_t)bg * 64 * 1536, 1536, rr, scr, lane); }
    }
}
__device__ __forceinline__ void fill_l1_small(const Args& a, int t, int nt) {
    unsigned char* ws = a.ws;
    u32x4* z = (u32x4*)((bf16*)(ws + WS_ODIN) + (size_t)4416 * 1024);
    for (int i = t; i < 192 * 1024 / 8; i += nt) z[i] = (u32x4){0u, 0u, 0u, 0u};
    bf16* L = (bf16*)(ws + WS_LORA);
    for (int i = t; i < 2048 * 384; i += nt) { const int n = i / 384, k = i % 384; float v = 0.f;
        if (n < 512) { if (k < 64) v = a.in[27][(size_t)k * 512 + n]; }
        else if (n < 1024) { if (k >= 64 && k < 128) v = a.in[27][(size_t)(64 + (k - 64)) * 512 + (n - 512)]; }
        else if (n < 1536) { if (k >= 128 && k < 192) v = a.in[29][(size_t)(k - 128) * 512 + (n - 1024)]; }
        else { if (k >= 192 && k < 320) v = a.in[30][(size_t)(k - 192) * 512 + (n - 1536)]; }
        L[i] = f2bf(v); }
}

__device__ __forceinline__ void phase0(const Args& a, unsigned char* lds) {
    const int tid = opq((int)threadIdx.x), lane = tid & 63, wave = tid >> 6;
    const int gw = blockIdx.x * 8 + wave, NGW = gridDim.x * 8, gt = blockIdx.x * 512 + tid, NGT = gridDim.x * 512;
    unsigned char* ws = a.ws;
    {
        float* cs = (float*)lds;
        float* red = cs + 5120;
        float* MOD = (float*)(ws + WS_MOD);
        if (blockIdx.x < 384) {
            for (int i = tid; i < 5120; i += 512) { const int cb = i >> 10, k = i & 1023; const float x = cb == 0 ? a.in[9][k] : a.in[8][(cb - 1) * 1024 + k]; cs[i] = silu(x); }
        }
        __syncthreads();
        for (int it = blockIdx.x; it < 768; it += gridDim.x) {
            const int l = it / 384, cgp = it % 384, col = cgp * 16 + (lane & 15), kp = wave * 4 + (lane >> 4);
            const float* W = a.in[10] + (size_t)l * 1024 * 6144 + col;
            float acc0 = 0.f, acc1 = 0.f, acc2 = 0.f, acc3 = 0.f, acc4 = 0.f;
#pragma unroll 8
            for (int kk = 0; kk < 32; ++kk) { const int k = kp * 32 + kk; const float w = W[(size_t)k * 6144];
                acc0 += cs[k] * w; acc1 += cs[1024 + k] * w; acc2 += cs[2048 + k] * w; acc3 += cs[3072 + k] * w; acc4 += cs[4096 + k] * w; }
            red[(kp * 5 + 0) * 16 + (lane & 15)] = acc0; red[(kp * 5 + 1) * 16 + (lane & 15)] = acc1; red[(kp * 5 + 2) * 16 + (lane & 15)] = acc2;
            red[(kp * 5 + 3) * 16 + (lane & 15)] = acc3; red[(kp * 5 + 4) * 16 + (lane & 15)] = acc4;
            __syncthreads();
            if (tid < 80) { const int cb = tid >> 4, c = tid & 15; float s = 0.f;
#pragma unroll
                for (int p = 0; p < 32; ++p) s += red[(p * 5 + cb) * 16 + c];
                MOD[(size_t)(l * 5 + cb) * 6144 + cgp * 16 + c] = s + a.in[11][l * 6144 + cgp * 16 + c]; }
            __syncthreads();
        }
    }
    tr_range(a, lds + 32768, 0, 1664, gw, NGW);
    tr_range(a, lds + 32768, 12832, 13472, gw, NGW);
    {
        const f32x4* s = (const f32x4*)a.in[2]; bf16* KA = (bf16*)(ws + WS_KAS);
        for (int i = gt; i < 4 * 4 * 512 * 128 / 4; i += NGT) { const int e0 = i * 4, bh = e0 >> 16, rem = e0 & 65535; const f32x4 v = s[i];
            u32x2 o; o.x = pk2(v.x, v.y); o.y = pk2(v.z, v.w); *(u32x2*)(KA + (size_t)bh * 1536 * 128 + rem) = o; }
        const f32x4* s2 = (const f32x4*)a.in[4]; bf16* KB = (bf16*)(ws + WS_KBS);
        for (int i = gt; i < 4 * 2 * 512 * 64 / 4; i += NGT) { const int e0 = i * 4, bg = e0 >> 15, rem = e0 & 32767; const f32x4 v = s2[i];
            u32x2 o; o.x = pk2(v.x, v.y); o.y = pk2(v.z, v.w); *(u32x2*)(KB + (size_t)bg * 1536 * 64 + rem) = o; }
    }
#if defined(RUN_UPTO) && RUN_UPTO < 14
    for (int i = gt; i < 3145728; i += NGT) a.out[O_SH + i] = 0.f;
#endif
    if (blockIdx.x == 0) {
        if (wave == 0) {
            const float* L = a.in[17];
            const float s1 = wave_sum(L[lane] * L[64 + lane]), s2 = wave_sum(L[128 + lane] * L[192 + lane]);
            if (lane == 0) { *(float*)(ws + WS_LAM) = __expf(s1) - __expf(s2) + 0.2f; ((unsigned*)(ws + WS_QCTR))[0] = 0u; ((unsigned*)(ws + WS_QCTR))[1] = 0u; }
        }
        float* LB = (float*)(ws + WS_LB);
        for (int i = tid; i < 1024; i += 512) { const int dr = i >> 9, c = i & 511; const float l0 = a.in[23][(dr * 2 + 0) * 512 + c], l1 = a.in[23][(dr * 2 + 1) * 512 + c];
            const float m = fmaxf(l0, l1), e0 = __expf(l0 - m), e1 = __expf(l1 - m), s0 = e0 / (e0 + e1), s1 = e1 / (e0 + e1); LB[i] = (s0 + s1) - s0; }
    }
}

template <int MODE, bool TMPF>
__device__ __forceinline__ void norm_phase(const Args& a, const float* g, int l, int shoff, int scoff) {
    const int lane = opq((int)threadIdx.x) & 63, wave = opq((int)threadIdx.x) >> 6, gw = blockIdx.x * 8 + wave, NGW = gridDim.x * 8;
    float* X = a.out; bf16* H = (bf16*)(a.ws + WS_H); const float* MOD = (const float*)(a.ws + WS_MOD) + (size_t)l * 5 * 6144;
    f32x4 gg[4];
#pragma unroll
    for (int j = 0; j < 4; ++j) gg[j] = *(const f32x4*)(g + 256 * j + lane * 4);
    for (int tb = gw; tb < NTOK / 4; tb += NGW) {
        f32x4 v[4][4]; float ss[4];
#pragma unroll
        for (int r = 0; r < 4; ++r) { const int t = tb * 4 + r;
            const float* src = MODE == 0 ? (t < NCTX ? a.in[0] + (size_t)t * DM : a.in[1] + (size_t)(t - NCTX) * DM) : X + (size_t)t * DM;
#pragma unroll
            for (int j = 0; j < 4; ++j) { v[r][j] = *(const f32x4*)(src + 256 * j + lane * 4);
                if (TMPF) v[r][j] += *(const f32x4*)((const float*)(a.ws + WS_TMP) + (size_t)t * DM + 256 * j + lane * 4); } }
#pragma unroll
        for (int r = 0; r < 4; ++r) { float q = 0.f;
#pragma unroll
            for (int j = 0; j < 4; ++j) q += (v[r][j].x * v[r][j].x + v[r][j].y * v[r][j].y) + (v[r][j].z * v[r][j].z + v[r][j].w * v[r][j].w);
            ss[r] = q; }
#pragma unroll
        for (int o = 1; o < 64; o <<= 1) {
#pragma unroll
            for (int r = 0; r < 4; ++r) ss[r] += __shfl_xor(ss[r], o); }
        const float* md = MOD + (size_t)cond_of(tb * 4) * 6144;
#pragma unroll
        for (int r = 0; r < 4; ++r) { const int t = tb * 4 + r; const float rstd = rsqrtf(ss[r] * (1.f / DM) + 1e-6f);
#pragma unroll
            for (int j = 0; j < 4; ++j) { const int col = 256 * j + lane * 4;
                if (MODE == 2) { *(f32x4*)(X + (size_t)t * DM + col) = v[r][j] * rstd * gg[j]; }
                else { const f32x4 sc = *(const f32x4*)(md + scoff + col), sh = *(const f32x4*)(md + shoff + col);
                    const f32x4 h = (v[r][j] * rstd * gg[j]) * (sc + 1.f) + sh;
                    u32x2 o; o.x = pk2(h.x, h.y); o.y = pk2(h.z, h.w); *(u32x2*)(H + (size_t)t * DM + col) = o;
                    if (TMPF) *(f32x4*)(X + (size_t)t * DM + col) = v[r][j]; } } }
    }
}

#define EPI_LOOP(...) \
    _Pragma("unroll") for (int ai = 0; ai < 2; ++ai) _Pragma("unroll") for (int m = 0; m < 4; ++m) { const int row = u.pm * 256 + ai * 128 + wr * 64 + m * 16 + fr; \
    _Pragma("unroll") for (int bj = 0; bj < 2; ++bj) _Pragma("unroll") for (int n = 0; n < 2; ++n) { const int cl = bj * 128 + wc * 32 + n * 16 + 4 * fq; const f32x4 v = acc[ai][bj][m][n]; __VA_ARGS__ } asm volatile("" ::: "memory"); }

struct EpiF32 {
    static constexpr bool PERM = false, AFTER_DRAIN = false;
    float* C; int ldc;
    __device__ __forceinline__ void operator()(const f32x4 (&acc)[2][2][4][2], const pg8::Unit& u, int wr, int wc, int fr, int fq) const {
        EPI_LOOP({ *(f32x4*)(C + (size_t)row * ldc + u.pn * 256 + cl) = v; })
    }
};
struct EpiBf16 {
    static constexpr bool PERM = false, AFTER_DRAIN = false;
    bf16* O; int ldc;
    __device__ __forceinline__ void operator()(const f32x4 (&acc)[2][2][4][2], const pg8::Unit& u, int wr, int wc, int fr, int fq) const {
        EPI_LOOP({ u32x2 o; o.x = pk2(v.x, v.y); o.y = pk2(v.z, v.w); *(u32x2*)(O + (size_t)row * ldc + u.pn * 256 + cl) = o; })
    }
};
struct EpiResid {
    static constexpr bool PERM = false, AFTER_DRAIN = false;
    float* X; const float* gate; float* TMP; const float* B0; const float* B1;
    __device__ __forceinline__ void operator()(const f32x4 (&acc)[2][2][4][2], const pg8::Unit& u, int wr, int wc, int fr, int fq) const {
        const float* gt_ = gate + (size_t)cond_of(u.pm * 256) * 6144; const int pn = u.pn & 3;
        const float* rb_ = u.pm < 16 ? B0 : B1 - (size_t)NCTX * DM;
        EPI_LOOP({ const int col = pn * 256 + cl; const f32x4 gg = *(const f32x4*)(gt_ + col); float* p = X + (size_t)row * DM + col;
            if (u.pn < 4) { const f32x4 x = *(const f32x4*)(rb_ + (size_t)row * DM + col); *(f32x4*)p = x + gg * v; }
            else { *(f32x4*)(TMP + (size_t)row * DM + col) = gg * v; } })
    }
};
struct EpiOdIn {
    static constexpr bool PERM = false, AFTER_DRAIN = false;
    float* HG; bf16* PR; const float* LB;
    __device__ __forceinline__ void operator()(const f32x4 (&acc)[2][2][4][2], const pg8::Unit& u, int wr, int wc, int fr, int fq) const {
        const int pn = u.pn;
        if (pn < 10) { const int kind = pn >> 1;
            EPI_LOOP({ const int col = pn * 256 + cl; f32x4 o = v;
                if (kind == 0) { o.x = silu(v.x); o.y = silu(v.y); o.z = silu(v.z); o.w = silu(v.w); }
                else if (kind <= 2) { const f32x4 lb = *(const f32x4*)(LB + (col - 512));
                    o.x = lb.x + (1.f - lb.x) * sigm(v.x); o.y = lb.y + (1.f - lb.y) * sigm(v.y); o.z = lb.z + (1.f - lb.z) * sigm(v.z); o.w = lb.w + (1.f - lb.w) * sigm(v.w); }
                *(f32x4*)(HG + (size_t)row * 2560 + col) = o; })
        } else {
            EPI_LOOP({ const int col = (pn - 10) * 256 + cl; if (col < 1856) { u32x2 o; o.x = pk2(v.x, v.y); o.y = pk2(v.z, v.w); *(u32x2*)(PR + (size_t)row * 1856 + col) = o; } })
        }
    }
};
struct EpiLora {
    static constexpr bool PERM = false, AFTER_DRAIN = false;
    float* WF; float* WB; const bf16* KK; const bf16* K1; bf16* KKA; bf16* KT; bf16* G; const float* w0; const float* a0; const float* k_a;
    __device__ __forceinline__ void operator()(const f32x4 (&acc)[2][2][4][2], const pg8::Unit& u, int wr, int wc, int fr, int fq) const {
        const int pn = u.pn, kind = pn >> 1;
        if (kind <= 1) { float* W = kind == 0 ? WF : WB;
            EPI_LOOP({ const int c = (pn & 1) * 256 + cl; const f32x4 z0 = *(const f32x4*)(w0 + kind * 512 + c); f32x4 o;
                o.x = __expf(-0.60653066f * sigm(v.x + z0.x)); o.y = __expf(-0.60653066f * sigm(v.y + z0.y)); o.z = __expf(-0.60653066f * sigm(v.z + z0.z)); o.w = __expf(-0.60653066f * sigm(v.w + z0.w));
                *(f32x4*)(W + (size_t)row * 512 + c) = o; })
        } else if (kind == 2) {
            EPI_LOOP({ const int c = (pn & 1) * 256 + cl; const f32x4 z0 = *(const f32x4*)(a0 + c), ka = *(const f32x4*)(k_a + c);
                const u32x2 kkw = *(const u32x2*)(KK + (size_t)row * 512 + c), k1w = *(const u32x2*)(K1 + (size_t)row * 512 + c);
                const float a0_ = sigm(v.x + z0.x), a1_ = sigm(v.y + z0.y), a2_ = sigm(v.z + z0.z), a3_ = sigm(v.w + z0.w);
                u32x2 o1; o1.x = pk2(bflo(kkw.x) * a0_, bfhi(kkw.x) * a1_); o1.y = pk2(bflo(kkw.y) * a2_, bfhi(kkw.y) * a3_);
                u32x2 o2; o2.x = pk2(bflo(k1w.x) * (1.f + (a0_ - 1.f) * ka.x), bfhi(k1w.x) * (1.f + (a1_ - 1.f) * ka.y)); o2.y = pk2(bflo(k1w.y) * (1.f + (a2_ - 1.f) * ka.z), bfhi(k1w.y) * (1.f + (a3_ - 1.f) * ka.w));
                *(u32x2*)(KKA + (size_t)row * 512 + c) = o1; *(u32x2*)(KT + (size_t)row * 512 + c) = o2; })
        } else {
            EPI_LOOP({ const int c = (pn & 1) * 256 + cl; u32x2 o; o.x = pk2(v.x, v.y); o.y = pk2(v.z, v.w); *(u32x2*)(G + (size_t)row * 512 + c) = o; })
        }
    }
};
template <class Epi>
__device__ __forceinline__ void run_gemm(unsigned char* lds, const bf16* A, const bf16* Bt, int Nunits256, int K, int ld, int nNr, const Epi& E) {
    pg8::Gemm g{A, Bt, NTOK, Nunits256 * 256, K, ld, nNr};
    pg8::StaticOrder S; S.init(NTOK, Nunits256 * 256, (int)gridDim.x, (int)blockIdx.x);
    pg8::gemm_phase<Epi, pg8::StaticOrder, false>((PG8_LAS unsigned char*)lds, g, S, E, nullptr);
}

__device__ __forceinline__ void rope4(f32x4& v, const float (&cs)[4], const float (&sn)[4], int lane) {
    float p[4], o[4]; const float x[4] = {v.x, v.y, v.z, v.w};
#pragma unroll
    for (int j = 0; j < 4; ++j) p[j] = __shfl_xor(x[j], 4);
#pragma unroll
    for (int j = 0; j < 4; ++j) o[j] = (lane & 4) ? (p[j] * sn[j] + x[j] * cs[j]) : (x[j] * cs[j] - p[j] * sn[j]);
    v = (f32x4){o[0], o[1], o[2], o[3]};
}
__device__ __forceinline__ void qkv_post(const Args& a, unsigned char* lds) {
    const int tid = opq((int)threadIdx.x), lane = tid & 63, wave = tid >> 6, gw = blockIdx.x * 8 + wave, NGW = gridDim.x * 8;
    unsigned char* ws = a.ws; const float* PROJ = (const float*)(ws + WS_PROJ);
    bf16* QA = (bf16*)(ws + WS_QA); bf16* QB = (bf16*)(ws + WS_QB);
    for (int t = gw; t < NTOK; t += NGW) {
        const float* row = PROJ + (size_t)t * 2304;
        const bool smp = t >= NCTX; const int b = smp ? ((t - NCTX) >> 10) : (t >> 8), s = smp ? ((t - NCTX) & 1023) : (t & 255);
        const int T = smp ? 1536 : 256, tpos = smp ? 512 + s : s;
        float cs[4], sn[4];
        { const float pos = (float)((lane & 8) ? (s & 63) : (s >> 6));
#pragma unroll
          for (int j = 0; j < 4; ++j) { const float fr_ = __expf(-(float)(4 * (lane & 3) + j) * (9.210340372f / 16.f)); const float ang = pos * fr_; cs[j] = __cosf(ang); sn[j] = __sinf(ang); } }
        const int hh = lane >> 4, cc4 = (lane & 15) * 4;
#pragma unroll
        for (int c = 0; c < 9; ++c) {
            f32x4 v = *(const f32x4*)(row + c * 256 + lane * 4);
            if (c < 2) {
                if (smp) rope4(v, cs, sn, lane);
                v = v * 0.18033688f; u32x2 o; o.x = pk2(v.x, v.y); o.y = pk2(v.z, v.w); *(u32x2*)(QA + (size_t)t * 512 + c * 256 + lane * 4) = o;
            } else if (c < 4) {
                if (smp) rope4(v, cs, sn, lane);
                const int col = (c - 2) * 256 + lane * 4, h = col >> 7, cc = col & 127;
                bf16* KA = (bf16*)(ws + (smp ? WS_KAS : WS_KAC));
                u32x2 o; o.x = pk2(v.x, v.y); o.y = pk2(v.z, v.w); *(u32x2*)(KA + ((size_t)(b * 4 + h) * T + tpos) * 128 + cc) = o;
                if (!smp) *(f32x4*)(a.out + O_AK + ((size_t)(b * 4 + h) * 256 + s) * 128 + cc) = v;
            } else if (c < 6) {
                const int col = (c - 4) * 256 + lane * 4, h = col >> 7, cc = col & 127;
                if (!smp) *(f32x4*)(a.out + O_AV + ((size_t)(b * 4 + h) * 256 + s) * 128 + cc) = v;
            } else {
                float ss = (v.x * v.x + v.y * v.y) + (v.z * v.z + v.w * v.w);
                ss += __shfl_xor(ss, 1); ss += __shfl_xor(ss, 2); ss += __shfl_xor(ss, 4); ss += __shfl_xor(ss, 8);
                const float rs = rsqrtf(ss * (1.f / 64.f) + 1e-6f);
                const f32x4 gg = *(const f32x4*)((c < 8 ? a.in[19] : a.in[20]) + cc4);
                f32x4 nv = v * rs * gg;
                if (smp) rope4(nv, cs, sn, lane);
                if (c < 8) { nv = nv * 0.18033688f; u32x2 o; o.x = pk2(nv.x, nv.y); o.y = pk2(nv.z, nv.w); *(u32x2*)(QB + (size_t)t * 512 + (c - 6) * 256 + lane * 4) = o; }
                else if (hh < 2) {
                    bf16* KB = (bf16*)(ws + (smp ? WS_KBS : WS_KBC));
                    u32x2 o; o.x = pk2(nv.x, nv.y); o.y = pk2(nv.z, nv.w); *(u32x2*)(KB + ((size_t)(b * 2 + hh) * T + tpos) * 64 + cc4) = o;
                    if (!smp) *(f32x4*)(a.out + O_BK + ((size_t)(b * 2 + hh) * 256 + s) * 64 + cc4) = nv;
                } else {
                    if (!smp) *(f32x4*)(a.out + O_BV + ((size_t)(b * 2 + (hh - 2)) * 256 + s) * 64 + cc4) = v;
                }
            }
        }
    }
    float* scr = (float*)(lds + wave * 8448);
    for (int it = gw; it < 128 * 20; it += NGW) {
        const int tb = it / 20, nb = it % 20; const bool smp = tb >= 64;
        const int b = smp ? ((tb - 64) >> 4) : (tb >> 2), s0 = smp ? ((tb - 64) & 15) * 64 : (tb & 3) * 64, T = smp ? 1536 : 256, tpos = smp ? 512 + s0 : s0;
        if (nb < 16) { const int h = nb >> 2, e0 = (nb & 3) * 32;
            bf16* dst = (bf16*)(ws + (smp ? WS_VATS : WS_VATC)) + ((size_t)(b * 4 + h) * 128 + e0) * T + tpos;
            tr_item(PROJ + (size_t)tb * 64 * 2304 + 1024 + nb * 32, 2304, dst, T, scr, lane);
        } else { const int n2 = nb - 16, g = n2 >> 1, e0 = (n2 & 1) * 32;
            bf16* dst = (bf16*)(ws + (smp ? WS_VBTS : WS_VBTC)) + ((size_t)(b * 2 + g) * 64 + e0) * T + tpos;
            tr_item(PROJ + (size_t)tb * 64 * 2304 + 2176 + n2 * 32, 2304, dst, T, scr, lane);
        }
    }
}

template <int DV, int LDK, bool SHK>
__device__ __forceinline__ void attn_core(unsigned char* ldsb, const bf16* Qw, int qc0, int qc1, const bf16* Kg, const bf16* VTg, int T, f32x4 (&O)[2][DV / 16], float (&linv)[2]) {
    constexpr int KSTR = LDK * 2 + 16, VSTR = 144, VOFF = 64 * KSTR, BUFB = VOFF + DV * VSTR, NKC = 64 * LDK / 8 / 512, NVC = DV * 8 / 512, KCPR = LDK / 8;
    const int tid = opq((int)threadIdx.x), lane = tid & 63, fr = lane & 15, fq = lane >> 4;
    bf16x8 qf[2][2];
#pragma unroll
    for (int ks = 0; ks < 2; ++ks) { qf[0][ks] = *(const bf16x8*)(Qw + (size_t)fr * 512 + qc0 + ks * 32 + fq * 8); qf[1][ks] = *(const bf16x8*)(Qw + (size_t)fr * 512 + qc1 + ks * 32 + fq * 8); }
#pragma unroll
    for (int s = 0; s < 2; ++s)
#pragma unroll
        for (int e = 0; e < DV / 16; ++e) O[s][e] = (f32x4){0.f, 0.f, 0.f, 0.f};
    float mrun[2] = {-1e30f, -1e30f}, lsum[2] = {0.f, 0.f};
    u32x4 kreg[NKC], vreg[NVC];
    const int ntile = T / 64;
#define ATT_LOAD(t0) do { _Pragma("unroll") for (int i = 0; i < NKC; ++i) { const int c = tid + i * 512, r = c / KCPR, cc = c % KCPR; kreg[i] = *(const u32x4*)(Kg + (size_t)((t0) + r) * LDK + cc * 8); } \
        _Pragma("unroll") for (int i = 0; i < NVC; ++i) { const int c = tid + i * 512, e = c >> 3, cc = c & 7; vreg[i] = *(const u32x4*)(VTg + (size_t)e * T + (t0) + cc * 8); } } while (0)
#define ATT_PUT(base) do { _Pragma("unroll") for (int i = 0; i < NKC; ++i) { const int c = tid + i * 512, r = c / KCPR, cc = c % KCPR; *(u32x4*)((base) + r * KSTR + cc * 16) = kreg[i]; } \
        _Pragma("unroll") for (int i = 0; i < NVC; ++i) { const int c = tid + i * 512, e = c >> 3, cc = c & 7; *(u32x4*)((base) + VOFF + e * VSTR + cc * 16) = vreg[i]; } } while (0)
    ATT_LOAD(0);
    __syncthreads();
    ATT_PUT(ldsb);
    if (ntile > 1) ATT_LOAD(64);
    __syncthreads();
    for (int it = 0; it < ntile; ++it) {
        unsigned char* lds = ldsb + (it & 1) * BUFB;
        if (it + 1 < ntile) { ATT_PUT(ldsb + ((it + 1) & 1) * BUFB); if (it + 2 < ntile) ATT_LOAD((it + 2) * 64); }
        f32x4 sc[2][4];
#pragma unroll
        for (int kt = 0; kt < 4; ++kt) {
            sc[0][kt] = (f32x4){0.f, 0.f, 0.f, 0.f}; sc[1][kt] = (f32x4){0.f, 0.f, 0.f, 0.f};
#pragma unroll
            for (int ks = 0; ks < 2; ++ks) {
                const bf16x8 a0 = *(const bf16x8*)(lds + (kt * 16 + fr) * KSTR + (ks * 32 + fq * 8) * 2);
                sc[0][kt] = __builtin_amdgcn_mfma_f32_16x16x32_bf16(a0, qf[0][ks], sc[0][kt], 0, 0, 0);
                if (SHK) sc[1][kt] = __builtin_amdgcn_mfma_f32_16x16x32_bf16(a0, qf[1][ks], sc[1][kt], 0, 0, 0);
                else { const bf16x8 a1 = *(const bf16x8*)(lds + (kt * 16 + fr) * KSTR + (64 + ks * 32 + fq * 8) * 2);
                    sc[1][kt] = __builtin_amdgcn_mfma_f32_16x16x32_bf16(a1, qf[1][ks], sc[1][kt], 0, 0, 0); }
            }
        }
        bf16x8 pb[2][2];
#pragma unroll
        for (int s = 0; s < 2; ++s) {
            float mt = -1e30f;
#pragma unroll
            for (int kt = 0; kt < 4; ++kt) mt = fmaxf(fmaxf(fmaxf(sc[s][kt].x, sc[s][kt].y), fmaxf(sc[s][kt].z, sc[s][kt].w)), mt);
            mt = fmaxf(mt, __shfl_xor(mt, 16)); mt = fmaxf(mt, __shfl_xor(mt, 32));
            const float mnew = fmaxf(mrun[s], mt), alpha = __builtin_amdgcn_exp2f(mrun[s] - mnew); mrun[s] = mnew;
            float ps = 0.f;
#pragma unroll
            for (int kt = 0; kt < 4; ++kt) { sc[s][kt].x = __builtin_amdgcn_exp2f(sc[s][kt].x - mnew); sc[s][kt].y = __builtin_amdgcn_exp2f(sc[s][kt].y - mnew); sc[s][kt].z = __builtin_amdgcn_exp2f(sc[s][kt].z - mnew); sc[s][kt].w = __builtin_amdgcn_exp2f(sc[s][kt].w - mnew);
                ps += (sc[s][kt].x + sc[s][kt].y) + (sc[s][kt].z + sc[s][kt].w); }
            lsum[s] = lsum[s] * alpha + ps;
            if (__builtin_amdgcn_ballot_w64(alpha != 1.f) != 0ull) {
#pragma unroll
                for (int e = 0; e < DV / 16; ++e) O[s][e] = O[s][e] * alpha; }
#pragma unroll
            for (int k2 = 0; k2 < 2; ++k2) { u32x4 w; w.x = pk2(sc[s][2 * k2].x, sc[s][2 * k2].y); w.y = pk2(sc[s][2 * k2].z, sc[s][2 * k2].w); w.z = pk2(sc[s][2 * k2 + 1].x, sc[s][2 * k2 + 1].y); w.w = pk2(sc[s][2 * k2 + 1].z, sc[s][2 * k2 + 1].w);
                pb[s][k2] = __builtin_bit_cast(bf16x8, w); }
        }
#pragma unroll
        for (int e = 0; e < DV / 16; ++e)
#pragma unroll
            for (int k2 = 0; k2 < 2; ++k2) {
                const unsigned char* vp = lds + VOFF + (e * 16 + fr) * VSTR + (k2 * 32 + fq * 4) * 2;
                const u32x2 lo = *(const u32x2*)vp, hi = *(const u32x2*)(vp + 32);
                const u32x4 w = {lo.x, lo.y, hi.x, hi.y}; const bf16x8 av = __builtin_bit_cast(bf16x8, w);
                O[0][e] = __builtin_amdgcn_mfma_f32_16x16x32_bf16(av, pb[0][k2], O[0][e], 0, 0, 0);
                O[1][e] = __builtin_amdgcn_mfma_f32_16x16x32_bf16(av, pb[1][k2], O[1][e], 0, 0, 0);
            }
        __syncthreads();
    }
#undef ATT_PUT
#undef ATT_LOAD
#pragma unroll
    for (int s = 0; s < 2; ++s) { float l = lsum[s]; l += __shfl_xor(l, 16); l += __shfl_xor(l, 32); linv[s] = 1.f / l; }
}
__device__ __forceinline__ void attn_phase(const Args& a, unsigned char* lds) {
    unsigned char* ws = a.ws; const int tid = opq((int)threadIdx.x), lane = tid & 63, wave = tid >> 6, fr = lane & 15, fq = lane >> 4;
    const bf16* QA = (const bf16*)(ws + WS_QA); const bf16* QB = (const bf16*)(ws + WS_QB); bf16* CAT = (bf16*)(ws + WS_CAT);
    const float lam = *(const float*)(ws + WS_LAM);
    const bool bal = gridDim.x == 256;
    for (int it = 0; ; ++it) {
        int u;
        if (bal) { if (it == 0) u = (int)blockIdx.x; else if (blockIdx.x >= 128 && it < 3) u = 128 + it * 128 + ((int)blockIdx.x - 128); else break; }
        else { u = (int)blockIdx.x + it * (int)gridDim.x; if (u >= 512) break; }
        const bool isA = (u < 128) || (u >= 384), smp = u < 256;
        int idx = u < 128 ? u : (u < 256 ? u - 128 : (u < 384 ? u - 256 : u - 384));
        const int T = smp ? 1536 : 256;
        int b, hx, pair = 0, qb;
        if (smp) { b = idx >> 5; qb = idx & 7; if (isA) hx = (idx >> 3) & 3; else { hx = (idx >> 4) & 1; pair = (idx >> 3) & 1; } }
        else { b = idx >> 3; if (isA) { hx = (idx >> 1) & 3; qb = idx & 1; } else { hx = (idx >> 2) & 1; pair = (idx >> 1) & 1; qb = idx & 1; } }
        const int tok0 = (smp ? NCTX + b * 1024 : b * 256) + qb * 128 + wave * 16;
        if (isA) {
            const bf16* Kg = (const bf16*)(ws + (smp ? WS_KAS : WS_KAC)) + (size_t)(b * 4 + hx) * T * 128;
            const bf16* Vg = (const bf16*)(ws + (smp ? WS_VATS : WS_VATC)) + (size_t)(b * 4 + hx) * 128 * T;
            f32x4 O[2][8]; float li[2];
            attn_core<128, 128, false>(lds, QA + (size_t)tok0 * 512, hx * 128, hx * 128 + 64, Kg, Vg, T, O, li);
            float ss = 0.f;
#pragma unroll
            for (int e = 0; e < 8; ++e) { O[0][e] = O[0][e] * li[0] - (O[1][e] * li[1]) * lam; ss += (O[0][e].x * O[0][e].x + O[0][e].y * O[0][e].y) + (O[0][e].z * O[0][e].z + O[0][e].w * O[0][e].w); }
            ss += __shfl_xor(ss, 16); ss += __shfl_xor(ss, 32);
            const float rs = rsqrtf(ss * (1.f / 128.f) + 1e-6f) * 0.8f;
#pragma unroll
            for (int e = 0; e < 8; ++e) { const int ec = e * 16 + fq * 4; const f32x4 gg = *(const f32x4*)(a.in[18] + ec); const f32x4 y = O[0][e] * rs * gg;
                u32x2 o; o.x = pk2(y.x, y.y); o.y = pk2(y.z, y.w); *(u32x2*)(CAT + (size_t)(tok0 + fr) * 1024 + hx * 128 + ec) = o; }
        } else {
            const bf16* Kg = (const bf16*)(ws + (smp ? WS_KBS : WS_KBC)) + (size_t)(b * 2 + hx) * T * 64;
            const bf16* Vg = (const bf16*)(ws + (smp ? WS_VBTS : WS_VBTC)) + (size_t)(b * 2 + hx) * 64 * T;
            const int hq0 = hx * 4 + pair * 2;
            f32x4 O[2][4]; float li[2];
#if defined(DBG_SKIP_B)
            if (DBG_SKIP_B == 1 ? smp : !smp) {
#pragma unroll
            for (int s = 0; s < 2; ++s) { li[s] = 0.f;
#pragma unroll
                for (int e = 0; e < 4; ++e) O[s][e] = (f32x4){0.f, 0.f, 0.f, 0.f}; }
            } else
#endif
            attn_core<64, 64, true>(lds, QB + (size_t)tok0 * 512, hq0 * 64, (hq0 + 1) * 64, Kg, Vg, T, O, li);
#pragma unroll
            for (int s = 0; s < 2; ++s)
#pragma unroll
                for (int e = 0; e < 4; ++e) { const f32x4 y = O[s][e] * li[s]; u32x2 o; o.x = pk2(y.x, y.y); o.y = pk2(y.z, y.w);
                    *(u32x2*)(CAT + (size_t)(tok0 + fr) * 1024 + 512 + (hq0 + s) * 64 + e * 16 + fq * 4) = o; }
        }
    }
}

__device__ __forceinline__ void conv_phase(const Args& a, int l) {
    const int gt = blockIdx.x * 512 + opq((int)threadIdx.x), NGT = gridDim.x * 512;
    const bf16* U = (const bf16*)(a.ws + WS_U); bf16* ACT = (bf16*)(a.ws + WS_ACT);
    const float* cw = a.in[37] + (size_t)l * 3 * 5632; const float* cb = a.in[38] + (size_t)l * 5632;
    const int nrw = NGT / 352;
    if (gt < nrw * 352) {
        const int ch = gt % 352, r0 = gt / 352, j0 = ch * 8;
        float w0v[8], w1v[8], w2v[8], bv[8], w0g[8], w1g[8], w2g[8], bg[8];
#pragma unroll
        for (int k = 0; k < 8; ++k) { w0v[k] = cw[j0 + k]; w1v[k] = cw[5632 + j0 + k]; w2v[k] = cw[2 * 5632 + j0 + k]; bv[k] = cb[j0 + k];
            w0g[k] = cw[DFF + j0 + k]; w1g[k] = cw[5632 + DFF + j0 + k]; w2g[k] = cw[2 * 5632 + DFF + j0 + k]; bg[k] = cb[DFF + j0 + k]; }
        for (int run = r0; run < 1024; run += nrw) {
            const int t0 = run * 8;
            const int S = t0 < NCTX ? 256 : 1024, s0 = t0 < NCTX ? (t0 & 255) : ((t0 - NCTX) & 1023);
            const u32x4 zero = {0u, 0u, 0u, 0u};
            u32x4 rv[10], rg[10];
#pragma unroll
            for (int i = 0; i < 10; ++i) { const int sp = s0 - 1 + i; const bool ok = sp >= 0 && sp < S; const size_t off = (size_t)(t0 - 1 + i) * 5632 + j0;
                rv[i] = ok ? *(const u32x4*)(U + off) : zero; rg[i] = ok ? *(const u32x4*)(U + off + DFF) : zero; }
#pragma unroll
            for (int i = 0; i < 8; ++i) {
                float o[8];
#pragma unroll
                for (int k = 0; k < 4; ++k) {
                    const float vl = w0v[2 * k] * bflo(rv[i][k]) + w1v[2 * k] * bflo(rv[i + 1][k]) + w2v[2 * k] * bflo(rv[i + 2][k]) + bv[2 * k];
                    const float vh = w0v[2 * k + 1] * bfhi(rv[i][k]) + w1v[2 * k + 1] * bfhi(rv[i + 1][k]) + w2v[2 * k + 1] * bfhi(rv[i + 2][k]) + bv[2 * k + 1];
                    const float gl = w0g[2 * k] * bflo(rg[i][k]) + w1g[2 * k] * bflo(rg[i + 1][k]) + w2g[2 * k] * bflo(rg[i + 2][k]) + bg[2 * k];
                    const float gh = w0g[2 * k + 1] * bfhi(rg[i][k]) + w1g[2 * k + 1] * bfhi(rg[i + 1][k]) + w2g[2 * k + 1] * bfhi(rg[i + 2][k]) + bg[2 * k + 1];
                    o[2 * k] = silu(gl) * vl; o[2 * k + 1] = silu(gh) * vh; }
                u32x4 w; w.x = pk2(o[0], o[1]); w.y = pk2(o[2], o[3]); w.z = pk2(o[4], o[5]); w.w = pk2(o[6], o[7]);
                *(u32x4*)(ACT + (size_t)(t0 + i) * DFF + j0) = w;
            }
        }
    }
}

__device__ __forceinline__ void prep1_phase(const Args& a) {
    const int lane = opq((int)threadIdx.x) & 63, wave = opq((int)threadIdx.x) >> 6, gw = blockIdx.x * 8 + wave, NGW = gridDim.x * 8;
    unsigned char* ws = a.ws; const bf16* PR = (const bf16*)(ws + WS_PR);
    bf16* R = (bf16*)(ws + WS_R); bf16* K1 = (bf16*)(ws + WS_K1); bf16* V1 = (bf16*)(ws + WS_V1); bf16* KK = (bf16*)(ws + WS_KK); bf16* AP = (bf16*)(ws + WS_AP);
    const float* mu = a.in[25]; const float* k_k = a.in[31];
    for (int t = gw; t < NTOK; t += NGW) {
        const int S = t < NCTX ? 256 : 1024, s = t < NCTX ? (t & 255) : ((t - NCTX) & 1023);
        const bool hp = s > 0, hn = s + 1 < S;
#pragma unroll
        for (int it = 0; it < 4; ++it) {
            const int c = it * 64 + lane; if (c >= 232) break;
            const int col = c * 8; const u32x4 zero = {0u, 0u, 0u, 0u};
            const u32x4 x = *(const u32x4*)(PR + (size_t)t * 1856 + col);
            const u32x4 xp = hp ? *(const u32x4*)(PR + (size_t)(t - 1) * 1856 + col) : zero;
            const u32x4 xn = hn ? *(const u32x4*)(PR + (size_t)(t + 1) * 1856 + col) : zero;
            float pd[8];
#pragma unroll
            for (int k = 0; k < 4; ++k) { const float m0 = mu[col + 2 * k], m1 = mu[col + 2 * k + 1];
                const float c0 = bflo(x[k]), c1 = bfhi(x[k]);
                pd[2 * k] = c0 + m0 * (0.5f * (bflo(xp[k]) + bflo(xn[k])) - c0); pd[2 * k + 1] = c1 + m1 * (0.5f * (bfhi(xp[k]) + bfhi(xn[k])) - c1); }
            u32x4 w; w.x = pk2(pd[0], pd[1]); w.y = pk2(pd[2], pd[3]); w.z = pk2(pd[4], pd[5]); w.w = pk2(pd[6], pd[7]);
            if (it == 0) { *(u32x4*)(R + (size_t)t * 512 + col) = w; }
            else if (it == 1) { const int kc = col - 512; *(u32x4*)(K1 + (size_t)t * 512 + kc) = w;
                float q[8], ss = 0.f;
#pragma unroll
                for (int k = 0; k < 8; ++k) { q[k] = pd[k] * k_k[kc + k]; ss += q[k] * q[k]; }
                ss += __shfl_xor(ss, 1); ss += __shfl_xor(ss, 2); ss += __shfl_xor(ss, 4);
                const float inv = 1.f / fmaxf(sqrtf(ss), 1e-12f);
                u32x4 o; o.x = pk2(q[0] * inv, q[1] * inv); o.y = pk2(q[2] * inv, q[3] * inv); o.z = pk2(q[4] * inv, q[5] * inv); o.w = pk2(q[6] * inv, q[7] * inv);
                *(u32x4*)(KK + (size_t)t * 512 + kc) = o; }
            else if (it == 2) { *(u32x4*)(V1 + (size_t)t * 512 + (col - 1024)) = w; }
            else { const int ac = col - 1536;
                float o[8];
#pragma unroll
                for (int k = 0; k < 8; ++k) { const float x_ = pd[k]; o[k] = ac < 128 ? (1.f - 2.f / (1.f + __expf(2.f * x_))) : (ac < 192 ? x_ : sigm(x_)); }
                u32x4 ow; ow.x = pk2(o[0], o[1]); ow.y = pk2(o[2], o[3]); ow.z = pk2(o[4], o[5]); ow.w = pk2(o[6], o[7]);
                *(u32x4*)(AP + (size_t)t * 384 + ac) = ow; }
        }
        if (lane < 8) *(u32x4*)(AP + (size_t)t * 384 + 320 + lane * 8) = (u32x4){0u, 0u, 0u, 0u};
    }
}

template <int CTRL> __device__ __forceinline__ float dppf(float x) { return __builtin_bit_cast(float, __builtin_amdgcn_update_dpp(0, __builtin_bit_cast(int, x), CTRL, 0xF, 0xF, true)); }
__device__ __forceinline__ float red8(float x) { x += dppf<0xB1>(x); x += dppf<0x4E>(x); x += dppf<0x141>(x); return x; }
__device__ __forceinline__ float red16(float x) { x = red8(x); x += dppf<0x140>(x); return x; }

template <int R> __device__ __forceinline__ void hgrn_step(const f32x4 (&X)[4], const float (&vv)[R], f32x2 (&St)[R][4], float (&oo)[R]) {
    const f32x2 f2[4] = {{X[0].x, X[0].y}, {X[0].z, X[0].w}, {X[1].x, X[1].y}, {X[1].z, X[1].w}}, q2[4] = {{X[2].x, X[2].y}, {X[2].z, X[2].w}, {X[3].x, X[3].y}, {X[3].z, X[3].w}};
#pragma unroll
    for (int c = 0; c < R; ++c) { const f32x2 v2 = {vv[c], vv[c]}; f32x2 o2 = {0.f, 0.f};
#pragma unroll
        for (int i = 0; i < 4; ++i) { const f32x2 d = St[c][i] - v2; St[c][i] = f2[i] * d + v2; o2 = q2[i] * St[c][i] + o2; }
        oo[c] = o2.x + o2.y; }
#pragma unroll
    for (int c = 0; c < R; ++c) oo[c] = red16(oo[c]);
}
template <int R> __device__ __forceinline__ void rwkv_step(const f32x4 (&X)[10], const float (&vv)[R], f32x2 (&St)[R][4], float (&oo)[R]) {
    const f32x2 kk2[4] = {{X[0].x, X[0].y}, {X[0].z, X[0].w}, {X[1].x, X[1].y}, {X[1].z, X[1].w}}, w2[4] = {{X[2].x, X[2].y}, {X[2].z, X[2].w}, {X[3].x, X[3].y}, {X[3].z, X[3].w}};
    const f32x2 ka2[4] = {{X[4].x, X[4].y}, {X[4].z, X[4].w}, {X[5].x, X[5].y}, {X[5].z, X[5].w}}, kt2[4] = {{X[6].x, X[6].y}, {X[6].z, X[6].w}, {X[7].x, X[7].y}, {X[7].z, X[7].w}};
    const f32x2 r2[4] = {{X[8].x, X[8].y}, {X[8].z, X[8].w}, {X[9].x, X[9].y}, {X[9].z, X[9].w}};
    float sa[R];
#pragma unroll
    for (int c = 0; c < R; ++c) { f32x2 s2 = {0.f, 0.f};
#pragma unroll
        for (int i = 0; i < 4; ++i) s2 = St[c][i] * kk2[i] + s2;
        sa[c] = s2.x + s2.y; }
#pragma unroll
    for (int c = 0; c < R; ++c) sa[c] = -red8(sa[c]);
#pragma unroll
    for (int c = 0; c < R; ++c) { const f32x2 v2 = {vv[c], vv[c]}, sa2 = {sa[c], sa[c]}; f32x2 o2 = {0.f, 0.f};
#pragma unroll
        for (int i = 0; i < 4; ++i) { const f32x2 t2 = sa2 * ka2[i] + v2 * kt2[i]; St[c][i] = St[c][i] * w2[i] + t2; o2 = St[c][i] * r2[i] + o2; }
        oo[c] = o2.x + o2.y; }
}
template <int R>
__device__ __forceinline__ void hgrn_wjob(const Args& a, unsigned char* wl, bool smp, int j, int lane) {
    unsigned char* ws = a.ws;
    constexpr int NCG = 32 / R;
    const int chain = j / NCG, cg = j % NCG, b = chain >> 3, h = (chain >> 1) & 3, dir = chain & 1;
    const int tok0 = smp ? NCTX + b * 1024 : b * 256, S = smp ? 1024 : 256;
    const int eg = lane >> 4, ksl = lane & 15, cb = cg * 4 * R, c0 = cb + eg * R;
    const float* HG = (const float*)(ws + WS_HG); bf16* OC = (bf16*)(ws + (dir ? WS_OCB : WS_OCF));
    f32x2 St[R][4];
#pragma unroll
    for (int c = 0; c < R; ++c)
#pragma unroll
        for (int i = 0; i < 4; ++i) {
            if (smp) { const float* sp = a.in[6] + ((size_t)((b * 2 + dir) * 4 + h) * 128 + (i < 2 ? 4 * ksl + 2 * i : 64 + 4 * ksl + 2 * (i - 2))) * 128 + c0 + c; St[c][i] = (f32x2){sp[0], sp[128]}; }
            else St[c][i] = (f32x2){0.f, 0.f}; }
    float* sF = (float*)wl; float* sQ = sF + 1024; float* sV = sQ + 1024; float* sO = sV + 64;
    f32x4 rf[4], rq[4], rv;
#define HGW_TOK(ch, st) (tok0 + (dir ? S - 1 - ((ch) * 8 + (st)) : ((ch) * 8 + (st))))
#define HGW_LOAD(ch) do { _Pragma("unroll") for (int m = 0; m < 4; ++m) { const int i_ = lane + 64 * m, st_ = i_ >> 5, c_ = i_ & 31; const float* r_ = HG + (size_t)HGW_TOK(ch, st_) * 2560 + h * 128 + c_ * 4; \
        rf[m] = *(const f32x4*)(r_ + 512 + dir * 512); rq[m] = *(const f32x4*)r_; } \
        if (lane < 8 * R) rv = *(const f32x4*)(HG + (size_t)HGW_TOK(ch, lane / R) * 2560 + 1536 + h * 128 + cb + (lane % R) * 4); } while (0)
    HGW_LOAD(0);
    const int nch = S / 8;
    for (int ch = 0; ch < nch; ++ch) {
#pragma unroll
        for (int m = 0; m < 4; ++m) { const int i_ = lane + 64 * m; *(f32x4*)(sF + i_ * 4) = rf[m]; *(f32x4*)(sQ + i_ * 4) = rq[m]; }
        if (lane < 8 * R) *(f32x4*)(sV + lane * 4) = rv;
        if (ch + 1 < nch) HGW_LOAD(ch + 1);
        float ob[8][R];
#pragma unroll
        for (int st = 0; st < 8; ++st) {
            f32x4 X[4]; float V[R];
            X[0] = *(const f32x4*)(sF + st * 128 + 4 * ksl); X[1] = *(const f32x4*)(sF + st * 128 + 64 + 4 * ksl); X[2] = *(const f32x4*)(sQ + st * 128 + 4 * ksl); X[3] = *(const f32x4*)(sQ + st * 128 + 64 + 4 * ksl);
#pragma unroll
            for (int c = 0; c < R; ++c) V[c] = sV[st * 4 * R + eg * R + c];
            hgrn_step<R>(X, V, St, ob[st]);
        }
        if (ksl == 0) {
#pragma unroll
            for (int st = 0; st < 8; ++st)
#pragma unroll
                for (int c = 0; c < R; ++c) sO[st * 4 * R + eg * R + c] = ob[st][c]; }
        if (lane < 8) {
            if (R == 2) { const f32x4 o0 = *(const f32x4*)(sO + lane * 8), o1 = *(const f32x4*)(sO + lane * 8 + 4);
                u32x4 w; w.x = pk2(o0.x, o0.y); w.y = pk2(o0.z, o0.w); w.z = pk2(o1.x, o1.y); w.w = pk2(o1.z, o1.w);
                *(u32x4*)(OC + (size_t)HGW_TOK(ch, lane) * 512 + h * 128 + cb) = w; }
            else { const f32x4 o0 = *(const f32x4*)(sO + lane * 4); u32x2 w; w.x = pk2(o0.x, o0.y); w.y = pk2(o0.z, o0.w);
                *(u32x2*)(OC + (size_t)HGW_TOK(ch, lane) * 512 + h * 128 + cb) = w; }
        }
    }
#undef HGW_LOAD
#undef HGW_TOK
    if (!smp) {
#pragma unroll
        for (int c = 0; c < R; ++c)
#pragma unroll
            for (int i = 0; i < 4; ++i) { float* dp = a.out + O_SH + ((size_t)((b * 2 + dir) * 4 + h) * 128 + (i < 2 ? 4 * ksl + 2 * i : 64 + 4 * ksl + 2 * (i - 2))) * 128 + c0 + c; dp[0] = St[c][i].x; dp[128] = St[c][i].y; }
    }
}
template <int R>
__device__ __forceinline__ void rwkv_wjob(const Args& a, unsigned char* wl, bool smp, int j, int lane) {
    unsigned char* ws = a.ws;
    constexpr int NRG = 8 / R;
    const int chain = j / NRG, rg = j % NRG, b = chain >> 4, h = (chain >> 1) & 7, dir = chain & 1;
    const int tok0 = smp ? NCTX + b * 1024 : b * 256, S = smp ? 1024 : 256;
    const int rp = lane >> 3, ksl = lane & 7, k0 = ksl * 8, rb = rg * 8 * R, r0 = rb + rp * R;
    const bf16* KK = (const bf16*)(ws + WS_KK); const bf16* KKA = (const bf16*)(ws + WS_KKA); const bf16* KT = (const bf16*)(ws + WS_KT);
    const bf16* Rr = (const bf16*)(ws + WS_R); const bf16* V1 = (const bf16*)(ws + WS_V1); const float* W = (const float*)(ws + (dir ? WS_WB : WS_WF));
    bf16* OD = (bf16*)(ws + (dir ? WS_ODB : WS_ODF));
    f32x2 St[R][4];
#pragma unroll
    for (int c = 0; c < R; ++c)
#pragma unroll
        for (int i = 0; i < 4; ++i) {
            if (smp) St[c][i] = *(const f32x2*)(a.in[7] + ((size_t)((b * 2 + dir) * 8 + h) * 64 + r0 + c) * 64 + k0 + 2 * i);
            else St[c][i] = (f32x2){0.f, 0.f}; }
    float* sX = (float*)wl;
    float* sV = sX + 2560; float* sO = sV + 128; float* sP = sO + 128;
    u32x4 rkk0, rka0, rkt0, rr0, rv0, rkk1, rka1, rkt1, rr1, rv1; f32x4 rw0[2], rw1[2];
#define RWW_TOK(ch, st) (tok0 + (dir ? S - 1 - ((ch) * 8 + (st)) : ((ch) * 8 + (st))))
#define RWW_LOAD(ch, Z) do { const size_t o_ = (size_t)RWW_TOK(ch, lane >> 3) * 512 + h * 64 + (lane & 7) * 8; \
        rkk##Z = *(const u32x4*)(KK + o_); rka##Z = *(const u32x4*)(KKA + o_); rkt##Z = *(const u32x4*)(KT + o_); rr##Z = *(const u32x4*)(Rr + o_); \
        _Pragma("unroll") for (int m = 0; m < 2; ++m) { const int i_ = lane + 64 * m; rw##Z[m] = *(const f32x4*)(W + (size_t)RWW_TOK(ch, i_ >> 4) * 512 + h * 64 + (i_ & 15) * 4); } \
        if (lane < 8 * R) rv##Z = *(const u32x4*)(V1 + (size_t)RWW_TOK(ch, lane / R) * 512 + h * 64 + rb + (lane % R) * 8); } while (0)
#define RWW_PUT(slot, reg) do { float* d_ = sX + (lane >> 3) * 320 + (slot) * 64 + (lane & 7) * 8; \
        *(f32x4*)d_ = (f32x4){bflo(reg.x), bfhi(reg.x), bflo(reg.y), bfhi(reg.y)}; *(f32x4*)(d_ + 4) = (f32x4){bflo(reg.z), bfhi(reg.z), bflo(reg.w), bfhi(reg.w)}; } while (0)
#define RWW_CHUNK(ch, Z) do { \
        RWW_PUT(0, rkk##Z); RWW_PUT(2, rka##Z); RWW_PUT(3, rkt##Z); RWW_PUT(4, rr##Z); \
        _Pragma("unroll") for (int m = 0; m < 2; ++m) { const int i_ = lane + 64 * m; *(f32x4*)(sX + (i_ >> 4) * 320 + 64 + (i_ & 15) * 4) = rw##Z[m]; } \
        if (lane < 8 * R) { float* d_ = sV + lane * 8; *(f32x4*)d_ = (f32x4){bflo(rv##Z.x), bfhi(rv##Z.x), bflo(rv##Z.y), bfhi(rv##Z.y)}; *(f32x4*)(d_ + 4) = (f32x4){bflo(rv##Z.z), bfhi(rv##Z.z), bflo(rv##Z.w), bfhi(rv##Z.w)}; } \
        if ((ch) + 2 < nch) RWW_LOAD((ch) + 2, Z); \
        float ob[8][R]; \
        _Pragma("unroll") for (int st = 0; st < 8; ++st) { \
            f32x4 X[10]; float V[R]; \
            const float* x_ = sX + st * 320 + k0; \
            _Pragma("unroll") for (int q = 0; q < 5; ++q) { X[2 * q] = *(const f32x4*)(x_ + 64 * q); X[2 * q + 1] = *(const f32x4*)(x_ + 64 * q + 4); } \
            _Pragma("unroll") for (int c = 0; c < R; ++c) V[c] = sV[st * 8 * R + rp * R + c]; \
            rwkv_step<R>(X, V, St, ob[st]); } \
        _Pragma("unroll") for (int st = 0; st < 8; ++st) _Pragma("unroll") for (int c = 0; c < R; ++c) sP[((st * 8 + rp) * R + c) * 8 + ksl] = ob[st][c]; \
        _Pragma("unroll") for (int m = 0; m < R; ++m) { const int q_ = lane + 64 * m; const f32x4 p0_ = *(const f32x4*)(sP + q_ * 8), p1_ = *(const f32x4*)(sP + q_ * 8 + 4); \
            sO[q_] = ((p0_.x + p0_.y) + (p0_.z + p0_.w)) + ((p1_.x + p1_.y) + (p1_.z + p1_.w)); } \
        if (lane < 8 * R) { const float* o_ = sO + lane * 8; const f32x4 o0 = *(const f32x4*)o_, o1 = *(const f32x4*)(o_ + 4); \
            u32x4 w; w.x = pk2(o0.x, o0.y); w.y = pk2(o0.z, o0.w); w.z = pk2(o1.x, o1.y); w.w = pk2(o1.z, o1.w); \
            *(u32x4*)(OD + (size_t)RWW_TOK(ch, lane / R) * 512 + h * 64 + rb + (lane % R) * 8) = w; } } while (0)
    const int nch = S / 8;
    RWW_LOAD(0, 0); RWW_LOAD(1, 1);
    for (int ch = 0; ch < nch; ch += 2) { RWW_CHUNK(ch, 0); RWW_CHUNK(ch + 1, 1); }
#undef RWW_CHUNK
#undef RWW_LOAD
#undef RWW_PUT
#undef RWW_TOK
    if (!smp) {
#pragma unroll
        for (int c = 0; c < R; ++c)
#pragma unroll
            for (int i = 0; i < 4; ++i) *(f32x2*)(a.out + O_SR + ((size_t)((b * 2 + dir) * 8 + h) * 64 + r0 + c) * 64 + k0 + 2 * i) = St[c][i];
    }
}
__device__ __forceinline__ void hgrn_chain(const Args& a, unsigned char* lds, bool smp, int chain) {
    unsigned char* ws = a.ws;
    const int tid = opq((int)threadIdx.x), lane = tid & 63, wave = tid >> 6, fr = lane & 15, fq = lane >> 4;
    const int b = chain >> 3, h = (chain >> 1) & 3, dir = chain & 1;
    const int tok0 = smp ? NCTX + b * 1024 : b * 256, S = smp ? 1024 : 256;
    const float* HG = (const float*)(ws + WS_HG); bf16* OC = (bf16*)(ws + (dir ? WS_OCB : WS_OCF));
    float* sFr = (float*)lds; float* sQr = sFr + 2048;
    bf16* sVT = (bf16*)(lds + 16384);
    bf16* sQs = (bf16*)(lds + 22528);
    bf16* sKn = (bf16*)(lds + 26880);
    bf16* sKeT = (bf16*)(lds + 31232);
    float* sDec = (float*)(lds + 37376);
    bf16* sPm = (bf16*)(lds + 37888);
    float* sPart = (float*)(lds + 38912);
    const int e = wave * 16 + fr;
    f32x4 acc[8];
#pragma unroll
    for (int kt = 0; kt < 8; ++kt) {
        if (smp) { const float* sp = a.in[6] + ((size_t)((b * 2 + dir) * 4 + h) * 128 + kt * 16 + fq * 4) * 128 + e; acc[kt] = (f32x4){sp[0], sp[128], sp[256], sp[384]}; }
        else acc[kt] = (f32x4){0.f, 0.f, 0.f, 0.f}; }
    const int tl = tid >> 5, c4 = (tid & 31) * 4;
    f32x4 rf, rq, rv;
#define HC_TOK(ch, t) (tok0 + (dir ? S - 1 - ((ch) * 16 + (t)) : ((ch) * 16 + (t))))
#define HC_LOAD(ch) do { const float* r_ = HG + (size_t)HC_TOK(ch, tl) * 2560 + h * 128 + c4; rq = *(const f32x4*)r_; rf = *(const f32x4*)(r_ + 512 + dir * 512); rv = *(const f32x4*)(r_ + 1536); } while (0)
    HC_LOAD(0);
    const int nch = S / 16;
    for (int ch = 0; ch < nch; ++ch) {
        __syncthreads();
        *(f32x4*)(sFr + tl * 128 + c4) = rf; *(f32x4*)(sQr + tl * 128 + c4) = rq;
        sVT[(c4 + 0) * 24 + tl] = f2bf(rv.x); sVT[(c4 + 1) * 24 + tl] = f2bf(rv.y); sVT[(c4 + 2) * 24 + tl] = f2bf(rv.z); sVT[(c4 + 3) * 24 + tl] = f2bf(rv.w);
        __syncthreads();
        if (ch + 1 < nch) HC_LOAD(ch + 1);
        {
            const int k = tid & 127, part = tid >> 7; float lf[4], fv[4], cs = 0.f;
#pragma unroll
            for (int i = 0; i < 4; ++i) { fv[i] = sFr[(part * 4 + i) * 128 + k]; lf[i] = __logf(fv[i]); cs += lf[i]; }
            sPart[part * 128 + k] = cs;
            __syncthreads();
            const float p0 = sPart[k], p1 = sPart[128 + k], p2 = sPart[256 + k], p3 = sPart[384 + k];
            float cum = part > 0 ? p0 : 0.f; cum += part > 1 ? p1 : 0.f; cum += part > 2 ? p2 : 0.f;
            const float dec = __expf((p0 + p1) + (p2 + p3)); if (part == 0) sDec[k] = dec;
            float kd[4];
#pragma unroll
            for (int i = 0; i < 4; ++i) { const int t = part * 4 + i; cum += lf[i]; const float e1 = __expf(cum), e2 = 1.f / e1, kn = (1.f - fv[i]) * e2;
                sQs[t * 136 + k] = f2bf(sQr[t * 128 + k] * e1); sKn[t * 136 + k] = f2bf(kn); kd[i] = kn * dec; }
            *(u32x2*)(sKeT + k * 24 + part * 4) = (u32x2){pk2(kd[0], kd[1]), pk2(kd[2], kd[3])};
        }
        __syncthreads();
        if (wave == 7) {
            f32x4 pc = {0.f, 0.f, 0.f, 0.f};
#pragma unroll
            for (int m = 0; m < 4; ++m) { const bf16x8 aa = *(const bf16x8*)(sQs + fr * 136 + 32 * m + 8 * fq), bb = *(const bf16x8*)(sKn + fr * 136 + 32 * m + 8 * fq);
                pc = __builtin_amdgcn_mfma_f32_16x16x32_bf16(aa, bb, pc, 0, 0, 0); }
            const float pv[4] = {pc.x, pc.y, pc.z, pc.w};
#pragma unroll
            for (int j = 0; j < 4; ++j) { const int t = fq * 4 + j; sPm[t * 24 + fr] = f2bf(fr <= t ? pv[j] : 0.f); }
        }
        f32x4 O = {0.f, 0.f, 0.f, 0.f};
#pragma unroll
        for (int m = 0; m < 4; ++m) {
            const u32x2 lo = *(const u32x2*)(sQs + fr * 136 + 32 * m + 4 * fq), hi = *(const u32x2*)(sQs + fr * 136 + 32 * m + 16 + 4 * fq);
            const u32x4 aw = {lo.x, lo.y, hi.x, hi.y};
            u32x4 bw; bw.x = pk2(acc[2 * m].x, acc[2 * m].y); bw.y = pk2(acc[2 * m].z, acc[2 * m].w); bw.z = pk2(acc[2 * m + 1].x, acc[2 * m + 1].y); bw.w = pk2(acc[2 * m + 1].z, acc[2 * m + 1].w);
            O = __builtin_amdgcn_mfma_f32_16x16x32_bf16(__builtin_bit_cast(bf16x8, aw), __builtin_bit_cast(bf16x8, bw), O, 0, 0, 0);
        }
        __syncthreads();
        const u32x4 zero4 = {0u, 0u, 0u, 0u};
        const u32x4 bvw = fq < 2 ? *(const u32x4*)(sVT + e * 24 + fq * 8) : zero4; const bf16x8 bV = __builtin_bit_cast(bf16x8, bvw);
        { const u32x4 aw = fq < 2 ? *(const u32x4*)(sPm + fr * 24 + fq * 8) : zero4;
          O = __builtin_amdgcn_mfma_f32_16x16x32_bf16(__builtin_bit_cast(bf16x8, aw), bV, O, 0, 0, 0); }
#pragma unroll
        for (int kt = 0; kt < 8; ++kt) {
            const f32x4 dc = *(const f32x4*)(sDec + kt * 16 + fq * 4);
            acc[kt] = acc[kt] * dc;
            const u32x4 aw = fq < 2 ? *(const u32x4*)(sKeT + (kt * 16 + fr) * 24 + fq * 8) : zero4;
            acc[kt] = __builtin_amdgcn_mfma_f32_16x16x32_bf16(__builtin_bit_cast(bf16x8, aw), bV, acc[kt], 0, 0, 0);
        }
        { const float ov[4] = {O.x, O.y, O.z, O.w};
#pragma unroll
          for (int j = 0; j < 4; ++j) OC[(size_t)HC_TOK(ch, fq * 4 + j) * 512 + h * 128 + e] = f2bf(ov[j]); }
    }
#undef HC_LOAD
#undef HC_TOK
    if (!smp) {
#pragma unroll
        for (int kt = 0; kt < 8; ++kt) { float* dp = a.out + O_SH + ((size_t)((b * 2 + dir) * 4 + h) * 128 + kt * 16 + fq * 4) * 128 + e; dp[0] = acc[kt].x; dp[128] = acc[kt].y; dp[256] = acc[kt].z; dp[384] = acc[kt].w; }
    }
    __syncthreads();
}
__device__ __forceinline__ void scan_phase(const Args& a, unsigned char* lds) {
    const int tid = opq((int)threadIdx.x), lane = tid & 63, wave = __builtin_amdgcn_readfirstlane(tid >> 6);
    unsigned* qc = (unsigned*)(a.ws + WS_QCTR);
    if (gridDim.x != 256) {
        int* sj = (int*)(lds + 65536);
        for (;;) {
            if (tid == 0) *sj = (int)atomicAdd(qc + 1, 1u);
            __syncthreads();
            const int job = *sj;
            __syncthreads();
            if (job >= 160) break;
            if (job < 32) hgrn_chain(a, lds, true, job); else hgrn_chain(a, lds, false, job - 32);
        }
        unsigned char* wl = lds + wave * 16384;
        for (;;) {
            int j = 0;
            if (lane == 0) j = (int)atomicAdd(qc, 1u);
            j = __builtin_amdgcn_readfirstlane(j);
            if (j >= 1536) break;
            if (j < 512) rwkv_wjob<1>(a, wl, true, j, lane); else rwkv_wjob<2>(a, wl, false, j - 512, lane);
        }
        return;
    }
    if (blockIdx.x < 32 || blockIdx.x >= 160) {
#ifdef PROBE_LONG
        const unsigned long long th0_ = wall_clock64();
#endif
        if (blockIdx.x < 32) hgrn_chain(a, lds, true, (int)blockIdx.x);
#ifdef PROBE_LONG
        if (PROBE_LONG == 2 && blockIdx.x == 0 && tid == 0) a.out[0] += (float)(wall_clock64() - th0_) * 1e-4f;
#endif
        int* sj = (int*)(lds + 65536);
        for (;;) {
            if (tid == 0) *sj = (int)atomicAdd(qc + 1, 1u);
            __syncthreads();
            const int job = *sj;
            __syncthreads();
            if (job >= 128) break;
            hgrn_chain(a, lds, false, job);
        }
#ifdef PROBE_LONG
        if (PROBE_LONG == 3 && blockIdx.x == 160 && tid == 0) a.out[0] += (float)(wall_clock64() - th0_) * 1e-4f;
#endif
    } else if (wave < 4) {
#ifdef PROBE_LONG
        const unsigned long long tl0_ = wall_clock64();
#endif
        __builtin_amdgcn_s_setprio(3);
        rwkv_wjob<1>(a, lds + wave * 16384, true, ((int)blockIdx.x - 32) * 4 + wave, lane);
        __builtin_amdgcn_s_setprio(0);
#ifdef PROBE_LONG
        if (PROBE_LONG == 1 && blockIdx.x == 32 && wave == 0 && lane == 0) a.out[0] += (float)(wall_clock64() - tl0_) * 1e-4f;
#endif
    } else return;
    unsigned char* wl = lds + wave * 16384;
    for (;;) {
        int j = 0;
        if (lane == 0) j = (int)atomicAdd(qc, 1u);
        j = __builtin_amdgcn_readfirstlane(j);
        if (j >= 1024) break;
        rwkv_wjob<2>(a, wl, false, j, lane);
    }
}

__device__ __forceinline__ void post1_phase(const Args& a) {
    const int lane = opq((int)threadIdx.x) & 63, wave = opq((int)threadIdx.x) >> 6, gw = blockIdx.x * 8 + wave, NGW = gridDim.x * 8;
    unsigned char* ws = a.ws;
    const bf16* OCF = (const bf16*)(ws + WS_OCF); const bf16* OCB = (const bf16*)(ws + WS_OCB); const bf16* ODF = (const bf16*)(ws + WS_ODF); const bf16* ODB = (const bf16*)(ws + WS_ODB);
    const float* HG = (const float*)(ws + WS_HG); const bf16* R = (const bf16*)(ws + WS_R); const bf16* KT = (const bf16*)(ws + WS_KT); const bf16* V1 = (const bf16*)(ws + WS_V1); const bf16* G = (const bf16*)(ws + WS_G);
    bf16* CAT = (bf16*)(ws + WS_CAT2);
    const int col = lane * 8;
    for (int t = gw; t < NTOK; t += NGW) {
        {
            const u32x4 xa = *(const u32x4*)(OCF + (size_t)t * 512 + col), xb = *(const u32x4*)(OCB + (size_t)t * 512 + col);
            float x[8], ss = 0.f;
#pragma unroll
            for (int k = 0; k < 4; ++k) { x[2 * k] = bflo(xa[k]) + bflo(xb[k]); x[2 * k + 1] = bfhi(xa[k]) + bfhi(xb[k]); }
#pragma unroll
            for (int k = 0; k < 8; ++k) ss += x[k] * x[k];
            ss += __shfl_xor(ss, 1); ss += __shfl_xor(ss, 2); ss += __shfl_xor(ss, 4); ss += __shfl_xor(ss, 8);
            const float rs = rsqrtf(ss * (1.f / 128.f) + 1e-6f);
            const float* gn = a.in[24] + (col & 127); const float* gc = HG + (size_t)t * 2560 + 2048 + col;
            float y[8];
#pragma unroll
            for (int k = 0; k < 8; ++k) y[k] = x[k] * rs * gn[k] * silu(gc[k]);
            u32x4 w; w.x = pk2(y[0], y[1]); w.y = pk2(y[2], y[3]); w.z = pk2(y[4], y[5]); w.w = pk2(y[6], y[7]);
            *(u32x4*)(CAT + (size_t)t * 1024 + col) = w;
        }
        {
            const u32x4 xa = *(const u32x4*)(ODF + (size_t)t * 512 + col), xb = *(const u32x4*)(ODB + (size_t)t * 512 + col);
            const u32x4 rw = *(const u32x4*)(R + (size_t)t * 512 + col), kw = *(const u32x4*)(KT + (size_t)t * 512 + col), vw = *(const u32x4*)(V1 + (size_t)t * 512 + col), gw_ = *(const u32x4*)(G + (size_t)t * 512 + col);
            float x[8], r[8], kt[8], v[8], g[8], sm = 0.f, bs = 0.f;
#pragma unroll
            for (int k = 0; k < 4; ++k) { x[2 * k] = bflo(xa[k]) + bflo(xb[k]); x[2 * k + 1] = bfhi(xa[k]) + bfhi(xb[k]); r[2 * k] = bflo(rw[k]); r[2 * k + 1] = bfhi(rw[k]);
                kt[2 * k] = bflo(kw[k]); kt[2 * k + 1] = bfhi(kw[k]); v[2 * k] = bflo(vw[k]); v[2 * k + 1] = bfhi(vw[k]); g[2 * k] = bflo(gw_[k]); g[2 * k + 1] = bfhi(gw_[k]); }
            const float* rk = a.in[33] + col; const float* lg = a.in[34] + col; const float* lbb = a.in[35] + col;
#pragma unroll
            for (int k = 0; k < 8; ++k) { sm += x[k]; bs += r[k] * kt[k] * rk[k]; }
            sm += __shfl_xor(sm, 1); sm += __shfl_xor(sm, 2); sm += __shfl_xor(sm, 4);
            bs += __shfl_xor(bs, 1); bs += __shfl_xor(bs, 2); bs += __shfl_xor(bs, 4);
            const float mean = sm * (1.f / 64.f); float vs = 0.f;
#pragma unroll
            for (int k = 0; k < 8; ++k) { const float d = x[k] - mean; vs += d * d; }
            vs += __shfl_xor(vs, 1); vs += __shfl_xor(vs, 2); vs += __shfl_xor(vs, 4);
            const float rs = rsqrtf(vs * (1.f / 64.f) + 64e-5f);
            float y[8];
#pragma unroll
            for (int k = 0; k < 8; ++k) y[k] = ((x[k] - mean) * rs * lg[k] + lbb[k] + bs * v[k]) * g[k];
            u32x4 w; w.x = pk2(y[0], y[1]); w.y = pk2(y[2], y[3]); w.z = pk2(y[4], y[5]); w.w = pk2(y[6], y[7]);
            *(u32x4*)(CAT + (size_t)t * 1024 + 512 + col) = w;
        }
    }
}

#define LAS __attribute__((address_space(3)))
#define XB_TMO      128
#define XB_XCNT(j)  (256  + 64 * (j))
#define XB_XSUB(j)  (1280 + 64 * (j))
#define XB_XGEN(j)  (2304 + 64 * (j))
#define XB_TOP      3328
#define XB_TOPGEN   3392
#define XCD_BAR_WORDS 3456
#define XB_SPIN_CAP (1u << 18)

__device__ __forceinline__ unsigned xb_ld(unsigned* p)              { return __hip_atomic_load(p, __ATOMIC_RELAXED, __HIP_MEMORY_SCOPE_AGENT); }
__device__ __forceinline__ unsigned xb_add(unsigned* p, unsigned v) { return __hip_atomic_fetch_add(p, v, __ATOMIC_RELAXED, __HIP_MEMORY_SCOPE_AGENT); }
__device__ __forceinline__ unsigned xb_xcc_id() { return (unsigned)__builtin_amdgcn_s_getreg((3 << 11) | 20) & 0xFu; }
#define XB_SPIN(cond, bar) do { unsigned _sp = 0; while (cond) { __builtin_amdgcn_s_sleep(1); \
    if ((++_sp & 255u) == 0u) { if (xb_ld(&(bar)[XB_TMO])) break; if (_sp > XB_SPIN_CAP) { atomicAdd(&(bar)[XB_TMO], 1u); break; } } } } while (0)

struct XcdBarrier {
    unsigned* bar; unsigned x;
    volatile LAS unsigned* st;
};

__device__ __forceinline__ XcdBarrier xcd_barrier_post(unsigned* bar, volatile LAS unsigned* st) {
    XcdBarrier b; b.bar = bar; b.x = xb_xcc_id(); b.st = st;
    if (threadIdx.x == 0) (void)xb_add(&bar[XB_XCNT(b.x)], 1u);
    return b;
}
__device__ __forceinline__ void xcd_barrier_complete(unsigned* bar, unsigned x, unsigned& nloc, unsigned& nx) {
    const unsigned G = gridDim.x * gridDim.y * gridDim.z;
    unsigned sum, cnt, mine, sp = 0u;
    for (;;) {
        sum = 0u; cnt = 0u; mine = 0u;
#pragma unroll
        for (unsigned j = 0; j < 16; ++j) { const unsigned c = xb_ld(&bar[XB_XCNT(j)]); sum += c; cnt += (c > 0u) ? 1u : 0u; mine = (j == x) ? c : mine; }
        if (sum == G) break;
        __builtin_amdgcn_s_sleep(1);
        if ((++sp & 255u) == 0u) { if (xb_ld(&bar[XB_TMO])) break; if (sp > XB_SPIN_CAP) { atomicAdd(&bar[XB_TMO], 1u); break; } }
    }
    nloc = mine > 0u ? mine : 1u; nx = cnt > 0u ? cnt : 1u;
}

__device__ __forceinline__ void xcd_barrier(const XcdBarrier& b) {
    asm volatile("s_waitcnt vmcnt(0)" ::: "memory");
    __syncthreads();
    if (threadIdx.x == 0) {
        unsigned* bar = b.bar;
        __builtin_amdgcn_s_waitcnt(0);
        unsigned nloc = b.st[0], nx = b.st[1];
        if (nloc == 0u) { xcd_barrier_complete(bar, b.x, nloc, nx); b.st[0] = nloc; b.st[1] = nx; }
        const unsigned old = xb_add(&bar[XB_XSUB(b.x)], 1u);
        const unsigned gen = old / nloc;
        if (old + 1u == (gen + 1u) * nloc) {
            __builtin_amdgcn_fence(__ATOMIC_RELEASE, "agent");
            asm volatile("s_waitcnt vmcnt(0)" ::: "memory");
            const unsigned og = xb_add(&bar[XB_TOP], 1u);
            const unsigned tg = og / nx;
            if (og + 1u == (tg + 1u) * nx) xb_add(&bar[XB_TOPGEN], 1u);
            else XB_SPIN(xb_ld(&bar[XB_TOPGEN]) == tg, bar);
            __builtin_amdgcn_fence(__ATOMIC_ACQUIRE, "agent");
            xb_add(&bar[XB_XGEN(b.x)], 1u);
            asm volatile("s_waitcnt vmcnt(0)" ::: "memory");
        } else {
            XB_SPIN(xb_ld(&bar[XB_XGEN(b.x)]) == gen, bar);
            __builtin_amdgcn_fence(__ATOMIC_ACQUIRE, "agent");
            asm volatile("s_waitcnt vmcnt(0)" ::: "memory");
        }
    }
    __syncthreads();
}

constexpr int LDS_BYTES = 131072 + 256, NPHASE = 21;
constexpr size_t WS_BAR = 512 * 1024;
#ifdef DBG_USE_H
#define DBG_A5 H
#else
#define DBG_A5 (const bf16*)(ws + WS_CAT)
#endif
__global__ void __launch_bounds__(512, 2) trunk_fwd(Args a) {
    extern __shared__ __attribute__((aligned(16))) unsigned char lds[];
    cg::grid_group grid = cg::this_grid();
    unsigned char* ws = a.ws;
    const float* MOD = (const float*)(ws + WS_MOD);
    bf16* H = (bf16*)(ws + WS_H);
    XcdBarrier bar; bar.bar = (unsigned*)(ws + WS_BAR); bar.x = 0; bar.st = nullptr;
    if (a.ph_hi - a.ph_lo > 1) {
        volatile LAS unsigned* st = (volatile LAS unsigned*)((LAS unsigned char*)lds + 131072);
        if (opq((int)threadIdx.x) < 2) st[opq((int)threadIdx.x)] = 0u;
        __syncthreads();
        bar = xcd_barrier_post((unsigned*)(ws + WS_BAR), st);
    }
    if (a.ph_hi == 0x7fffffff) grid.sync();
#define GBAR() xcd_barrier(bar)
#ifdef ONLY_PHASE
#define PH(k) if ((k) == ONLY_PHASE)
#else
#define PH(k) if (a.ph_lo <= (k) && (k) < a.ph_hi)
#endif
#ifdef PROBE_MASK
#ifndef PROBE_SCALE
#define PROBE_SCALE 1e-4f
#endif
    unsigned long long tacc = 0, tprev = wall_clock64();
#define SEAM(k) { if (a.ph_lo <= (k) && (k) + 1 < a.ph_hi) GBAR(); const unsigned long long tn_ = wall_clock64(); if ((PROBE_MASK >> (k)) & 1) tacc += tn_ - tprev; tprev = tn_; }
#else
#define SEAM(k) if (a.ph_lo <= (k) && (k) + 1 < a.ph_hi) GBAR();
#endif
    PH(0) { phase0(a, lds); } SEAM(0)
    PH(1) { norm_phase<0, false>(a, a.in[12], 0, 0, 1024); } SEAM(1)
    PH(2) { EpiF32 E{(float*)(ws + WS_PROJ), 2304}; run_gemm(lds, H, (const bf16*)(ws + WS_EVIN), 9, 1024, 1024, 9, E);
            if (blockIdx.x >= 32) {
                const int w_ = ((int)blockIdx.x - 32) * 8 + (opq((int)threadIdx.x) >> 6), nw_ = ((int)gridDim.x - 32) * 8;
                tr_range(a, lds, 10112, 12832, w_, nw_); fill_l1_small(a, ((int)blockIdx.x - 32) * 512 + opq((int)threadIdx.x), ((int)gridDim.x - 32) * 512); } } SEAM(2)
    PH(3) { qkv_post(a, lds); } SEAM(3)
    PH(4) { attn_phase(a, lds); } SEAM(4)
#ifdef DBG_COPY_CAT
    PH(5) { const bf16* C_ = (const bf16*)(ws + WS_CAT); for (int i = blockIdx.x * 512 + opq((int)threadIdx.x); i < NTOK * 1024; i += gridDim.x * 512) {
#if DBG_COPY_CAT == 2
        const int t_ = i >> 10, c_ = i & 1023; a.out[i] = bf2f(c_ < 512 ? ((const bf16*)(ws + WS_QB))[t_ * 512 + c_] : ((const bf16*)(ws + WS_KBS))[(size_t)t_ * 96 + (c_ - 512) % 96]);
#elif DBG_COPY_CAT == 3
        const int t_ = i >> 10, c_ = i & 1023; a.out[i] = bf2f(c_ < 512 ? ((const bf16*)(ws + WS_VBTS))[t_ * 96 + c_ % 96] : ((const bf16*)(ws + WS_KBC))[(size_t)t_ * 64 + (c_ - 512) % 64]) + bf2f(((const bf16*)(ws + WS_VBTC))[(size_t)t_ * 64 + c_ % 64]);
#else
        a.out[i] = bf2f(C_[i]);
#endif
    } } SEAM(5)
#else
    PH(5) { EpiResid E{a.out, MOD + 2048,(float*)(ws + WS_TMP), a.in[0], a.in[1]}; run_gemm(lds, DBG_A5, (const bf16*)(ws + WS_EVOUT), 4, 1024, 1024, 4, E);
            if (blockIdx.x >= 128) {
                const int w_ = ((int)blockIdx.x - 128) * 8 + (opq((int)threadIdx.x) >> 6), nw_ = ((int)gridDim.x - 128) * 8;
                tr_range(a, lds, 1664, 4480, w_, nw_); tr_range(a, lds, 7296, 8704, w_, nw_); } } SEAM(5)
#endif
    PH(6) { norm_phase<1, false>(a, a.in[13], 0, 3072, 4096); } SEAM(6)
    PH(7) { EpiBf16 E{(bf16*)(ws + WS_U), 5632}; run_gemm(lds, H, (const bf16*)(ws + WS_UP0), 22, 1024, 1024, 22, E); } SEAM(7)
    PH(8) { conv_phase(a, 0); } SEAM(8)
    PH(9) { EpiResid E{a.out, MOD + 5120,(float*)(ws + WS_TMP), a.out, a.out + (size_t)NCTX * DM}; run_gemm(lds, (const bf16*)(ws + WS_ACT), (const bf16*)(ws + WS_DOWN0), 8, 1408, 2816, 4, E); } SEAM(9)
    PH(10) { norm_phase<1, true>(a, a.in[12] + 1024, 1, 0, 1024); } SEAM(10)
    PH(11) { EpiOdIn E{(float*)(ws + WS_HG), (bf16*)(ws + WS_PR), (const float*)(ws + WS_LB)}; run_gemm(lds, H, (const bf16*)(ws + WS_ODIN), 18, 1024, 1024, 18, E);
            if (blockIdx.x >= 64) {
                const int w_ = ((int)blockIdx.x - 64) * 8 + (opq((int)threadIdx.x) >> 6), nw_ = ((int)gridDim.x - 64) * 8;
                tr_range(a, lds, 4480, 7296, w_, nw_); tr_range(a, lds, 8704, 10112, w_, nw_); } } SEAM(11)
    PH(12) { prep1_phase(a); } SEAM(12)
    PH(13) { EpiLora E{(float*)(ws + WS_WF), (float*)(ws + WS_WB), (const bf16*)(ws + WS_KK), (const bf16*)(ws + WS_K1), (bf16*)(ws + WS_KKA), (bf16*)(ws + WS_KT), (bf16*)(ws + WS_G), a.in[26], a.in[28], a.in[32]};
             run_gemm(lds, (const bf16*)(ws + WS_AP), (const bf16*)(ws + WS_LORA), 8, 384, 384, 8, E); } SEAM(13)
    PH(14) { scan_phase(a, lds); } SEAM(14)
    PH(15) { post1_phase(a); } SEAM(15)
    PH(16) { EpiResid E{a.out, MOD + 5 * 6144 + 2048,(float*)(ws + WS_TMP), a.out, a.out + (size_t)NCTX * DM}; run_gemm(lds, (const bf16*)(ws + WS_CAT2), (const bf16*)(ws + WS_ODOUT), 4, 1024, 1024, 4, E); } SEAM(16)
    PH(17) { norm_phase<1, false>(a, a.in[13] + 1024, 1, 3072, 4096); } SEAM(17)
    PH(18) { EpiBf16 E{(bf16*)(ws + WS_U), 5632}; run_gemm(lds, H, (const bf16*)(ws + WS_UP1), 22, 1024, 1024, 22, E); } SEAM(18)
    PH(19) { conv_phase(a, 1); } SEAM(19)
    PH(20) { EpiResid E{a.out, MOD + 5 * 6144 + 5120,(float*)(ws + WS_TMP), a.out, a.out + (size_t)NCTX * DM}; run_gemm(lds, (const bf16*)(ws + WS_ACT), (const bf16*)(ws + WS_DOWN1), 8, 1408, 2816, 4, E); } SEAM(20)
    PH(21) { norm_phase<2, true>(a, a.in[14], 0, 0, 0); }
#ifdef PROBE_MASK
    { unsigned long long tn_ = wall_clock64(); if ((PROBE_MASK >> 21) & 1) tacc += tn_ - tprev;
#ifdef PROBE_SYNCS
      for (int i_ = 0; i_ < 20; ++i_) GBAR();
      tacc = wall_clock64() - tn_;
#endif
#ifdef PROBE_LONG
      __syncthreads(); if (blockIdx.x == PROBE_LONG / 4 && opq((int)threadIdx.x) == 0) a.out[0] += (float)(*(unsigned*)(lds + 131072 + 64)) * PROBE_SCALE;
#else
      if (blockIdx.x == 0 && opq((int)threadIdx.x) == 0) a.out[0] += (float)tacc * PROBE_SCALE;
#endif
    }
#endif
#undef PH
#undef SEAM
}

extern "C" void kernel_launch(void* const* d_in, const int* in_sizes, int n_in, void* d_out, int out_size, void* d_ws, size_t ws_size, hipStream_t stream) {
    static int grid = 0;
    if (grid == 0) {
        int dev = 0, cus = 0, per_cu = 0;
        if (n_in != 40 || out_size != 16777216 || ws_size < 256 * MiB) { fprintf(stderr, "kernel_launch: unexpected shapes n_in %d out %d ws %zu\n", n_in, out_size, ws_size); grid = -1; return; }
        (void)hipGetDevice(&dev); (void)hipDeviceGetAttribute(&cus, hipDeviceAttributeMultiprocessorCount, dev);
        if (hipFuncSetAttribute((const void*)trunk_fwd, hipFuncAttributeMaxDynamicSharedMemorySize, LDS_BYTES) != hipSuccess) { fprintf(stderr, "kernel_launch: hipFuncSetAttribute failed\n"); grid = -1; return; }
        if (hipOccupancyMaxActiveBlocksPerMultiprocessor(&per_cu, (const void*)trunk_fwd, 512, LDS_BYTES) != hipSuccess || per_cu < 1) { fprintf(stderr, "kernel_launch: occupancy query says %d\n", per_cu); per_cu = 1; }
        (void)hipGetLastError();
        grid = cus * (per_cu > 1 ? 1 : per_cu);
        if (grid <= 0) grid = 256;
    }
    if (grid < 0) return;
    Args a{};
    for (int i = 0; i < 40; ++i) a.in[i] = (const float*)d_in[i];
    a.out = (float*)d_out; a.ws = (unsigned char*)d_ws;
#if MK_N_LAUNCHES == 1
    if (hipMemsetAsync((unsigned char*)d_ws + WS_BAR, 0, XCD_BAR_WORDS * sizeof(unsigned), stream) != hipSuccess) { fprintf(stderr, "kernel_launch: memset of the barrier words failed\n"); return; }
    a.ph_lo = 0; a.ph_hi = NPHASE + 1;
    void* args[] = {&a};
    hipError_t e = hipLaunchCooperativeKernel((const void*)trunk_fwd, dim3(grid), dim3(512), args, LDS_BYTES, stream);
    if (e != hipSuccess) fprintf(stderr, "kernel_launch: cooperative launch failed: %s (grid %d)\n", hipGetErrorString(e), grid);
#else
#ifndef RUN_UPTO
#define RUN_UPTO NPHASE
#endif
    for (int p = 0; p <= RUN_UPTO; ++p) { a.ph_lo = p; a.ph_hi = p + 1; hipLaunchKernelGGL(trunk_fwd, dim3(grid), dim3(512), LDS_BYTES, stream, a); }
#endif
}
```

```cpp
#include <hip/hip_runtime.h>
#include <hip/hip_cooperative_groups.h>
#include <cstdio>
#include <cstdint>
namespace cg = cooperative_groups;
#ifndef MK_N_LAUNCHES
#define MK_N_LAUNCHES 1
#endif
namespace pg8 {
#define PG8_LAS __attribute__((address_space(3)))
typedef unsigned short bf16_t;
typedef short bf16x8 __attribute__((ext_vector_type(8)));
typedef float f32x4 __attribute__((ext_vector_type(4)));
typedef unsigned u32x4 __attribute__((ext_vector_type(4)));
constexpr int BM = 256, BK = 64, HALF = 128, HTB = HALF * BK * 2  , STAGE_BYTES = 8 * HTB, NXCD = 8, WGM = 8;

__host__ __device__ __forceinline__ int lds_byte(int r, int c) { const int st = (r >> 4) * 2 + (c >> 5), rr = r & 15, cc = c & 31, ob = rr * 64 + cc * 2; return st * 1024 + (ob ^ (((ob >> 9) & 1) << 5)); }
__host__ __device__ __forceinline__ void stage_rc(int b, int& R, int& C) { const int st = b / 1024, sb = b % 1024, swz = sb ^ (((sb >> 9) & 1) << 5); R = (st >> 1) * 16 + swz / 64; C = (st & 1) * 32 + (swz % 64) / 2; }
__host__ __device__ __forceinline__ int perm32(int rho) { const int n = rho >> 4, i = rho & 15; return 8 * (i >> 2) + 4 * n + (i & 3); }

struct Unit { int pm, pn; };
struct Gemm { const bf16_t* A; const bf16_t* Bt; int M, N, K, ld, nNr; };

struct StaticOrder {
    int nM, nN, nwg, G, c;
    __host__ __device__ void init(int M, int N, int G_, int c_) { nM = M / BM; nN = N / BM; nwg = nM * nN; G = G_; c = c_; }
    __host__ __device__ bool next(int i, Unit& u) const {
        const long L = (long)i * G + c; if (L >= nwg) return false;
        int wgid = (int)L; { const int q = nwg / NXCD, r = nwg % NXCD, xcd = wgid % NXCD, off = wgid / NXCD; wgid = (xcd < r ? xcd * (q + 1) : r * (q + 1) + (xcd - r) * q) + off; }
        const int nig = WGM * nN, gid = wgid / nig, fm = gid * WGM, gsz = (nM - fm) < WGM ? (nM - fm) : WGM;
        u.pm = fm + ((wgid % nig) % gsz); u.pn = (wgid % nig) / gsz; return true;
    }
    __device__ __forceinline__ void a_ready(const Unit&) const {}
    __device__ __forceinline__ void done(const Unit&) const {}
};

template <class Epi, class Sched, bool STAMP = false>
__device__ __forceinline__ void gemm_phase(PG8_LAS unsigned char* lds, const Gemm g, const Sched& S, const Epi& E, unsigned long long* stamps) {
    const int tid = threadIdx.x, wid = __builtin_amdgcn_readfirstlane(tid >> 6), lane = tid & 63, wr = wid >> 2, wc = wid & 3, fr = lane & 15, fq = lane >> 4;
    const int K = g.K, nt = K / BK;
    int ts_lo = 0, ts_hi = 0, nts = 0; const unsigned long long rt_entry = 0ull;
#define PG8_STAMP() do { if (STAMP && wid == 0 && nts < 64) { const unsigned long long _c = (unsigned long long)clock64(); \
        ts_lo = (lane == nts) ? (int)(unsigned)_c : ts_lo; ts_hi = (lane == nts) ? (int)(unsigned)(_c >> 32) : ts_hi; ++nts; } } while (0)
    PG8_STAMP();
    unsigned voffA[2], voffB[2];
#pragma unroll
    for (int i = 0; i < 2; ++i) { int R, C; stage_rc(tid * 16 + i * 8192, R, C); const int Rb = Epi::PERM ? ((R & ~31) + perm32(R & 31)) : R;
        voffA[i] = (unsigned)(R * g.ld + C) * 2u; voffB[i] = (unsigned)(Rb * g.ld + C) * 2u; }
    const size_t kstep = (size_t)(BK * 2);
    const size_t hstep = (size_t)HALF * g.ld * 2;
    const size_t tstep = 2 * hstep;
    const unsigned ldsw = (unsigned)wid * 1024u;
    const int aoff = lds_byte(wr * 64 + fr, fq * 8), boff = lds_byte(wc * 32 + fr, fq * 8);
#define PG8_SA(b, h) (((b) * 2 + (h)) * HTB)
#define PG8_SB(b, h) ((4 + (b) * 2 + (h)) * HTB)
#define PG8_STAGE(bufoff, gbase, voff) do { _Pragma("unroll") for (int _i = 0; _i < 2; ++_i) \
        __builtin_amdgcn_global_load_lds((const unsigned*)((const char*)(gbase) + (voff)[_i]), (PG8_LAS unsigned*)(lds + (bufoff) + ldsw + _i * 8192), 16, 0, 0); } while (0)
#define PG8_LDA(dst, b, h) do { _Pragma("unroll") for (int m = 0; m < 4; ++m) _Pragma("unroll") for (int k = 0; k < 2; ++k) dst[m][k] = *(const PG8_LAS bf16x8*)(lds + PG8_SA(b, h) + aoff + m * 2048 + k * 1024); } while (0)
#define PG8_LDB(dst, b, h) do { _Pragma("unroll") for (int n = 0; n < 2; ++n) _Pragma("unroll") for (int k = 0; k < 2; ++k) dst[n][k] = *(const PG8_LAS bf16x8*)(lds + PG8_SB(b, h) + boff + n * 2048 + k * 1024); } while (0)
#define PG8_MMA(ai, bj, At, Bt) do { __builtin_amdgcn_s_setprio(1); _Pragma("unroll") for (int m = 0; m < 4; ++m) _Pragma("unroll") for (int n = 0; n < 2; ++n) _Pragma("unroll") for (int k = 0; k < 2; ++k) \
        acc[ai][bj][m][n] = __builtin_amdgcn_mfma_f32_16x16x32_bf16(Bt[n][k], At[m][k], acc[ai][bj][m][n], 0, 0, 0); __builtin_amdgcn_s_setprio(0); } while (0)
#define PG8_WAIT_V(n) asm volatile("s_waitcnt vmcnt(" #n ")" ::: "memory")
#define PG8_WAIT_L(n) asm volatile("s_waitcnt lgkmcnt(" #n ")" ::: "memory")
#define PG8_BAR __builtin_amdgcn_s_barrier()
#define PG8_SCHED __builtin_amdgcn_sched_barrier(0)
    Unit cur, nxt; int ui = 0;
    if (!S.next(0, cur)) return;
    f32x4 acc[2][2][4][2];
#pragma unroll
    for (int a = 0; a < 2; ++a)
#pragma unroll
        for (int b = 0; b < 2; ++b)
#pragma unroll
            for (int m = 0; m < 4; ++m)
#pragma unroll
                for (int n = 0; n < 2; ++n) acc[a][b][m][n] = (f32x4){0.f, 0.f, 0.f, 0.f};
    bf16x8 At[4][2], B0[2][2], B1[2][2];
    const char* cA = (const char*)g.A + (size_t)cur.pm * tstep + (size_t)(cur.pn / g.nNr) * K * 2; const char* cB = (const char*)g.Bt + (size_t)(cur.pn % g.nNr) * tstep + (size_t)(cur.pn / g.nNr) * K * 2;
    S.a_ready(cur);
    PG8_STAGE(PG8_SB(0, 0), cB, voffB); PG8_STAGE(PG8_SA(0, 0), cA, voffA); PG8_STAGE(PG8_SB(0, 1), cB + hstep, voffB); PG8_STAGE(PG8_SA(0, 1), cA + hstep, voffA);
    if (wr == 1) PG8_BAR;
    PG8_WAIT_V(4); PG8_BAR;
    PG8_STAGE(PG8_SB(1, 0), cB + kstep, voffB); PG8_STAGE(PG8_SA(1, 0), cA + kstep, voffA); PG8_STAGE(PG8_SB(1, 1), cB + hstep + kstep, voffB);
    PG8_WAIT_V(6); PG8_BAR;
    PG8_STAMP();
    for (;;) {
        const bool has_next = S.next(ui + 1, nxt);
        const char* nA = has_next ? (const char*)g.A + (size_t)nxt.pm * tstep + (size_t)(nxt.pn / g.nNr) * K * 2 : cA; const char* nB = has_next ? (const char*)g.Bt + (size_t)(nxt.pn % g.nNr) * tstep + (size_t)(nxt.pn / g.nNr) * K * 2 : cB;
        for (int t = 0; t < nt; t += 2) {
            const bool last = (t == nt - 2);
            const char* a1 = cA + (size_t)(t + 1) * kstep;
            const char* a2 = last ? nA : cA + (size_t)(t + 2) * kstep; const char* b2 = last ? nB : cB + (size_t)(t + 2) * kstep;
            const char* a3 = a2 + kstep; const char* b3 = b2 + kstep;
            if (last && has_next) S.a_ready(nxt);
            PG8_LDB(B0, 0, 0); PG8_SCHED; PG8_LDA(At, 0, 0); PG8_STAGE(PG8_SA(1, 1), a1 + hstep, voffA);
            PG8_WAIT_L(8); PG8_BAR; PG8_WAIT_L(0); PG8_MMA(0, 0, At, B0); PG8_BAR; PG8_SCHED;
            PG8_LDB(B1, 0, 1); PG8_STAGE(PG8_SB(0, 0), b2, voffB);
            PG8_BAR; PG8_WAIT_L(0); PG8_MMA(0, 1, At, B1); PG8_BAR;
            PG8_LDA(At, 0, 1); PG8_STAGE(PG8_SA(0, 0), a2, voffA);
            PG8_BAR; PG8_WAIT_L(0); PG8_MMA(1, 0, At, B0); PG8_BAR; PG8_SCHED;
            PG8_STAGE(PG8_SB(0, 1), b2 + hstep, voffB);
            PG8_WAIT_V(6); PG8_BAR; PG8_MMA(1, 1, At, B1); PG8_BAR;
            PG8_LDB(B0, 1, 0); PG8_SCHED; PG8_LDA(At, 1, 0); PG8_STAGE(PG8_SA(0, 1), a2 + hstep, voffA);
            PG8_WAIT_L(8); PG8_BAR; PG8_WAIT_L(0); PG8_MMA(0, 0, At, B0); PG8_BAR; PG8_SCHED;
            PG8_LDB(B1, 1, 1); PG8_STAGE(PG8_SB(1, 0), b3, voffB);
            PG8_BAR; PG8_WAIT_L(0); PG8_MMA(0, 1, At, B1); PG8_BAR;
            PG8_LDA(At, 1, 1); PG8_STAGE(PG8_SA(1, 0), a3, voffA);
            PG8_BAR; PG8_WAIT_L(0); PG8_MMA(1, 0, At, B0); PG8_BAR; PG8_SCHED;
            PG8_STAGE(PG8_SB(1, 1), b3 + hstep, voffB);
            PG8_WAIT_V(6); PG8_BAR; PG8_MMA(1, 1, At, B1); PG8_BAR;
        }
        PG8_STAMP();
        if constexpr (!Epi::AFTER_DRAIN) { E(acc, cur, wr, wc, fr, fq); S.done(cur); }
        PG8_STAMP();
        if (!has_next) break;
#pragma unroll
        for (int a = 0; a < 2; ++a)
#pragma unroll
            for (int b = 0; b < 2; ++b)
#pragma unroll
                for (int m = 0; m < 4; ++m)
#pragma unroll
                    for (int n = 0; n < 2; ++n) acc[a][b][m][n] = (f32x4){0.f, 0.f, 0.f, 0.f};
        cur = nxt; cA = nA; cB = nB; ++ui;
    }
    PG8_WAIT_V(0);
    if (wr == 0) PG8_BAR;
    PG8_BAR;
    if constexpr (Epi::AFTER_DRAIN) { E.fused(acc, cur, wr, wc, fr, fq, lds, wid, lane); S.done(cur); }
    PG8_STAMP();
    if (STAMP && wid == 0) { stamps[lane] = lane < nts ? (((unsigned long long)(unsigned)ts_hi << 32) | (unsigned)ts_lo) : 0ull;
        if (lane == 62) stamps[62] = rt_entry; }
#undef PG8_STAMP
#undef PG8_SA
#undef PG8_SB
#undef PG8_STAGE
#undef PG8_LDA
#undef PG8_LDB
#undef PG8_MMA
#undef PG8_WAIT_V
#undef PG8_WAIT_L
#undef PG8_BAR
#undef PG8_SCHED
}
}

using pg8::f32x4; using pg8::bf16x8;
typedef unsigned short bf16;
typedef unsigned u32x4 __attribute__((ext_vector_type(4)));
typedef unsigned u32x2 __attribute__((ext_vector_type(2)));
typedef float f32x2 __attribute__((ext_vector_type(2)));

constexpr size_t MiB = 1ull << 20;
constexpr int NTOK = 8192, NCTX = 4096, DM = 1024, DFF = 2816;
constexpr size_t WS_MOD = 0, WS_LAM = 256 * 1024, WS_LB = 256 * 1024 + 256, WS_QCTR = 256 * 1024 + 8192;
constexpr size_t WS_ODIN = 1 * MiB, WS_ODOUT = 10 * MiB, WS_UP1 = 12 * MiB, WS_DOWN1 = 23 * MiB, WS_LORA = 28 * MiB + 512 * 1024;
constexpr size_t WS_EVIN = 30 * MiB, WS_EVOUT = 34 * MiB + 512 * 1024, WS_UP0 = 36 * MiB + 512 * 1024, WS_DOWN0 = 47 * MiB + 512 * 1024;
constexpr size_t WS_H = 53 * MiB;
constexpr size_t WS_PROJ = 69 * MiB, WS_QA = 141 * MiB, WS_QB = 149 * MiB, WS_KAC = 157 * MiB, WS_VATC = 161 * MiB, WS_KBC = 165 * MiB, WS_VBTC = 166 * MiB,
                 WS_KAS = 167 * MiB, WS_VATS = 173 * MiB, WS_KBS = 179 * MiB, WS_VBTS = 180 * MiB + 512 * 1024, WS_CAT = 182 * MiB;
constexpr size_t WS_U = 69 * MiB, WS_ACT = 157 * MiB, WS_TMP = 69 * MiB;
constexpr size_t WS_KK = 53 * MiB, WS_KKA = 61 * MiB, WS_HG = 69 * MiB, WS_PR = 149 * MiB, WS_K1 = 178 * MiB,
                 WS_OCF = 149 * MiB, WS_OCB = 157 * MiB, WS_ODF = 165 * MiB, WS_ODB = 173 * MiB,
                 WS_KT = 186 * MiB, WS_WF = 194 * MiB, WS_WB = 210 * MiB, WS_G = 226 * MiB, WS_CAT2 = 234 * MiB,
                 WS_R = 30 * MiB, WS_V1 = 38 * MiB, WS_AP = 46 * MiB;
constexpr size_t O_AK = 8388608, O_AV = 10485760, O_BK = 12582912, O_BV = 13107200, O_SH = 13631488, O_SR = 15728640;

struct Args { const float* in[40]; float* out; unsigned char* ws; int ph_lo, ph_hi; };

typedef __bf16 bf16x2_t __attribute__((ext_vector_type(2)));
__device__ __forceinline__ unsigned pk2(float lo, float hi) { f32x2 v = {lo, hi}; bf16x2_t r = __builtin_convertvector(v, bf16x2_t); return __builtin_bit_cast(unsigned, r); }
__device__ __forceinline__ float bflo(unsigned w) { return __uint_as_float(w << 16); }
__device__ __forceinline__ float bfhi(unsigned w) { return __uint_as_float(w & 0xffff0000u); }
__device__ __forceinline__ float bf2f(bf16 b) { return __uint_as_float(((unsigned)b) << 16); }
__device__ __forceinline__ bf16 f2bf(float f) { return (bf16)(pk2(f, 0.f) & 0xffffu); }
__device__ __forceinline__ float sigm(float x) { return 1.f / (1.f + __expf(-x)); }
__device__ __forceinline__ float silu(float x) { return x / (1.f + __expf(-x)); }
__device__ __forceinline__ float wave_sum(float v) {
#pragma unroll
    for (int o = 1; o < 64; o <<= 1) v += __shfl_xor(v, o);
    return v;
}
__device__ __forceinline__ int cond_of(int t) { return t < NCTX ? 0 : 1 + ((t - NCTX) >> 10); }
__device__ __forceinline__ int opq(int x) { asm volatile("" : "+v"(x)); return x; }
#define LDSWAIT() asm volatile("s_waitcnt lgkmcnt(0)" ::: "memory")

__device__ __forceinline__ void tr_item(const float* W, int ldw, bf16* WT, int ldo, float* scr, int lane) {
#pragma unroll 8
    for (int i = 0; i < 32; ++i) { const int kk = 2 * i + (lane >> 5); scr[kk * 33 + (lane & 31)] = W[(size_t)kk * ldw + (lane & 31)]; }
    LDSWAIT();
    const int c = lane & 7;
#pragma unroll
    for (int j = 0; j < 4; ++j) { const int n = (lane >> 3) + 8 * j; const float* s = scr + (8 * c) * 33 + n;
        u32x4 o; o.x = pk2(s[0 * 33], s[1 * 33]); o.y = pk2(s[2 * 33], s[3 * 33]); o.z = pk2(s[4 * 33], s[5 * 33]); o.w = pk2(s[6 * 33], s[7 * 33]);
        *(u32x4*)(WT + (size_t)n * ldo + 8 * c) = o; }
    LDSWAIT();
}
__device__ __forceinline__ void tr_mat(const float* W, int N, bf16* WT, int ldo, int r, float* scr, int lane) {
    const int nblk = N / 32, kb = r / nblk, nb = r % nblk;
    tr_item(W + (size_t)kb * 64 * N + nb * 32, N, WT + (size_t)nb * 32 * ldo + kb * 64, ldo, scr, lane);
}

__device__ __forceinline__ void tr_range(const Args& a, unsigned char* ldsbase, int lo, int hi, int w, int nw) {
    unsigned char* ws = a.ws; const int lane = opq((int)threadIdx.x) & 63, wave = opq((int)threadIdx.x) >> 6;
    float* scr = (float*)(ldsbase + wave * 8448);
    constexpr int I_EVIN = 16 * 72, I_EVOUT = 16 * 32, I_UP = 16 * 176, I_DOWN = 44 * 32, I_ODIN = 16 * 138, I_ODOUT = 16 * 32, I_CAV = 16 * 32;
    for (int it = lo + w; it < hi; it += nw) {
        int r = it;
        if (r < I_EVIN) { tr_mat(a.in[15], 2304, (bf16*)(ws + WS_EVIN), 1024, r, scr, lane); continue; } r -= I_EVIN;
        if (r < I_EVOUT) { tr_mat(a.in[16], 1024, (bf16*)(ws + WS_EVOUT), 1024, r, scr, lane); continue; } r -= I_EVOUT;
        if (r < I_UP) { tr_mat(a.in[36], 5632, (bf16*)(ws + WS_UP0), 1024, r, scr, lane); continue; } r -= I_UP;
        if (r < I_UP) { tr_mat(a.in[36] + (size_t)1024 * 5632, 5632, (bf16*)(ws + WS_UP1), 1024, r, scr, lane); continue; } r -= I_UP;
        if (r < I_DOWN) { tr_mat(a.in[39], 1024, (bf16*)(ws + WS_DOWN0), 2816, r, scr, lane); continue; } r -= I_DOWN;
        if (r < I_DOWN) { tr_mat(a.in[39] + (size_t)2816 * 1024, 1024, (bf16*)(ws + WS_DOWN1), 2816, r, scr, lane); continue; } r -= I_DOWN;
        if (r < I_ODIN) { tr_mat(a.in[21], 4416, (bf16*)(ws + WS_ODIN), 1024, r, scr, lane); continue; } r -= I_ODIN;
        if (r < I_ODOUT) { tr_mat(a.in[22], 1024, (bf16*)(ws + WS_ODOUT), 1024, r, scr, lane); continue; } r -= I_ODOUT;
        if (r < I_CAV) { const int bh = r / 32, rr = r % 32; tr_mat(a.in[3] + (size_t)bh * 512 * 128, 128, (bf16*)(ws + WS_VATS) + (size_t)bh * 128 * 1536, 1536, rr, scr, lane); continue; } r -= I_CAV;
        { const int bg = r / 16, rr = r % 16; tr_mat(a.in[5] + (size_t)bg * 512 * 64, 64, (bf16*)(ws + WS_VBTS) + (size_t)bg * 64 * 1536, 1536, rr, scr, lane); }
    }
}
__device__ __forceinline__ void fill_l1_small(const Args& a, int t, int nt) {
    unsigned char* ws = a.ws;
    u32x4* z = (u32x4*)((bf16*)(ws + WS_ODIN) + (size_t)4416 * 1024);
    for (int i = t; i < 192 * 1024 / 8; i += nt) z[i] = (u32x4){0u, 0u, 0u, 0u};
    bf16* L = (bf16*)(ws + WS_LORA);
    for (int i = t; i < 2048 * 384; i += nt) { const int n = i / 384, k = i % 384; float v = 0.f;
        if (n < 512) { if (k < 64) v = a.in[27][(size_t)k * 512 + n]; }
        else if (n < 1024) { if (k >= 64 && k < 128) v = a.in[27][(size_t)(64 + (k - 64)) * 512 + (n - 512)]; }
        else if (n < 1536) { if (k >= 128 && k < 192) v = a.in[29][(size_t)(k - 128) * 512 + (n - 1024)]; }
        else { if (k >= 192 && k < 320) v = a.in[30][(size_t)(k - 192) * 512 + (n - 1536)]; }
        L[i] = f2bf(v); }
}

__device__ __forceinline__ void phase0(const Args& a, unsigned char* lds) {
    const int tid = opq((int)threadIdx.x), lane = tid & 63, wave = tid >> 6;
    const int gw = blockIdx.x * 8 + wave, NGW = gridDim.x * 8, gt = blockIdx.x * 512 + tid, NGT = gridDim.x * 512;
    unsigned char* ws = a.ws;
    {
        float* cs = (float*)lds;
        float* red = cs + 5120;
        float* MOD = (float*)(ws + WS_MOD);
        if (blockIdx.x < 384) {
            for (int i = tid; i < 5120; i += 512) { const int cb = i >> 10, k = i & 1023; const float x = cb == 0 ? a.in[9][k] : a.in[8][(cb - 1) * 1024 + k]; cs[i] = silu(x); }
        }
        __syncthreads();
        for (int it = blockIdx.x; it < 768; it += gridDim.x) {
            const int l = it / 384, cgp = it % 384, col = cgp * 16 + (lane & 15), kp = wave * 4 + (lane >> 4);
            const float* W = a.in[10] + (size_t)l * 1024 * 6144 + col;
            float acc0 = 0.f, acc1 = 0.f, acc2 = 0.f, acc3 = 0.f, acc4 = 0.f;
#pragma unroll 8
            for (int kk = 0; kk < 32; ++kk) { const int k = kp * 32 + kk; const float w = W[(size_t)k * 6144];
                acc0 += cs[k] * w; acc1 += cs[1024 + k] * w; acc2 += cs[2048 + k] * w; acc3 += cs[3072 + k] * w; acc4 += cs[4096 + k] * w; }
            red[(kp * 5 + 0) * 16 + (lane & 15)] = acc0; red[(kp * 5 + 1) * 16 + (lane & 15)] = acc1; red[(kp * 5 + 2) * 16 + (lane & 15)] = acc2;
            red[(kp * 5 + 3) * 16 + (lane & 15)] = acc3; red[(kp * 5 + 4) * 16 + (lane & 15)] = acc4;
            __syncthreads();
            if (tid < 80) { const int cb = tid >> 4, c = tid & 15; float s = 0.f;
#pragma unroll
                for (int p = 0; p < 32; ++p) s += red[(p * 5 + cb) * 16 + c];
                MOD[(size_t)(l * 5 + cb) * 6144 + cgp * 16 + c] = s + a.in[11][l * 6144 + cgp * 16 + c]; }
            __syncthreads();
        }
    }
    tr_range(a, lds + 32768, 0, 1664, gw, NGW);
    tr_range(a, lds + 32768, 12832, 13472, gw, NGW);
    {
        const f32x4* s = (const f32x4*)a.in[2]; bf16* KA = (bf16*)(ws + WS_KAS);
        for (int i = gt; i < 4 * 4 * 512 * 128 / 4; i += NGT) { const int e0 = i * 4, bh = e0 >> 16, rem = e0 & 65535; const f32x4 v = s[i];
            u32x2 o; o.x = pk2(v.x, v.y); o.y = pk2(v.z, v.w); *(u32x2*)(KA + (size_t)bh * 1536 * 128 + rem) = o; }
        const f32x4* s2 = (const f32x4*)a.in[4]; bf16* KB = (bf16*)(ws + WS_KBS);
        for (int i = gt; i < 4 * 2 * 512 * 64 / 4; i += NGT) { const int e0 = i * 4, bg = e0 >> 15, rem = e0 & 32767; const f32x4 v = s2[i];
            u32x2 o; o.x = pk2(v.x, v.y); o.y = pk2(v.z, v.w); *(u32x2*)(KB + (size_t)bg * 1536 * 64 + rem) = o; }
    }
#if defined(RUN_UPTO) && RUN_UPTO < 14
    for (int i = gt; i < 3145728; i += NGT) a.out[O_SH + i] = 0.f;
#endif
    if (blockIdx.x == 0) {
        if (wave == 0) {
            const float* L = a.in[17];
            const float s1 = wave_sum(L[lane] * L[64 + lane]), s2 = wave_sum(L[128 + lane] * L[192 + lane]);
            if (lane == 0) { *(float*)(ws + WS_LAM) = __expf(s1) - __expf(s2) + 0.2f; ((unsigned*)(ws + WS_QCTR))[0] = 0u; ((unsigned*)(ws + WS_QCTR))[1] = 0u; }
        }
        float* LB = (float*)(ws + WS_LB);
        for (int i = tid; i < 1024; i += 512) { const int dr = i >> 9, c = i & 511; const float l0 = a.in[23][(dr * 2 + 0) * 512 + c], l1 = a.in[23][(dr * 2 + 1) * 512 + c];
            const float m = fmaxf(l0, l1), e0 = __expf(l0 - m), e1 = __expf(l1 - m), s0 = e0 / (e0 + e1), s1 = e1 / (e0 + e1); LB[i] = (s0 + s1) - s0; }
    }
}

template <int MODE, bool TMPF>
__device__ __forceinline__ void norm_phase(const Args& a, const float* g, int l, int shoff, int scoff) {
    const int lane = opq((int)threadIdx.x) & 63, wave = opq((int)threadIdx.x) >> 6, gw = blockIdx.x * 8 + wave, NGW = gridDim.x * 8;
    float* X = a.out; bf16* H = (bf16*)(a.ws + WS_H); const float* MOD = (const float*)(a.ws + WS_MOD) + (size_t)l * 5 * 6144;
    f32x4 gg[4];
#pragma unroll
    for (int j = 0; j < 4; ++j) gg[j] = *(const f32x4*)(g + 256 * j + lane * 4);
    for (int tb = gw; tb < NTOK / 4; tb += NGW) {
        f32x4 v[4][4]; float ss[4];
#pragma unroll
        for (int r = 0; r < 4; ++r) { const int t = tb * 4 + r;
            const float* src = MODE == 0 ? (t < NCTX ? a.in[0] + (size_t)t * DM : a.in[1] + (size_t)(t - NCTX) * DM) : X + (size_t)t * DM;
#pragma unroll
            for (int j = 0; j < 4; ++j) { v[r][j] = *(const f32x4*)(src + 256 * j + lane * 4);
                if (TMPF) v[r][j] += *(const f32x4*)((const float*)(a.ws + WS_TMP) + (size_t)t * DM + 256 * j + lane * 4); } }
#pragma unroll
        for (int r = 0; r < 4; ++r) { float q = 0.f;
#pragma unroll
            for (int j = 0; j < 4; ++j) q += (v[r][j].x * v[r][j].x + v[r][j].y * v[r][j].y) + (v[r][j].z * v[r][j].z + v[r][j].w * v[r][j].w);
            ss[r] = q; }
#pragma unroll
        for (int o = 1; o < 64; o <<= 1) {
#pragma unroll
            for (int r = 0; r < 4; ++r) ss[r] += __shfl_xor(ss[r], o); }
        const float* md = MOD + (size_t)cond_of(tb * 4) * 6144;
#pragma unroll
        for (int r = 0; r < 4; ++r) { const int t = tb * 4 + r; const float rstd = rsqrtf(ss[r] * (1.f / DM) + 1e-6f);
#pragma unroll
            for (int j = 0; j < 4; ++j) { const int col = 256 * j + lane * 4;
                if (MODE == 2) { *(f32x4*)(X + (size_t)t * DM + col) = v[r][j] * rstd * gg[j]; }
                else { const f32x4 sc = *(const f32x4*)(md + scoff + col), sh = *(const f32x4*)(md + shoff + col);
                    const f32x4 h = (v[r][j] * rstd * gg[j]) * (sc + 1.f) + sh;
                    u32x2 o; o.x = pk2(h.x, h.y); o.y = pk2(h.z, h.w); *(u32x2*)(H + (size_t)t * DM + col) = o;
                    if (TMPF) *(f32x4*)(X + (size_t)t * DM + col) = v[r][j]; } } }
    }
}

#define EPI_LOOP(...) \
    _Pragma("unroll") for (int ai = 0; ai < 2; ++ai) _Pragma("unroll") for (int m = 0; m < 4; ++m) { const int row = u.pm * 256 + ai * 128 + wr * 64 + m * 16 + fr; \
    _Pragma("unroll") for (int bj = 0; bj < 2; ++bj) _Pragma("unroll") for (int n = 0; n < 2; ++n) { const int cl = bj * 128 + wc * 32 + n * 16 + 4 * fq; const f32x4 v = acc[ai][bj][m][n]; __VA_ARGS__ } asm volatile("" ::: "memory"); }

struct EpiF32 {
    static constexpr bool PERM = false, AFTER_DRAIN = false;
    float* C; int ldc;
    __device__ __forceinline__ void operator()(const f32x4 (&acc)[2][2][4][2], const pg8::Unit& u, int wr, int wc, int fr, int fq) const {
        EPI_LOOP({ *(f32x4*)(C + (size_t)row * ldc + u.pn * 256 + cl) = v; })
    }
};
struct EpiBf16 {
    static constexpr bool PERM = false, AFTER_DRAIN = false;
    bf16* O; int ldc;
    __device__ __forceinline__ void operator()(const f32x4 (&acc)[2][2][4][2], const pg8::Unit& u, int wr, int wc, int fr, int fq) const {
        EPI_LOOP({ u32x2 o; o.x = pk2(v.x, v.y); o.y = pk2(v.z, v.w); *(u32x2*)(O + (size_t)row * ldc + u.pn * 256 + cl) = o; })
    }
};
struct EpiResid {
    static constexpr bool PERM = false, AFTER_DRAIN = false;
    float* X; const float* gate; float* TMP; const float* B0; const float* B1;
    __device__ __forceinline__ void operator()(const f32x4 (&acc)[2][2][4][2], const pg8::Unit& u, int wr, int wc, int fr, int fq) const {
        const float* gt_ = gate + (size_t)cond_of(u.pm * 256) * 6144; const int pn = u.pn & 3;
        const float* rb_ = u.pm < 16 ? B0 : B1 - (size_t)NCTX * DM;
        EPI_LOOP({ const int col = pn * 256 + cl; const f32x4 gg = *(const f32x4*)(gt_ + col); float* p = X + (size_t)row * DM + col;
            if (u.pn < 4) { const f32x4 x = *(const f32x4*)(rb_ + (size_t)row * DM + col); *(f32x4*)p = x + gg * v; }
            else { *(f32x4*)(TMP + (size_t)row * DM + col) = gg * v; } })
    }
};
struct EpiOdIn {
    static constexpr bool PERM = false, AFTER_DRAIN = false;
    float* HG; bf16* PR; const float* LB;
    __device__ __forceinline__ void operator()(const f32x4 (&acc)[2][2][4][2], const pg8::Unit& u, int wr, int wc, int fr, int fq) const {
        const int pn = u.pn;
        if (pn < 10) { const int kind = pn >> 1;
            EPI_LOOP({ const int col = pn * 256 + cl; f32x4 o = v;
                if (kind == 0) { o.x = silu(v.x); o.y = silu(v.y); o.z = silu(v.z); o.w = silu(v.w); }
                else if (kind <= 2) { const f32x4 lb = *(const f32x4*)(LB + (col - 512));
                    o.x = lb.x + (1.f - lb.x) * sigm(v.x); o.y = lb.y + (1.f - lb.y) * sigm(v.y); o.z = lb.z + (1.f - lb.z) * sigm(v.z); o.w = lb.w + (1.f - lb.w) * sigm(v.w); }
                *(f32x4*)(HG + (size_t)row * 2560 + col) = o; })
        } else {
            EPI_LOOP({ const int col = (pn - 10) * 256 + cl; if (col < 1856) { u32x2 o; o.x = pk2(v.x, v.y); o.y = pk2(v.z, v.w); *(u32x2*)(PR + (size_t)row * 1856 + col) = o; } })
        }
    }
};
struct EpiLora {
    static constexpr bool PERM = false, AFTER_DRAIN = false;
    float* WF; float* WB; const bf16* KK; const bf16* K1; bf16* KKA; bf16* KT; bf16* G; const float* w0; const float* a0; const float* k_a;
    __device__ __forceinline__ void operator()(const f32x4 (&acc)[2][2][4][2], const pg8::Unit& u, int wr, int wc, int fr, int fq) const {
        const int pn = u.pn, kind = pn >> 1;
        if (kind <= 1) { float* W = kind == 0 ? WF : WB;
            EPI_LOOP({ const int c = (pn & 1) * 256 + cl; const f32x4 z0 = *(const f32x4*)(w0 + kind * 512 + c); f32x4 o;
                o.x = __expf(-0.60653066f * sigm(v.x + z0.x)); o.y = __expf(-0.60653066f * sigm(v.y + z0.y)); o.z = __expf(-0.60653066f * sigm(v.z + z0.z)); o.w = __expf(-0.60653066f * sigm(v.w + z0.w));
                *(f32x4*)(W + (size_t)row * 512 + c) = o; })
        } else if (kind == 2) {
            EPI_LOOP({ const int c = (pn & 1) * 256 + cl; const f32x4 z0 = *(const f32x4*)(a0 + c), ka = *(const f32x4*)(k_a + c);
                const u32x2 kkw = *(const u32x2*)(KK + (size_t)row * 512 + c), k1w = *(const u32x2*)(K1 + (size_t)row * 512 + c);
                const float a0_ = sigm(v.x + z0.x), a1_ = sigm(v.y + z0.y), a2_ = sigm(v.z + z0.z), a3_ = sigm(v.w + z0.w);
                u32x2 o1; o1.x = pk2(bflo(kkw.x) * a0_, bfhi(kkw.x) * a1_); o1.y = pk2(bflo(kkw.y) * a2_, bfhi(kkw.y) * a3_);
                u32x2 o2; o2.x = pk2(bflo(k1w.x) * (1.f + (a0_ - 1.f) * ka.x), bfhi(k1w.x) * (1.f + (a1_ - 1.f) * ka.y)); o2.y = pk2(bflo(k1w.y) * (1.f + (a2_ - 1.f) * ka.z), bfhi(k1w.y) * (1.f + (a3_ - 1.f) * ka.w));
                *(u32x2*)(KKA + (size_t)row * 512 + c) = o1; *(u32x2*)(KT + (size_t)row * 512 + c) = o2; })
        } else {
            EPI_LOOP({ const int c = (pn & 1) * 256 + cl; u32x2 o; o.x = pk2(v.x, v.y); o.y = pk2(v.z, v.w); *(u32x2*)(G + (size_t)row * 512 + c) = o; })
        }
    }
};
template <class Epi>
__device__ __forceinline__ void run_gemm(unsigned char* lds, const bf16* A, const bf16* Bt, int Nunits256, int K, int ld, int nNr, const Epi& E) {
    pg8::Gemm g{A, Bt, NTOK, Nunits256 * 256, K, ld, nNr};
    pg8::StaticOrder S; S.init(NTOK, Nunits256 * 256, (int)gridDim.x, (int)blockIdx.x);
    pg8::gemm_phase<Epi, pg8::StaticOrder, false>((PG8_LAS unsigned char*)lds, g, S, E, nullptr);
}

__device__ __forceinline__ void rope4(f32x4& v, const float (&cs)[4], const float (&sn)[4], int lane) {
    float p[4], o[4]; const float x[4] = {v.x, v.y, v.z, v.w};
#pragma unroll
    for (int j = 0; j < 4; ++j) p[j] = __shfl_xor(x[j], 4);
#pragma unroll
    for (int j = 0; j < 4; ++j) o[j] = (lane & 4) ? (p[j] * sn[j] + x[j] * cs[j]) : (x[j] * cs[j] - p[j] * sn[j]);
    v = (f32x4){o[0], o[1], o[2], o[3]};
}
__device__ __forceinline__ void qkv_post(const Args& a, unsigned char* lds) {
    const int tid = opq((int)threadIdx.x), lane = tid & 63, wave = tid >> 6, gw = blockIdx.x * 8 + wave, NGW = gridDim.x * 8;
    unsigned char* ws = a.ws; const float* PROJ = (const float*)(ws + WS_PROJ);
    bf16* QA = (bf16*)(ws + WS_QA); bf16* QB = (bf16*)(ws + WS_QB);
    for (int t = gw; t < NTOK; t += NGW) {
        const float* row = PROJ + (size_t)t * 2304;
        const bool smp = t >= NCTX; const int b = smp ? ((t - NCTX) >> 10) : (t >> 8), s = smp ? ((t - NCTX) & 1023) : (t & 255);
        const int T = smp ? 1536 : 256, tpos = smp ? 512 + s : s;
        float cs[4], sn[4];
        { const float pos = (float)((lane & 8) ? (s & 63) : (s >> 6));
#pragma unroll
          for (int j = 0; j < 4; ++j) { const float fr_ = __expf(-(float)(4 * (lane & 3) + j) * (9.210340372f / 16.f)); const float ang = pos * fr_; cs[j] = __cosf(ang); sn[j] = __sinf(ang); } }
        const int hh = lane >> 4, cc4 = (lane & 15) * 4;
        f32x4 vin[9];
#pragma unroll
        for (int c = 0; c < 9; ++c) vin[c] = *(const f32x4*)(row + c * 256 + lane * 4);
#pragma unroll
        for (int c = 0; c < 9; ++c) {
            f32x4 v = vin[c];
            if (c < 2) {
                if (smp) rope4(v, cs, sn, lane);
                v = v * 0.18033688f; u32x2 o; o.x = pk2(v.x, v.y); o.y = pk2(v.z, v.w); *(u32x2*)(QA + (size_t)t * 512 + c * 256 + lane * 4) = o;
            } else if (c < 4) {
                if (smp) rope4(v, cs, sn, lane);
                const int col = (c - 2) * 256 + lane * 4, h = col >> 7, cc = col & 127;
                bf16* KA = (bf16*)(ws + (smp ? WS_KAS : WS_KAC));
                u32x2 o; o.x = pk2(v.x, v.y); o.y = pk2(v.z, v.w); *(u32x2*)(KA + ((size_t)(b * 4 + h) * T + tpos) * 128 + cc) = o;
                if (!smp) *(f32x4*)(a.out + O_AK + ((size_t)(b * 4 + h) * 256 + s) * 128 + cc) = v;
            } else if (c < 6) {
                const int col = (c - 4) * 256 + lane * 4, h = col >> 7, cc = col & 127;
                if (!smp) *(f32x4*)(a.out + O_AV + ((size_t)(b * 4 + h) * 256 + s) * 128 + cc) = v;
            } else {
                float ss = (v.x * v.x + v.y * v.y) + (v.z * v.z + v.w * v.w);
                ss += __shfl_xor(ss, 1); ss += __shfl_xor(ss, 2); ss += __shfl_xor(ss, 4); ss += __shfl_xor(ss, 8);
                const float rs = rsqrtf(ss * (1.f / 64.f) + 1e-6f);
                const f32x4 gg = *(const f32x4*)((c < 8 ? a.in[19] : a.in[20]) + cc4);
                f32x4 nv = v * rs * gg;
                if (smp) rope4(nv, cs, sn, lane);
                if (c < 8) { nv = nv * 0.18033688f; u32x2 o; o.x = pk2(nv.x, nv.y); o.y = pk2(nv.z, nv.w); *(u32x2*)(QB + (size_t)t * 512 + (c - 6) * 256 + lane * 4) = o; }
                else if (hh < 2) {
                    bf16* KB = (bf16*)(ws + (smp ? WS_KBS : WS_KBC));
                    u32x2 o; o.x = pk2(nv.x, nv.y); o.y = pk2(nv.z, nv.w); *(u32x2*)(KB + ((size_t)(b * 2 + hh) * T + tpos) * 64 + cc4) = o;
                    if (!smp) *(f32x4*)(a.out + O_BK + ((size_t)(b * 2 + hh) * 256 + s) * 64 + cc4) = nv;
                } else {
                    if (!smp) *(f32x4*)(a.out + O_BV + ((size_t)(b * 2 + (hh - 2)) * 256 + s) * 64 + cc4) = v;
                }
            }
        }
    }
    float* scr = (float*)(lds + wave * 8448);
    for (int it = gw; it < 128 * 20; it += NGW) {
        const int tb = it / 20, nb = it % 20; const bool smp = tb >= 64;
        const int b = smp ? ((tb - 64) >> 4) : (tb >> 2), s0 = smp ? ((tb - 64) & 15) * 64 : (tb & 3) * 64, T = smp ? 1536 : 256, tpos = smp ? 512 + s0 : s0;
        if (nb < 16) { const int h = nb >> 2, e0 = (nb & 3) * 32;
            bf16* dst = (bf16*)(ws + (smp ? WS_VATS : WS_VATC)) + ((size_t)(b * 4 + h) * 128 + e0) * T + tpos;
            tr_item(PROJ + (size_t)tb * 64 * 2304 + 1024 + nb * 32, 2304, dst, T, scr, lane);
        } else { const int n2 = nb - 16, g = n2 >> 1, e0 = (n2 & 1) * 32;
            bf16* dst = (bf16*)(ws + (smp ? WS_VBTS : WS_VBTC)) + ((size_t)(b * 2 + g) * 64 + e0) * T + tpos;
            tr_item(PROJ + (size_t)tb * 64 * 2304 + 2176 + n2 * 32, 2304, dst, T, scr, lane);
        }
    }
}

template <int DV, int LDK, bool SHK>
__device__ __forceinline__ void attn_core(unsigned char* ldsb, const bf16* Qw, int qc0, int qc1, const bf16* Kg, const bf16* VTg, int T, f32x4 (&O)[2][DV / 16], float (&linv)[2]) {
    constexpr int KSTR = LDK * 2 + 16, VSTR = 144, VOFF = 64 * KSTR, BUFB = VOFF + DV * VSTR, NKC = 64 * LDK / 8 / 512, NVC = DV * 8 / 512, KCPR = LDK / 8;
    const int tid = opq((int)threadIdx.x), lane = tid & 63, fr = lane & 15, fq = lane >> 4;
    bf16x8 qf[2][2];
#pragma unroll
    for (int ks = 0; ks < 2; ++ks) { qf[0][ks] = *(const bf16x8*)(Qw + (size_t)fr * 512 + qc0 + ks * 32 + fq * 8); qf[1][ks] = *(const bf16x8*)(Qw + (size_t)fr * 512 + qc1 + ks * 32 + fq * 8); }
#pragma unroll
    for (int s = 0; s < 2; ++s)
#pragma unroll
        for (int e = 0; e < DV / 16; ++e) O[s][e] = (f32x4){0.f, 0.f, 0.f, 0.f};
    float mrun[2] = {-1e30f, -1e30f}, lsum[2] = {0.f, 0.f};
    u32x4 kreg[NKC], vreg[NVC];
    const int ntile = T / 64;
#define ATT_LOAD(t0) do { _Pragma("unroll") for (int i = 0; i < NKC; ++i) { const int c = tid + i * 512, r = c / KCPR, cc = c % KCPR; kreg[i] = *(const u32x4*)(Kg + (size_t)((t0) + r) * LDK + cc * 8); } \
        _Pragma("unroll") for (int i = 0; i < NVC; ++i) { const int c = tid + i * 512, e = c >> 3, cc = c & 7; vreg[i] = *(const u32x4*)(VTg + (size_t)e * T + (t0) + cc * 8); } } while (0)
#define ATT_PUT(base) do { _Pragma("unroll") for (int i = 0; i < NKC; ++i) { const int c = tid + i * 512, r = c / KCPR, cc = c % KCPR; *(u32x4*)((base) + r * KSTR + cc * 16) = kreg[i]; } \
        _Pragma("unroll") for (int i = 0; i < NVC; ++i) { const int c = tid + i * 512, e = c >> 3, cc = c & 7; *(u32x4*)((base) + VOFF + e * VSTR + cc * 16) = vreg[i]; } } while (0)
    ATT_LOAD(0);
    __syncthreads();
    ATT_PUT(ldsb);
    if (ntile > 1) ATT_LOAD(64);
    __syncthreads();
    for (int it = 0; it < ntile; ++it) {
        unsigned char* lds = ldsb + (it & 1) * BUFB;
        if (it + 1 < ntile) { ATT_PUT(ldsb + ((it + 1) & 1) * BUFB); if (it + 2 < ntile) ATT_LOAD((it + 2) * 64); }
        f32x4 sc[2][4];
#pragma unroll
        for (int kt = 0; kt < 4; ++kt) {
            sc[0][kt] = (f32x4){0.f, 0.f, 0.f, 0.f}; sc[1][kt] = (f32x4){0.f, 0.f, 0.f, 0.f};
#pragma unroll
            for (int ks = 0; ks < 2; ++ks) {
                const bf16x8 a0 = *(const bf16x8*)(lds + (kt * 16 + fr) * KSTR + (ks * 32 + fq * 8) * 2);
                sc[0][kt] = __builtin_amdgcn_mfma_f32_16x16x32_bf16(a0, qf[0][ks], sc[0][kt], 0, 0, 0);
                if (SHK) sc[1][kt] = __builtin_amdgcn_mfma_f32_16x16x32_bf16(a0, qf[1][ks], sc[1][kt], 0, 0, 0);
                else { const bf16x8 a1 = *(const bf16x8*)(lds + (kt * 16 + fr) * KSTR + (64 + ks * 32 + fq * 8) * 2);
                    sc[1][kt] = __builtin_amdgcn_mfma_f32_16x16x32_bf16(a1, qf[1][ks], sc[1][kt], 0, 0, 0); }
            }
        }
        bf16x8 pb[2][2];
#pragma unroll
        for (int s = 0; s < 2; ++s) {
            float mt = -1e30f;
#pragma unroll
            for (int kt = 0; kt < 4; ++kt) mt = fmaxf(fmaxf(fmaxf(sc[s][kt].x, sc[s][kt].y), fmaxf(sc[s][kt].z, sc[s][kt].w)), mt);
            mt = fmaxf(mt, __shfl_xor(mt, 16)); mt = fmaxf(mt, __shfl_xor(mt, 32));
            const float mnew = fmaxf(mrun[s], mt), alpha = __builtin_amdgcn_exp2f(mrun[s] - mnew); mrun[s] = mnew;
            float ps = 0.f;
#pragma unroll
            for (int kt = 0; kt < 4; ++kt) { sc[s][kt].x = __builtin_amdgcn_exp2f(sc[s][kt].x - mnew); sc[s][kt].y = __builtin_amdgcn_exp2f(sc[s][kt].y - mnew); sc[s][kt].z = __builtin_amdgcn_exp2f(sc[s][kt].z - mnew); sc[s][kt].w = __builtin_amdgcn_exp2f(sc[s][kt].w - mnew);
                ps += (sc[s][kt].x + sc[s][kt].y) + (sc[s][kt].z + sc[s][kt].w); }
            lsum[s] = lsum[s] * alpha + ps;
            if (__builtin_amdgcn_ballot_w64(alpha != 1.f) != 0ull) {
#pragma unroll
                for (int e = 0; e < DV / 16; ++e) O[s][e] = O[s][e] * alpha; }
#pragma unroll
            for (int k2 = 0; k2 < 2; ++k2) { u32x4 w; w.x = pk2(sc[s][2 * k2].x, sc[s][2 * k2].y); w.y = pk2(sc[s][2 * k2].z, sc[s][2 * k2].w); w.z = pk2(sc[s][2 * k2 + 1].x, sc[s][2 * k2 + 1].y); w.w = pk2(sc[s][2 * k2 + 1].z, sc[s][2 * k2 + 1].w);
                pb[s][k2] = __builtin_bit_cast(bf16x8, w); }
        }
#pragma unroll
        for (int e = 0; e < DV / 16; ++e)
#pragma unroll
            for (int k2 = 0; k2 < 2; ++k2) {
                const unsigned char* vp = lds + VOFF + (e * 16 + fr) * VSTR + (k2 * 32 + fq * 4) * 2;
                const u32x2 lo = *(const u32x2*)vp, hi = *(const u32x2*)(vp + 32);
                const u32x4 w = {lo.x, lo.y, hi.x, hi.y}; const bf16x8 av = __builtin_bit_cast(bf16x8, w);
                O[0][e] = __builtin_amdgcn_mfma_f32_16x16x32_bf16(av, pb[0][k2], O[0][e], 0, 0, 0);
                O[1][e] = __builtin_amdgcn_mfma_f32_16x16x32_bf16(av, pb[1][k2], O[1][e], 0, 0, 0);
            }
        __syncthreads();
    }
#undef ATT_PUT
#undef ATT_LOAD
#pragma unroll
    for (int s = 0; s < 2; ++s) { float l = lsum[s]; l += __shfl_xor(l, 16); l += __shfl_xor(l, 32); linv[s] = 1.f / l; }
}
__device__ __forceinline__ void attn_phase(const Args& a, unsigned char* lds) {
    unsigned char* ws = a.ws; const int tid = opq((int)threadIdx.x), lane = tid & 63, wave = tid >> 6, fr = lane & 15, fq = lane >> 4;
    const bf16* QA = (const bf16*)(ws + WS_QA); const bf16* QB = (const bf16*)(ws + WS_QB); bf16* CAT = (bf16*)(ws + WS_CAT);
    const float lam = *(const float*)(ws + WS_LAM);
    const bool bal = gridDim.x == 256;
    for (int it = 0; ; ++it) {
        int u;
        if (bal) { if (it == 0) u = (int)blockIdx.x; else if (blockIdx.x >= 128 && it < 3) u = 128 + it * 128 + ((int)blockIdx.x - 128); else break; }
        else { u = (int)blockIdx.x + it * (int)gridDim.x; if (u >= 512) break; }
        const bool isA = (u < 128) || (u >= 384), smp = u < 256;
        int idx = u < 128 ? u : (u < 256 ? u - 128 : (u < 384 ? u - 256 : u - 384));
        const int T = smp ? 1536 : 256;
        int b, hx, pair = 0, qb;
        if (smp) { b = idx >> 5; qb = idx & 7; if (isA) hx = (idx >> 3) & 3; else { hx = (idx >> 4) & 1; pair = (idx >> 3) & 1; } }
        else { b = idx >> 3; if (isA) { hx = (idx >> 1) & 3; qb = idx & 1; } else { hx = (idx >> 2) & 1; pair = (idx >> 1) & 1; qb = idx & 1; } }
        const int tok0 = (smp ? NCTX + b * 1024 : b * 256) + qb * 128 + wave * 16;
        if (isA) {
            const bf16* Kg = (const bf16*)(ws + (smp ? WS_KAS : WS_KAC)) + (size_t)(b * 4 + hx) * T * 128;
            const bf16* Vg = (const bf16*)(ws + (smp ? WS_VATS : WS_VATC)) + (size_t)(b * 4 + hx) * 128 * T;
            f32x4 O[2][8]; float li[2];
            attn_core<128, 128, false>(lds, QA + (size_t)tok0 * 512, hx * 128, hx * 128 + 64, Kg, Vg, T, O, li);
            float ss = 0.f;
#pragma unroll
            for (int e = 0; e < 8; ++e) { O[0][e] = O[0][e] * li[0] - (O[1][e] * li[1]) * lam; ss += (O[0][e].x * O[0][e].x + O[0][e].y * O[0][e].y) + (O[0][e].z * O[0][e].z + O[0][e].w * O[0][e].w); }
            ss += __shfl_xor(ss, 16); ss += __shfl_xor(ss, 32);
            const float rs = rsqrtf(ss * (1.f / 128.f) + 1e-6f) * 0.8f;
#pragma unroll
            for (int e = 0; e < 8; ++e) { const int ec = e * 16 + fq * 4; const f32x4 gg = *(const f32x4*)(a.in[18] + ec); const f32x4 y = O[0][e] * rs * gg;
                u32x2 o; o.x = pk2(y.x, y.y); o.y = pk2(y.z, y.w); *(u32x2*)(CAT + (size_t)(tok0 + fr) * 1024 + hx * 128 + ec) = o; }
        } else {
            const bf16* Kg = (const bf16*)(ws + (smp ? WS_KBS : WS_KBC)) + (size_t)(b * 2 + hx) * T * 64;
            const bf16* Vg = (const bf16*)(ws + (smp ? WS_VBTS : WS_VBTC)) + (size_t)(b * 2 + hx) * 64 * T;
            const int hq0 = hx * 4 + pair * 2;
            f32x4 O[2][4]; float li[2];
#if defined(DBG_SKIP_B)
            if (DBG_SKIP_B == 1 ? smp : !smp) {
#pragma unroll
            for (int s = 0; s < 2; ++s) { li[s] = 0.f;
#pragma unroll
                for (int e = 0; e < 4; ++e) O[s][e] = (f32x4){0.f, 0.f, 0.f, 0.f}; }
            } else
#endif
            attn_core<64, 64, true>(lds, QB + (size_t)tok0 * 512, hq0 * 64, (hq0 + 1) * 64, Kg, Vg, T, O, li);
#pragma unroll
            for (int s = 0; s < 2; ++s)
#pragma unroll
                for (int e = 0; e < 4; ++e) { const f32x4 y = O[s][e] * li[s]; u32x2 o; o.x = pk2(y.x, y.y); o.y = pk2(y.z, y.w);
                    *(u32x2*)(CAT + (size_t)(tok0 + fr) * 1024 + 512 + (hq0 + s) * 64 + e * 16 + fq * 4) = o; }
        }
    }
}

__device__ __forceinline__ void conv_phase(const Args& a, int l) {
    const int gt = blockIdx.x * 512 + opq((int)threadIdx.x), NGT = gridDim.x * 512;
    const bf16* U = (const bf16*)(a.ws + WS_U); bf16* ACT = (bf16*)(a.ws + WS_ACT);
    const float* cw = a.in[37] + (size_t)l * 3 * 5632; const float* cb = a.in[38] + (size_t)l * 5632;
    const int nrw = NGT / 352;
    if (gt < nrw * 352) {
        const int ch = gt % 352, r0 = gt / 352, j0 = ch * 8;
        float w0v[8], w1v[8], w2v[8], bv[8], w0g[8], w1g[8], w2g[8], bg[8];
#pragma unroll
        for (int k = 0; k < 8; ++k) { w0v[k] = cw[j0 + k]; w1v[k] = cw[5632 + j0 + k]; w2v[k] = cw[2 * 5632 + j0 + k]; bv[k] = cb[j0 + k];
            w0g[k] = cw[DFF + j0 + k]; w1g[k] = cw[5632 + DFF + j0 + k]; w2g[k] = cw[2 * 5632 + DFF + j0 + k]; bg[k] = cb[DFF + j0 + k]; }
        for (int run = r0; run < 1024; run += nrw) {
            const int t0 = run * 8;
            const int S = t0 < NCTX ? 256 : 1024, s0 = t0 < NCTX ? (t0 & 255) : ((t0 - NCTX) & 1023);
            const u32x4 zero = {0u, 0u, 0u, 0u};
            u32x4 rv[10], rg[10];
#pragma unroll
            for (int i = 0; i < 10; ++i) { const int sp = s0 - 1 + i; const bool ok = sp >= 0 && sp < S; const size_t off = (size_t)(t0 - 1 + i) * 5632 + j0;
                rv[i] = ok ? *(const u32x4*)(U + off) : zero; rg[i] = ok ? *(const u32x4*)(U + off + DFF) : zero; }
#pragma unroll
            for (int i = 0; i < 8; ++i) {
                float o[8];
#pragma unroll
                for (int k = 0; k < 4; ++k) {
                    const float vl = w0v[2 * k] * bflo(rv[i][k]) + w1v[2 * k] * bflo(rv[i + 1][k]) + w2v[2 * k] * bflo(rv[i + 2][k]) + bv[2 * k];
                    const float vh = w0v[2 * k + 1] * bfhi(rv[i][k]) + w1v[2 * k + 1] * bfhi(rv[i + 1][k]) + w2v[2 * k + 1] * bfhi(rv[i + 2][k]) + bv[2 * k + 1];
                    const float gl = w0g[2 * k] * bflo(rg[i][k]) + w1g[2 * k] * bflo(rg[i + 1][k]) + w2g[2 * k] * bflo(rg[i + 2][k]) + bg[2 * k];
                    const float gh = w0g[2 * k + 1] * bfhi(rg[i][k]) + w1g[2 * k + 1] * bfhi(rg[i + 1][k]) + w2g[2 * k + 1] * bfhi(rg[i + 2][k]) + bg[2 * k + 1];
                    o[2 * k] = silu(gl) * vl; o[2 * k + 1] = silu(gh) * vh; }
                u32x4 w; w.x = pk2(o[0], o[1]); w.y = pk2(o[2], o[3]); w.z = pk2(o[4], o[5]); w.w = pk2(o[6], o[7]);
                *(u32x4*)(ACT + (size_t)(t0 + i) * DFF + j0) = w;
            }
        }
    }
}

__device__ __forceinline__ void prep1_phase(const Args& a) {
    const int lane = opq((int)threadIdx.x) & 63, wave = opq((int)threadIdx.x) >> 6, gw = blockIdx.x * 8 + wave, NGW = gridDim.x * 8;
    unsigned char* ws = a.ws; const bf16* PR = (const bf16*)(ws + WS_PR);
    bf16* R = (bf16*)(ws + WS_R); bf16* K1 = (bf16*)(ws + WS_K1); bf16* V1 = (bf16*)(ws + WS_V1); bf16* KK = (bf16*)(ws + WS_KK); bf16* AP = (bf16*)(ws + WS_AP);
    const float* mu = a.in[25]; const float* k_k = a.in[31];
    for (int t = gw; t < NTOK; t += NGW) {
        const int S = t < NCTX ? 256 : 1024, s = t < NCTX ? (t & 255) : ((t - NCTX) & 1023);
        const bool hp = s > 0, hn = s + 1 < S;
        u32x4 xin[4], xpin[4], xnin[4];
#pragma unroll
        for (int it = 0; it < 4; ++it) { const int c = it * 64 + lane, col = (c < 232 ? c : 0) * 8; const u32x4 zero = {0u, 0u, 0u, 0u};
            xin[it] = *(const u32x4*)(PR + (size_t)t * 1856 + col);
            xpin[it] = hp ? *(const u32x4*)(PR + (size_t)(t - 1) * 1856 + col) : zero;
            xnin[it] = hn ? *(const u32x4*)(PR + (size_t)(t + 1) * 1856 + col) : zero; }
#pragma unroll
        for (int it = 0; it < 4; ++it) {
            const int c = it * 64 + lane; if (c >= 232) break;
            const int col = c * 8;
            const u32x4 x = xin[it], xp = xpin[it], xn = xnin[it];
            float pd[8];
#pragma unroll
            for (int k = 0; k < 4; ++k) { const float m0 = mu[col + 2 * k], m1 = mu[col + 2 * k + 1];
                const float c0 = bflo(x[k]), c1 = bfhi(x[k]);
                pd[2 * k] = c0 + m0 * (0.5f * (bflo(xp[k]) + bflo(xn[k])) - c0); pd[2 * k + 1] = c1 + m1 * (0.5f * (bfhi(xp[k]) + bfhi(xn[k])) - c1); }
            u32x4 w; w.x = pk2(pd[0], pd[1]); w.y = pk2(pd[2], pd[3]); w.z = pk2(pd[4], pd[5]); w.w = pk2(pd[6], pd[7]);
            if (it == 0) { *(u32x4*)(R + (size_t)t * 512 + col) = w; }
            else if (it == 1) { const int kc = col - 512; *(u32x4*)(K1 + (size_t)t * 512 + kc) = w;
                float q[8], ss = 0.f;
#pragma unroll
                for (int k = 0; k < 8; ++k) { q[k] = pd[k] * k_k[kc + k]; ss += q[k] * q[k]; }
                ss += __shfl_xor(ss, 1); ss += __shfl_xor(ss, 2); ss += __shfl_xor(ss, 4);
                const float inv = 1.f / fmaxf(sqrtf(ss), 1e-12f);
                u32x4 o; o.x = pk2(q[0] * inv, q[1] * inv); o.y = pk2(q[2] * inv, q[3] * inv); o.z = pk2(q[4] * inv, q[5] * inv); o.w = pk2(q[6] * inv, q[7] * inv);
                *(u32x4*)(KK + (size_t)t * 512 + kc) = o; }
            else if (it == 2) { *(u32x4*)(V1 + (size_t)t * 512 + (col - 1024)) = w; }
            else { const int ac = col - 1536;
                float o[8];
#pragma unroll
                for (int k = 0; k < 8; ++k) { const float x_ = pd[k]; o[k] = ac < 128 ? (1.f - 2.f / (1.f + __expf(2.f * x_))) : (ac < 192 ? x_ : sigm(x_)); }
                u32x4 ow; ow.x = pk2(o[0], o[1]); ow.y = pk2(o[2], o[3]); ow.z = pk2(o[4], o[5]); ow.w = pk2(o[6], o[7]);
                *(u32x4*)(AP + (size_t)t * 384 + ac) = ow; }
        }
        if (lane < 8) *(u32x4*)(AP + (size_t)t * 384 + 320 + lane * 8) = (u32x4){0u, 0u, 0u, 0u};
    }
}

template <int CTRL> __device__ __forceinline__ float dppf(float x) { return __builtin_bit_cast(float, __builtin_amdgcn_update_dpp(0, __builtin_bit_cast(int, x), CTRL, 0xF, 0xF, true)); }
__device__ __forceinline__ float red8(float x) { x += dppf<0xB1>(x); x += dppf<0x4E>(x); x += dppf<0x141>(x); return x; }
__device__ __forceinline__ float red16(float x) { x = red8(x); x += dppf<0x140>(x); return x; }

template <int R> __device__ __forceinline__ void hgrn_step(const f32x4 (&X)[4], const float (&vv)[R], f32x2 (&St)[R][4], float (&oo)[R]) {
    const f32x2 f2[4] = {{X[0].x, X[0].y}, {X[0].z, X[0].w}, {X[1].x, X[1].y}, {X[1].z, X[1].w}}, q2[4] = {{X[2].x, X[2].y}, {X[2].z, X[2].w}, {X[3].x, X[3].y}, {X[3].z, X[3].w}};
#pragma unroll
    for (int c = 0; c < R; ++c) { const f32x2 v2 = {vv[c], vv[c]}; f32x2 o2 = {0.f, 0.f};
#pragma unroll
        for (int i = 0; i < 4; ++i) { const f32x2 d = St[c][i] - v2; St[c][i] = f2[i] * d + v2; o2 = q2[i] * St[c][i] + o2; }
        oo[c] = o2.x + o2.y; }
#pragma unroll
    for (int c = 0; c < R; ++c) oo[c] = red16(oo[c]);
}
template <int R> __device__ __forceinline__ void rwkv_step(const f32x4 (&X)[10], const float (&vv)[R], f32x2 (&St)[R][4], float (&oo)[R]) {
    const f32x2 kk2[4] = {{X[0].x, X[0].y}, {X[0].z, X[0].w}, {X[1].x, X[1].y}, {X[1].z, X[1].w}}, w2[4] = {{X[2].x, X[2].y}, {X[2].z, X[2].w}, {X[3].x, X[3].y}, {X[3].z, X[3].w}};
    const f32x2 ka2[4] = {{X[4].x, X[4].y}, {X[4].z, X[4].w}, {X[5].x, X[5].y}, {X[5].z, X[5].w}}, kt2[4] = {{X[6].x, X[6].y}, {X[6].z, X[6].w}, {X[7].x, X[7].y}, {X[7].z, X[7].w}};
    const f32x2 r2[4] = {{X[8].x, X[8].y}, {X[8].z, X[8].w}, {X[9].x, X[9].y}, {X[9].z, X[9].w}};
    float sa[R];
#pragma unroll
    for (int c = 0; c < R; ++c) { f32x2 s2 = {0.f, 0.f};
#pragma unroll
        for (int i = 0; i < 4; ++i) s2 = St[c][i] * kk2[i] + s2;
        sa[c] = s2.x + s2.y; }
#pragma unroll
    for (int c = 0; c < R; ++c) sa[c] = -red8(sa[c]);
#pragma unroll
    for (int c = 0; c < R; ++c) { const f32x2 v2 = {vv[c], vv[c]}, sa2 = {sa[c], sa[c]}; f32x2 o2 = {0.f, 0.f};
#pragma unroll
        for (int i = 0; i < 4; ++i) { const f32x2 t2 = sa2 * ka2[i] + v2 * kt2[i]; St[c][i] = St[c][i] * w2[i] + t2; o2 = St[c][i] * r2[i] + o2; }
        oo[c] = o2.x + o2.y; }
}
template <int R>
__device__ __forceinline__ void hgrn_wjob(const Args& a, unsigned char* wl, bool smp, int j, int lane) {
    unsigned char* ws = a.ws;
    constexpr int NCG = 32 / R;
    const int chain = j / NCG, cg = j % NCG, b = chain >> 3, h = (chain >> 1) & 3, dir = chain & 1;
    const int tok0 = smp ? NCTX + b * 1024 : b * 256, S = smp ? 1024 : 256;
    const int eg = lane >> 4, ksl = lane & 15, cb = cg * 4 * R, c0 = cb + eg * R;
    const float* HG = (const float*)(ws + WS_HG); bf16* OC = (bf16*)(ws + (dir ? WS_OCB : WS_OCF));
    f32x2 St[R][4];
#pragma unroll
    for (int c = 0; c < R; ++c)
#pragma unroll
        for (int i = 0; i < 4; ++i) {
            if (smp) { const float* sp = a.in[6] + ((size_t)((b * 2 + dir) * 4 + h) * 128 + (i < 2 ? 4 * ksl + 2 * i : 64 + 4 * ksl + 2 * (i - 2))) * 128 + c0 + c; St[c][i] = (f32x2){sp[0], sp[128]}; }
            else St[c][i] = (f32x2){0.f, 0.f}; }
    float* sF = (float*)wl; float* sQ = sF + 1024; float* sV = sQ + 1024; float* sO = sV + 64;
    f32x4 rf[4], rq[4], rv;
#define HGW_TOK(ch, st) (tok0 + (dir ? S - 1 - ((ch) * 8 + (st)) : ((ch) * 8 + (st))))
#define HGW_LOAD(ch) do { _Pragma("unroll") for (int m = 0; m < 4; ++m) { const int i_ = lane + 64 * m, st_ = i_ >> 5, c_ = i_ & 31; const float* r_ = HG + (size_t)HGW_TOK(ch, st_) * 2560 + h * 128 + c_ * 4; \
        rf[m] = *(const f32x4*)(r_ + 512 + dir * 512); rq[m] = *(const f32x4*)r_; } \
        if (lane < 8 * R) rv = *(const f32x4*)(HG + (size_t)HGW_TOK(ch, lane / R) * 2560 + 1536 + h * 128 + cb + (lane % R) * 4); } while (0)
    HGW_LOAD(0);
    const int nch = S / 8;
    for (int ch = 0; ch < nch; ++ch) {
#pragma unroll
        for (int m = 0; m < 4; ++m) { const int i_ = lane + 64 * m; *(f32x4*)(sF + i_ * 4) = rf[m]; *(f32x4*)(sQ + i_ * 4) = rq[m]; }
        if (lane < 8 * R) *(f32x4*)(sV + lane * 4) = rv;
        if (ch + 1 < nch) HGW_LOAD(ch + 1);
        float ob[8][R];
#pragma unroll
        for (int st = 0; st < 8; ++st) {
            f32x4 X[4]; float V[R];
            X[0] = *(const f32x4*)(sF + st * 128 + 4 * ksl); X[1] = *(const f32x4*)(sF + st * 128 + 64 + 4 * ksl); X[2] = *(const f32x4*)(sQ + st * 128 + 4 * ksl); X[3] = *(const f32x4*)(sQ + st * 128 + 64 + 4 * ksl);
#pragma unroll
            for (int c = 0; c < R; ++c) V[c] = sV[st * 4 * R + eg * R + c];
            hgrn_step<R>(X, V, St, ob[st]);
        }
        if (ksl == 0) {
#pragma unroll
            for (int st = 0; st < 8; ++st)
#pragma unroll
                for (int c = 0; c < R; ++c) sO[st * 4 * R + eg * R + c] = ob[st][c]; }
        if (lane < 8) {
            if (R == 2) { const f32x4 o0 = *(const f32x4*)(sO + lane * 8), o1 = *(const f32x4*)(sO + lane * 8 + 4);
                u32x4 w; w.x = pk2(o0.x, o0.y); w.y = pk2(o0.z, o0.w); w.z = pk2(o1.x, o1.y); w.w = pk2(o1.z, o1.w);
                *(u32x4*)(OC + (size_t)HGW_TOK(ch, lane) * 512 + h * 128 + cb) = w; }
            else { const f32x4 o0 = *(const f32x4*)(sO + lane * 4); u32x2 w; w.x = pk2(o0.x, o0.y); w.y = pk2(o0.z, o0.w);
                *(u32x2*)(OC + (size_t)HGW_TOK(ch, lane) * 512 + h * 128 + cb) = w; }
        }
    }
#undef HGW_LOAD
#undef HGW_TOK
    if (!smp) {
#pragma unroll
        for (int c = 0; c < R; ++c)
#pragma unroll
            for (int i = 0; i < 4; ++i) { float* dp = a.out + O_SH + ((size_t)((b * 2 + dir) * 4 + h) * 128 + (i < 2 ? 4 * ksl + 2 * i : 64 + 4 * ksl + 2 * (i - 2))) * 128 + c0 + c; dp[0] = St[c][i].x; dp[128] = St[c][i].y; }
    }
}
template <int R>
__device__ __forceinline__ void rwkv_wjob(const Args& a, unsigned char* wl, bool smp, int j, int lane) {
    unsigned char* ws = a.ws;
    constexpr int NRG = 8 / R;
    const int chain = j / NRG, rg = j % NRG, b = chain >> 4, h = (chain >> 1) & 7, dir = chain & 1;
    const int tok0 = smp ? NCTX + b * 1024 : b * 256, S = smp ? 1024 : 256;
    const int rp = lane >> 3, ksl = lane & 7, k0 = ksl * 8, rb = rg * 8 * R, r0 = rb + rp * R;
    const bf16* KK = (const bf16*)(ws + WS_KK); const bf16* KKA = (const bf16*)(ws + WS_KKA); const bf16* KT = (const bf16*)(ws + WS_KT);
    const bf16* Rr = (const bf16*)(ws + WS_R); const bf16* V1 = (const bf16*)(ws + WS_V1); const float* W = (const float*)(ws + (dir ? WS_WB : WS_WF));
    bf16* OD = (bf16*)(ws + (dir ? WS_ODB : WS_ODF));
    f32x2 St[R][4];
#pragma unroll
    for (int c = 0; c < R; ++c)
#pragma unroll
        for (int i = 0; i < 4; ++i) {
            if (smp) St[c][i] = *(const f32x2*)(a.in[7] + ((size_t)((b * 2 + dir) * 8 + h) * 64 + r0 + c) * 64 + k0 + 2 * i);
            else St[c][i] = (f32x2){0.f, 0.f}; }
    float* sX = (float*)wl;
    float* sV = sX + 2560; float* sO = sV + 128; float* sP = sO + 128;
    u32x4 rkk0, rka0, rkt0, rr0, rv0, rkk1, rka1, rkt1, rr1, rv1; f32x4 rw0[2], rw1[2];
#define RWW_TOK(ch, st) (tok0 + (dir ? S - 1 - ((ch) * 8 + (st)) : ((ch) * 8 + (st))))
#define RWW_LOAD(ch, Z) do { const size_t o_ = (size_t)RWW_TOK(ch, lane >> 3) * 512 + h * 64 + (lane & 7) * 8; \
        rkk##Z = *(const u32x4*)(KK + o_); rka##Z = *(const u32x4*)(KKA + o_); rkt##Z = *(const u32x4*)(KT + o_); rr##Z = *(const u32x4*)(Rr + o_); \
        _Pragma("unroll") for (int m = 0; m < 2; ++m) { const int i_ = lane + 64 * m; rw##Z[m] = *(const f32x4*)(W + (size_t)RWW_TOK(ch, i_ >> 4) * 512 + h * 64 + (i_ & 15) * 4); } \
        if (lane < 8 * R) rv##Z = *(const u32x4*)(V1 + (size_t)RWW_TOK(ch, lane / R) * 512 + h * 64 + rb + (lane % R) * 8); } while (0)
#define RWW_PUT(slot, reg) do { float* d_ = sX + (lane >> 3) * 320 + (slot) * 64 + (lane & 7) * 8; \
        *(f32x4*)d_ = (f32x4){bflo(reg.x), bfhi(reg.x), bflo(reg.y), bfhi(reg.y)}; *(f32x4*)(d_ + 4) = (f32x4){bflo(reg.z), bfhi(reg.z), bflo(reg.w), bfhi(reg.w)}; } while (0)
#define RWW_CHUNK(ch, Z) do { \
        RWW_PUT(0, rkk##Z); RWW_PUT(2, rka##Z); RWW_PUT(3, rkt##Z); RWW_PUT(4, rr##Z); \
        _Pragma("unroll") for (int m = 0; m < 2; ++m) { const int i_ = lane + 64 * m; *(f32x4*)(sX + (i_ >> 4) * 320 + 64 + (i_ & 15) * 4) = rw##Z[m]; } \
        if (lane < 8 * R) { float* d_ = sV + lane * 8; *(f32x4*)d_ = (f32x4){bflo(rv##Z.x), bfhi(rv##Z.x), bflo(rv##Z.y), bfhi(rv##Z.y)}; *(f32x4*)(d_ + 4) = (f32x4){bflo(rv##Z.z), bfhi(rv##Z.z), bflo(rv##Z.w), bfhi(rv##Z.w)}; } \
        if ((ch) + 2 < nch) RWW_LOAD((ch) + 2, Z); \
        float ob[8][R]; \
        _Pragma("unroll") for (int st = 0; st < 8; ++st) { \
            f32x4 X[10]; float V[R]; \
            const float* x_ = sX + st * 320 + k0; \
            _Pragma("unroll") for (int q = 0; q < 5; ++q) { X[2 * q] = *(const f32x4*)(x_ + 64 * q); X[2 * q + 1] = *(const f32x4*)(x_ + 64 * q + 4); } \
            _Pragma("unroll") for (int c = 0; c < R; ++c) V[c] = sV[st * 8 * R + rp * R + c]; \
            rwkv_step<R>(X, V, St, ob[st]); } \
        _Pragma("unroll") for (int st = 0; st < 8; ++st) _Pragma("unroll") for (int c = 0; c < R; ++c) sP[((st * 8 + rp) * R + c) * 8 + ksl] = ob[st][c]; \
        _Pragma("unroll") for (int m = 0; m < R; ++m) { const int q_ = lane + 64 * m; const f32x4 p0_ = *(const f32x4*)(sP + q_ * 8), p1_ = *(const f32x4*)(sP + q_ * 8 + 4); \
            sO[q_] = ((p0_.x + p0_.y) + (p0_.z + p0_.w)) + ((p1_.x + p1_.y) + (p1_.z + p1_.w)); } \
        if (lane < 8 * R) { const float* o_ = sO + lane * 8; const f32x4 o0 = *(const f32x4*)o_, o1 = *(const f32x4*)(o_ + 4); \
            u32x4 w; w.x = pk2(o0.x, o0.y); w.y = pk2(o0.z, o0.w); w.z = pk2(o1.x, o1.y); w.w = pk2(o1.z, o1.w); \
            *(u32x4*)(OD + (size_t)RWW_TOK(ch, lane / R) * 512 + h * 64 + rb + (lane % R) * 8) = w; } } while (0)
    const int nch = S / 8;
    RWW_LOAD(0, 0); RWW_LOAD(1, 1);
    for (int ch = 0; ch < nch; ch += 2) { RWW_CHUNK(ch, 0); RWW_CHUNK(ch + 1, 1); }
#undef RWW_CHUNK
#undef RWW_LOAD
#undef RWW_PUT
#undef RWW_TOK
    if (!smp) {
#pragma unroll
        for (int c = 0; c < R; ++c)
#pragma unroll
            for (int i = 0; i < 4; ++i) *(f32x2*)(a.out + O_SR + ((size_t)((b * 2 + dir) * 8 + h) * 64 + r0 + c) * 64 + k0 + 2 * i) = St[c][i];
    }
}
__device__ __forceinline__ void hgrn_chain(const Args& a, unsigned char* lds, bool smp, int chain) {
    unsigned char* ws = a.ws;
    const int tid = opq((int)threadIdx.x), lane = tid & 63, wave = tid >> 6, fr = lane & 15, fq = lane >> 4;
    const int b = chain >> 3, h = (chain >> 1) & 3, dir = chain & 1;
    const int tok0 = smp ? NCTX + b * 1024 : b * 256, S = smp ? 1024 : 256;
    const float* HG = (const float*)(ws + WS_HG); bf16* OC = (bf16*)(ws + (dir ? WS_OCB : WS_OCF));
    float* sFr = (float*)lds; float* sQr = sFr + 2048;
    bf16* sVT = (bf16*)(lds + 16384);
    bf16* sQs = (bf16*)(lds + 22528);
    bf16* sKn = (bf16*)(lds + 26880);
    bf16* sKeT = (bf16*)(lds + 31232);
    float* sDec = (float*)(lds + 37376);
    bf16* sPm = (bf16*)(lds + 37888);
    float* sPart = (float*)(lds + 38912);
    const int e = wave * 16 + fr;
    f32x4 acc[8];
#pragma unroll
    for (int kt = 0; kt < 8; ++kt) {
        if (smp) { const float* sp = a.in[6] + ((size_t)((b * 2 + dir) * 4 + h) * 128 + kt * 16 + fq * 4) * 128 + e; acc[kt] = (f32x4){sp[0], sp[128], sp[256], sp[384]}; }
        else acc[kt] = (f32x4){0.f, 0.f, 0.f, 0.f}; }
    const int tl = tid >> 5, c4 = (tid & 31) * 4;
    f32x4 rf, rq, rv;
#define HC_TOK(ch, t) (tok0 + (dir ? S - 1 - ((ch) * 16 + (t)) : ((ch) * 16 + (t))))
#define HC_LOAD(ch) do { const float* r_ = HG + (size_t)HC_TOK(ch, tl) * 2560 + h * 128 + c4; rq = *(const f32x4*)r_; rf = *(const f32x4*)(r_ + 512 + dir * 512); rv = *(const f32x4*)(r_ + 1536); } while (0)
    HC_LOAD(0);
    const int nch = S / 16;
    for (int ch = 0; ch < nch; ++ch) {
        __syncthreads();
        *(f32x4*)(sFr + tl * 128 + c4) = rf; *(f32x4*)(sQr + tl * 128 + c4) = rq;
        sVT[(c4 + 0) * 24 + tl] = f2bf(rv.x); sVT[(c4 + 1) * 24 + tl] = f2bf(rv.y); sVT[(c4 + 2) * 24 + tl] = f2bf(rv.z); sVT[(c4 + 3) * 24 + tl] = f2bf(rv.w);
        __syncthreads();
        if (ch + 1 < nch) HC_LOAD(ch + 1);
        {
            const int k = tid & 127, part = tid >> 7; float lf[4], fv[4], cs = 0.f;
#pragma unroll
            for (int i = 0; i < 4; ++i) { fv[i] = sFr[(part * 4 + i) * 128 + k]; lf[i] = __logf(fv[i]); cs += lf[i]; }
            sPart[part * 128 + k] = cs;
            __syncthreads();
            const float p0 = sPart[k], p1 = sPart[128 + k], p2 = sPart[256 + k], p3 = sPart[384 + k];
            float cum = part > 0 ? p0 : 0.f; cum += part > 1 ? p1 : 0.f; cum += part > 2 ? p2 : 0.f;
            const float dec = __expf((p0 + p1) + (p2 + p3)); if (part == 0) sDec[k] = dec;
            float kd[4];
#pragma unroll
            for (int i = 0; i < 4; ++i) { const int t = part * 4 + i; cum += lf[i]; const float e1 = __expf(cum), e2 = 1.f / e1, kn = (1.f - fv[i]) * e2;
                sQs[t * 136 + k] = f2bf(sQr[t * 128 + k] * e1); sKn[t * 136 + k] = f2bf(kn); kd[i] = kn * dec; }
            *(u32x2*)(sKeT + k * 24 + part * 4) = (u32x2){pk2(kd[0], kd[1]), pk2(kd[2], kd[3])};
        }
        __syncthreads();
        if (wave == 7) {
            f32x4 pc = {0.f, 0.f, 0.f, 0.f};
#pragma unroll
            for (int m = 0; m < 4; ++m) { const bf16x8 aa = *(const bf16x8*)(sQs + fr * 136 + 32 * m + 8 * fq), bb = *(const bf16x8*)(sKn + fr * 136 + 32 * m + 8 * fq);
                pc = __builtin_amdgcn_mfma_f32_16x16x32_bf16(aa, bb, pc, 0, 0, 0); }
            const float pv[4] = {pc.x, pc.y, pc.z, pc.w};
#pragma unroll
            for (int j = 0; j < 4; ++j) { const int t = fq * 4 + j; sPm[t * 24 + fr] = f2bf(fr <= t ? pv[j] : 0.f); }
        }
        f32x4 O = {0.f, 0.f, 0.f, 0.f};
#pragma unroll
        for (int m = 0; m < 4; ++m) {
            const u32x2 lo = *(const u32x2*)(sQs + fr * 136 + 32 * m + 4 * fq), hi = *(const u32x2*)(sQs + fr * 136 + 32 * m + 16 + 4 * fq);
            const u32x4 aw = {lo.x, lo.y, hi.x, hi.y};
            u32x4 bw; bw.x = pk2(acc[2 * m].x, acc[2 * m].y); bw.y = pk2(acc[2 * m].z, acc[2 * m].w); bw.z = pk2(acc[2 * m + 1].x, acc[2 * m + 1].y); bw.w = pk2(acc[2 * m + 1].z, acc[2 * m + 1].w);
            O = __builtin_amdgcn_mfma_f32_16x16x32_bf16(__builtin_bit_cast(bf16x8, aw), __builtin_bit_cast(bf16x8, bw), O, 0, 0, 0);
        }
        __syncthreads();
        const u32x4 zero4 = {0u, 0u, 0u, 0u};
        const u32x4 bvw = fq < 2 ? *(const u32x4*)(sVT + e * 24 + fq * 8) : zero4; const bf16x8 bV = __builtin_bit_cast(bf16x8, bvw);
        { const u32x4 aw = fq < 2 ? *(const u32x4*)(sPm + fr * 24 + fq * 8) : zero4;
          O = __builtin_amdgcn_mfma_f32_16x16x32_bf16(__builtin_bit_cast(bf16x8, aw), bV, O, 0, 0, 0); }
#pragma unroll
        for (int kt = 0; kt < 8; ++kt) {
            const f32x4 dc = *(const f32x4*)(sDec + kt * 16 + fq * 4);
            acc[kt] = acc[kt] * dc;
            const u32x4 aw = fq < 2 ? *(const u32x4*)(sKeT + (kt * 16 + fr) * 24 + fq * 8) : zero4;
            acc[kt] = __builtin_amdgcn_mfma_f32_16x16x32_bf16(__builtin_bit_cast(bf16x8, aw), bV, acc[kt], 0, 0, 0);
        }
        { const float ov[4] = {O.x, O.y, O.z, O.w};
#pragma unroll
          for (int j = 0; j < 4; ++j) OC[(size_t)HC_TOK(ch, fq * 4 + j) * 512 + h * 128 + e] = f2bf(ov[j]); }
    }
#undef HC_LOAD
#undef HC_TOK
    if (!smp) {
#pragma unroll
        for (int kt = 0; kt < 8; ++kt) { float* dp = a.out + O_SH + ((size_t)((b * 2 + dir) * 4 + h) * 128 + kt * 16 + fq * 4) * 128 + e; dp[0] = acc[kt].x; dp[128] = acc[kt].y; dp[256] = acc[kt].z; dp[384] = acc[kt].w; }
    }
    __syncthreads();
}
__device__ __forceinline__ void scan_phase(const Args& a, unsigned char* lds) {
    const int tid = opq((int)threadIdx.x), lane = tid & 63, wave = __builtin_amdgcn_readfirstlane(tid >> 6);
    unsigned* qc = (unsigned*)(a.ws + WS_QCTR);
    if (gridDim.x != 256) {
        int* sj = (int*)(lds + 65536);
        for (;;) {
            if (tid == 0) *sj = (int)atomicAdd(qc + 1, 1u);
            __syncthreads();
            const int job = *sj;
            __syncthreads();
            if (job >= 160) break;
            if (job < 32) hgrn_chain(a, lds, true, job); else hgrn_chain(a, lds, false, job - 32);
        }
        unsigned char* wl = lds + wave * 16384;
        for (;;) {
            int j = 0;
            if (lane == 0) j = (int)atomicAdd(qc, 1u);
            j = __builtin_amdgcn_readfirstlane(j);
            if (j >= 1536) break;
            if (j < 512) rwkv_wjob<1>(a, wl, true, j, lane); else rwkv_wjob<2>(a, wl, false, j - 512, lane);
        }
        return;
    }
    if (blockIdx.x < 32 || blockIdx.x >= 160) {
#ifdef PROBE_LONG
        const unsigned long long th0_ = wall_clock64();
#endif
        if (blockIdx.x < 32) hgrn_chain(a, lds, true, (int)blockIdx.x);
#ifdef PROBE_LONG
        if (PROBE_LONG == 2 && blockIdx.x == 0 && tid == 0) a.out[0] += (float)(wall_clock64() - th0_) * 1e-4f;
#endif
        int* sj = (int*)(lds + 65536);
        for (;;) {
            if (tid == 0) *sj = (int)atomicAdd(qc + 1, 1u);
            __syncthreads();
            const int job = *sj;
            __syncthreads();
            if (job >= 128) break;
            hgrn_chain(a, lds, false, job);
        }
#ifdef PROBE_LONG
        if (PROBE_LONG == 3 && blockIdx.x == 160 && tid == 0) a.out[0] += (float)(wall_clock64() - th0_) * 1e-4f;
#endif
    } else if (wave < 4) {
#ifdef PROBE_LONG
        const unsigned long long tl0_ = wall_clock64();
#endif
        __builtin_amdgcn_s_setprio(3);
        rwkv_wjob<1>(a, lds + wave * 16384, true, ((int)blockIdx.x - 32) * 4 + wave, lane);
        __builtin_amdgcn_s_setprio(0);
#ifdef PROBE_LONG
        if (PROBE_LONG == 1 && blockIdx.x == 32 && wave == 0 && lane == 0) a.out[0] += (float)(wall_clock64() - tl0_) * 1e-4f;
#endif
    } else return;
    unsigned char* wl = lds + wave * 16384;
    for (;;) {
        int j = 0;
        if (lane == 0) j = (int)atomicAdd(qc, 1u);
        j = __builtin_amdgcn_readfirstlane(j);
        if (j >= 1024) break;
        rwkv_wjob<2>(a, wl, false, j, lane);
    }
}

__device__ __forceinline__ void post1_phase(const Args& a) {
    const int lane = opq((int)threadIdx.x) & 63, wave = opq((int)threadIdx.x) >> 6, gw = blockIdx.x * 8 + wave, NGW = gridDim.x * 8;
    unsigned char* ws = a.ws;
    const bf16* OCF = (const bf16*)(ws + WS_OCF); const bf16* OCB = (const bf16*)(ws + WS_OCB); const bf16* ODF = (const bf16*)(ws + WS_ODF); const bf16* ODB = (const bf16*)(ws + WS_ODB);
    const float* HG = (const float*)(ws + WS_HG); const bf16* R = (const bf16*)(ws + WS_R); const bf16* KT = (const bf16*)(ws + WS_KT); const bf16* V1 = (const bf16*)(ws + WS_V1); const bf16* G = (const bf16*)(ws + WS_G);
    bf16* CAT = (bf16*)(ws + WS_CAT2);
    const int col = lane * 8;
    for (int t = gw; t < NTOK; t += NGW) {
        {
            const u32x4 xa = *(const u32x4*)(OCF + (size_t)t * 512 + col), xb = *(const u32x4*)(OCB + (size_t)t * 512 + col);
            float x[8], ss = 0.f;
#pragma unroll
            for (int k = 0; k < 4; ++k) { x[2 * k] = bflo(xa[k]) + bflo(xb[k]); x[2 * k + 1] = bfhi(xa[k]) + bfhi(xb[k]); }
#pragma unroll
            for (int k = 0; k < 8; ++k) ss += x[k] * x[k];
            ss += __shfl_xor(ss, 1); ss += __shfl_xor(ss, 2); ss += __shfl_xor(ss, 4); ss += __shfl_xor(ss, 8);
            const float rs = rsqrtf(ss * (1.f / 128.f) + 1e-6f);
            const float* gn = a.in[24] + (col & 127); const float* gc = HG + (size_t)t * 2560 + 2048 + col;
            float y[8];
#pragma unroll
            for (int k = 0; k < 8; ++k) y[k] = x[k] * rs * gn[k] * silu(gc[k]);
            u32x4 w; w.x = pk2(y[0], y[1]); w.y = pk2(y[2], y[3]); w.z = pk2(y[4], y[5]); w.w = pk2(y[6], y[7]);
            *(u32x4*)(CAT + (size_t)t * 1024 + col) = w;
        }
        {
            const u32x4 xa = *(const u32x4*)(ODF + (size_t)t * 512 + col), xb = *(const u32x4*)(ODB + (size_t)t * 512 + col);
            const u32x4 rw = *(const u32x4*)(R + (size_t)t * 512 + col), kw = *(const u32x4*)(KT + (size_t)t * 512 + col), vw = *(const u32x4*)(V1 + (size_t)t * 512 + col), gw_ = *(const u32x4*)(G + (size_t)t * 512 + col);
            float x[8], r[8], kt[8], v[8], g[8], sm = 0.f, bs = 0.f;
#pragma unroll
            for (int k = 0; k < 4; ++k) { x[2 * k] = bflo(xa[k]) + bflo(xb[k]); x[2 * k + 1] = bfhi(xa[k]) + bfhi(xb[k]); r[2 * k] = bflo(rw[k]); r[2 * k + 1] = bfhi(rw[k]);
                kt[2 * k] = bflo(kw[k]); kt[2 * k + 1] = bfhi(kw[k]); v[2 * k] = bflo(vw[k]); v[2 * k + 1] = bfhi(vw[k]); g[2 * k] = bflo(gw_[k]); g[2 * k + 1] = bfhi(gw_[k]); }
            const float* rk = a.in[33] + col; const float* lg = a.in[34] + col; const float* lbb = a.in[35] + col;
#pragma unroll
            for (int k = 0; k < 8; ++k) { sm += x[k]; bs += r[k] * kt[k] * rk[k]; }
            sm += __shfl_xor(sm, 1); sm += __shfl_xor(sm, 2); sm += __shfl_xor(sm, 4);
            bs += __shfl_xor(bs, 1); bs += __shfl_xor(bs, 2); bs += __shfl_xor(bs, 4);
            const float mean = sm * (1.f / 64.f); float vs = 0.f;
#pragma unroll
            for (int k = 0; k < 8; ++k) { const float d = x[k] - mean; vs += d * d; }
            vs += __shfl_xor(vs, 1); vs += __shfl_xor(vs, 2); vs += __shfl_xor(vs, 4);
            const float rs = rsqrtf(vs * (1.f / 64.f) + 64e-5f);
            float y[8];
#pragma unroll
            for (int k = 0; k < 8; ++k) y[k] = ((x[k] - mean) * rs * lg[k] + lbb[k] + bs * v[k]) * g[k];
            u32x4 w; w.x = pk2(y[0], y[1]); w.y = pk2(y[2], y[3]); w.z = pk2(y[4], y[5]); w.w = pk2(y[6], y[7]);
            *(u32x4*)(CAT + (size_t)t * 1024 + 512 + col) = w;
        }
    }
}

#define LAS __attribute__((address_space(3)))
#define XB_TMO      128
#define XB_XCNT(j)  (256  + 64 * (j))
#define XB_XSUB(j)  (1280 + 64 * (j))
#define XB_XGEN(j)  (2304 + 64 * (j))
#define XB_TOP      3328
#define XB_TOPGEN   3392
#define XCD_BAR_WORDS 3456
#define XB_SPIN_CAP (1u << 18)

__device__ __forceinline__ unsigned xb_ld(unsigned* p)              { return __hip_atomic_load(p, __ATOMIC_RELAXED, __HIP_MEMORY_SCOPE_AGENT); }
__device__ __forceinline__ unsigned xb_add(unsigned* p, unsigned v) { return __hip_atomic_fetch_add(p, v, __ATOMIC_RELAXED, __HIP_MEMORY_SCOPE_AGENT); }
__device__ __forceinline__ unsigned xb_xcc_id() { return (unsigned)__builtin_amdgcn_s_getreg((3 << 11) | 20) & 0xFu; }
#define XB_SPIN(cond, bar) do { unsigned _sp = 0; while (cond) { __builtin_amdgcn_s_sleep(1); \
    if ((++_sp & 255u) == 0u) { if (xb_ld(&(bar)[XB_TMO])) break; if (_sp > XB_SPIN_CAP) { atomicAdd(&(bar)[XB_TMO], 1u); break; } } } } while (0)

struct XcdBarrier {
    unsigned* bar; unsigned x;
    volatile LAS unsigned* st;
};

__device__ __forceinline__ XcdBarrier xcd_barrier_post(unsigned* bar, volatile LAS unsigned* st) {
    XcdBarrier b; b.bar = bar; b.x = xb_xcc_id(); b.st = st;
    if (threadIdx.x == 0) (void)xb_add(&bar[XB_XCNT(b.x)], 1u);
    return b;
}
__device__ __forceinline__ void xcd_barrier_complete(unsigned* bar, unsigned x, unsigned& nloc, unsigned& nx) {
    const unsigned G = gridDim.x * gridDim.y * gridDim.z;
    unsigned sum, cnt, mine, sp = 0u;
    for (;;) {
        sum = 0u; cnt = 0u; mine = 0u;
#pragma unroll
        for (unsigned j = 0; j < 16; ++j) { const unsigned c = xb_ld(&bar[XB_XCNT(j)]); sum += c; cnt += (c > 0u) ? 1u : 0u; mine = (j == x) ? c : mine; }
        if (sum == G) break;
        __builtin_amdgcn_s_sleep(1);
        if ((++sp & 255u) == 0u) { if (xb_ld(&bar[XB_TMO])) break; if (sp > XB_SPIN_CAP) { atomicAdd(&bar[XB_TMO], 1u); break; } }
    }
    nloc = mine > 0u ? mine : 1u; nx = cnt > 0u ? cnt : 1u;
}

__device__ __forceinline__ void xcd_barrier(const XcdBarrier& b) {
    asm volatile("s_waitcnt vmcnt(0)" ::: "memory");
    __syncthreads();
    if (threadIdx.x == 0) {
        unsigned* bar = b.bar;
        __builtin_amdgcn_s_waitcnt(0);
        unsigned nloc = b.st[0], nx = b.st[1];
        if (nloc == 0u) { xcd_barrier_complete(bar, b.x, nloc, nx); b.st[0] = nloc; b.st[1] = nx; }
        const unsigned old = xb_add(&bar[XB_XSUB(b.x)], 1u);
        const unsigned gen = old / nloc;
        if (old + 1u == (gen + 1u) * nloc) {
            __builtin_amdgcn_fence(__ATOMIC_RELEASE, "agent");
            asm volatile("s_waitcnt vmcnt(0)" ::: "memory");
            const unsigned og = xb_add(&bar[XB_TOP], 1u);
            const unsigned tg = og / nx;
            if (og + 1u == (tg + 1u) * nx) xb_add(&bar[XB_TOPGEN], 1u);
            else XB_SPIN(xb_ld(&bar[XB_TOPGEN]) == tg, bar);
            __builtin_amdgcn_fence(__ATOMIC_ACQUIRE, "agent");
            xb_add(&bar[XB_XGEN(b.x)], 1u);
            asm volatile("s_waitcnt vmcnt(0)" ::: "memory");
        } else {
            XB_SPIN(xb_ld(&bar[XB_XGEN(b.x)]) == gen, bar);
            __builtin_amdgcn_fence(__ATOMIC_ACQUIRE, "agent");
            asm volatile("s_waitcnt vmcnt(0)" ::: "memory");
        }
    }
    __syncthreads();
}

constexpr int LDS_BYTES = 131072 + 256, NPHASE = 21;
constexpr size_t WS_BAR = 512 * 1024;
#ifdef DBG_USE_H
#define DBG_A5 H
#else
#define DBG_A5 (const bf16*)(ws + WS_CAT)
#endif
__global__ void __launch_bounds__(512, 2) trunk_fwd(Args a) {
    extern __shared__ __attribute__((aligned(16))) unsigned char lds[];
    cg::grid_group grid = cg::this_grid();
    unsigned char* ws = a.ws;
    const float* MOD = (const float*)(ws + WS_MOD);
    bf16* H = (bf16*)(ws + WS_H);
    XcdBarrier bar; bar.bar = (unsigned*)(ws + WS_BAR); bar.x = 0; bar.st = nullptr;
    if (a.ph_hi - a.ph_lo > 1) {
        volatile LAS unsigned* st = (volatile LAS unsigned*)((LAS unsigned char*)lds + 131072);
        if (opq((int)threadIdx.x) < 2) st[opq((int)threadIdx.x)] = 0u;
        __syncthreads();
        bar = xcd_barrier_post((unsigned*)(ws + WS_BAR), st);
    }
    if (a.ph_hi == 0x7fffffff) grid.sync();
#define GBAR() xcd_barrier(bar)
#ifdef ONLY_PHASE
#define PH(k) if ((k) == ONLY_PHASE)
#else
#define PH(k) if (a.ph_lo <= (k) && (k) < a.ph_hi)
#endif
#ifdef PROBE_MASK
#ifndef PROBE_SCALE
#define PROBE_SCALE 1e-4f
#endif
    unsigned long long tacc = 0, tprev = wall_clock64();
#define SEAM(k) { if (a.ph_lo <= (k) && (k) + 1 < a.ph_hi) GBAR(); const unsigned long long tn_ = wall_clock64(); if ((PROBE_MASK >> (k)) & 1) tacc += tn_ - tprev; tprev = tn_; }
#else
#define SEAM(k) if (a.ph_lo <= (k) && (k) + 1 < a.ph_hi) GBAR();
#endif
    PH(0) { phase0(a, lds); } SEAM(0)
    PH(1) { norm_phase<0, false>(a, a.in[12], 0, 0, 1024); } SEAM(1)
    PH(2) { EpiF32 E{(float*)(ws + WS_PROJ), 2304}; run_gemm(lds, H, (const bf16*)(ws + WS_EVIN), 9, 1024, 1024, 9, E);
            if (blockIdx.x >= 32) {
                const int w_ = ((int)blockIdx.x - 32) * 8 + (opq((int)threadIdx.x) >> 6), nw_ = ((int)gridDim.x - 32) * 8;
                tr_range(a, lds, 10112, 12832, w_, nw_); fill_l1_small(a, ((int)blockIdx.x - 32) * 512 + opq((int)threadIdx.x), ((int)gridDim.x - 32) * 512); } } SEAM(2)
    PH(3) { qkv_post(a, lds); } SEAM(3)
    PH(4) { attn_phase(a, lds); } SEAM(4)
#ifdef DBG_COPY_CAT
    PH(5) { const bf16* C_ = (const bf16*)(ws + WS_CAT); for (int i = blockIdx.x * 512 + opq((int)threadIdx.x); i < NTOK * 1024; i += gridDim.x * 512) {
#if DBG_COPY_CAT == 2
        const int t_ = i >> 10, c_ = i & 1023; a.out[i] = bf2f(c_ < 512 ? ((const bf16*)(ws + WS_QB))[t_ * 512 + c_] : ((const bf16*)(ws + WS_KBS))[(size_t)t_ * 96 + (c_ - 512) % 96]);
#elif DBG_COPY_CAT == 3
        const int t_ = i >> 10, c_ = i & 1023; a.out[i] = bf2f(c_ < 512 ? ((const bf16*)(ws + WS_VBTS))[t_ * 96 + c_ % 96] : ((const bf16*)(ws + WS_KBC))[(size_t)t_ * 64 + (c_ - 512) % 64]) + bf2f(((const bf16*)(ws + WS_VBTC))[(size_t)t_ * 64 + c_ % 64]);
#else
        a.out[i] = bf2f(C_[i]);
#endif
    } } SEAM(5)
#else
    PH(5) { EpiResid E{a.out, MOD + 2048,(float*)(ws + WS_TMP), a.in[0], a.in[1]}; run_gemm(lds, DBG_A5, (const bf16*)(ws + WS_EVOUT), 4, 1024, 1024, 4, E);
            if (blockIdx.x >= 128) {
                const int w_ = ((int)blockIdx.x - 128) * 8 + (opq((int)threadIdx.x) >> 6), nw_ = ((int)gridDim.x - 128) * 8;
                tr_range(a, lds, 1664, 4480, w_, nw_); tr_range(a, lds, 7296, 8704, w_, nw_); } } SEAM(5)
#endif
    PH(6) { norm_phase<1, false>(a, a.in[13], 0, 3072, 4096); } SEAM(6)
    PH(7) { EpiBf16 E{(bf16*)(ws + WS_U), 5632}; run_gemm(lds, H, (const bf16*)(ws + WS_UP0), 22, 1024, 1024, 22, E); } SEAM(7)
    PH(8) { conv_phase(a, 0); } SEAM(8)
    PH(9) { EpiResid E{a.out, MOD + 5120,(float*)(ws + WS_TMP), a.out, a.out + (size_t)NCTX * DM}; run_gemm(lds, (const bf16*)(ws + WS_ACT), (const bf16*)(ws + WS_DOWN0), 8, 1408, 2816, 4, E); } SEAM(9)
    PH(10) { norm_phase<1, true>(a, a.in[12] + 1024, 1, 0, 1024); } SEAM(10)
    PH(11) { EpiOdIn E{(float*)(ws + WS_HG), (bf16*)(ws + WS_PR), (const float*)(ws + WS_LB)}; run_gemm(lds, H, (const bf16*)(ws + WS_ODIN), 18, 1024, 1024, 18, E);
            if (blockIdx.x >= 64) {
                const int w_ = ((int)blockIdx.x - 64) * 8 + (opq((int)threadIdx.x) >> 6), nw_ = ((int)gridDim.x - 64) * 8;
                tr_range(a, lds, 4480, 7296, w_, nw_); tr_range(a, lds, 8704, 10112, w_, nw_); } } SEAM(11)
    PH(12) { prep1_phase(a); } SEAM(12)
    PH(13) { EpiLora E{(float*)(ws + WS_WF), (float*)(ws + WS_WB), (const bf16*)(ws + WS_KK), (const bf16*)(ws + WS_K1), (bf16*)(ws + WS_KKA), (bf16*)(ws + WS_KT), (bf16*)(ws + WS_G), a.in[26], a.in[28], a.in[32]};
             run_gemm(lds, (const bf16*)(ws + WS_AP), (const bf16*)(ws + WS_LORA), 8, 384, 384, 8, E); } SEAM(13)
    PH(14) { scan_phase(a, lds); } SEAM(14)
    PH(15) { post1_phase(a); } SEAM(15)
    PH(16) { EpiResid E{a.out, MOD + 5 * 6144 + 2048,(float*)(ws + WS_TMP), a.out, a.out + (size_t)NCTX * DM}; run_gemm(lds, (const bf16*)(ws + WS_CAT2), (const bf16*)(ws + WS_ODOUT), 4, 1024, 1024, 4, E); } SEAM(16)
    PH(17) { norm_phase<1, false>(a, a.in[13] + 1024, 1, 3072, 4096); } SEAM(17)
    PH(18) { EpiBf16 E{(bf16*)(ws + WS_U), 5632}; run_gemm(lds, H, (const bf16*)(ws + WS_UP1), 22, 1024, 1024, 22, E); } SEAM(18)
    PH(19) { conv_phase(a, 1); } SEAM(19)
    PH(20) { EpiResid E{a.out, MOD + 5 * 6144 + 5120,(float*)(ws + WS_TMP), a.out, a.out + (size_t)NCTX * DM}; run_gemm(lds, (const bf16*)(ws + WS_ACT), (const bf16*)(ws + WS_DOWN1), 8, 1408, 2816, 4, E); } SEAM(20)
    PH(21) { norm_phase<2, true>(a, a.in[14], 0, 0, 0); }
#ifdef PROBE_MASK
    { unsigned long long tn_ = wall_clock64(); if ((PROBE_MASK >> 21) & 1) tacc += tn_ - tprev;
#ifdef PROBE_SYNCS
      for (int i_ = 0; i_ < 20; ++i_) GBAR();
      tacc = wall_clock64() - tn_;
#endif
#ifdef PROBE_LONG
      __syncthreads(); if (blockIdx.x == PROBE_LONG / 4 && opq((int)threadIdx.x) == 0) a.out[0] += (float)(*(unsigned*)(lds + 131072 + 64)) * PROBE_SCALE;
#else
      if (blockIdx.x == 0 && opq((int)threadIdx.x) == 0) a.out[0] += (float)tacc * PROBE_SCALE;
#endif
    }
#endif
#undef PH
#undef SEAM
}

extern "C" void kernel_launch(void* const* d_in, const int* in_sizes, int n_in, void* d_out, int out_size, void* d_ws, size_t ws_size, hipStream_t stream) {
    static int grid = 0;
    if (grid == 0) {
        int dev = 0, cus = 0, per_cu = 0;
        if (n_in != 40 || out_size != 16777216 || ws_size < 256 * MiB) { fprintf(stderr, "kernel_launch: unexpected shapes n_in %d out %d ws %zu\n", n_in, out_size, ws_size); grid = -1; return; }
        (void)hipGetDevice(&dev); (void)hipDeviceGetAttribute(&cus, hipDeviceAttributeMultiprocessorCount, dev);
        if (hipFuncSetAttribute((const void*)trunk_fwd, hipFuncAttributeMaxDynamicSharedMemorySize, LDS_BYTES) != hipSuccess) { fprintf(stderr, "kernel_launch: hipFuncSetAttribute failed\n"); grid = -1; return; }
        if (hipOccupancyMaxActiveBlocksPerMultiprocessor(&per_cu, (const void*)trunk_fwd, 512, LDS_BYTES) != hipSuccess || per_cu < 1) { fprintf(stderr, "kernel_launch: occupancy query says %d\n", per_cu); per_cu = 1; }
        (void)hipGetLastError();
        grid = cus * (per_cu > 1 ? 1 : per_cu);
        if (grid <= 0) grid = 256;
    }
    if (grid < 0) return;
    Args a{};
    for (int i = 0; i < 40; ++i) a.in[i] = (const float*)d_in[i];
    a.out = (float*)d_out; a.ws = (unsigned char*)d_ws;
#if MK_N_LAUNCHES == 1
    if (hipMemsetAsync((unsigned char*)d_ws + WS_BAR, 0, XCD_BAR_WORDS * sizeof(unsigned), stream) != hipSuccess) { fprintf(stderr, "kernel_launch: memset of the barrier words failed\n"); return; }
    a.ph_lo = 0; a.ph_hi = NPHASE + 1;
    void* args[] = {&a};
    hipError_t e = hipLaunchCooperativeKernel((const void*)trunk_fwd, dim3(grid), dim3(512), args, LDS_BYTES, stream);
    if (e != hipSuccess) fprintf(stderr, "kernel_launch: cooperative launch failed: %s (grid %d)\n", hipGetErrorString(e), grid);
#else
#ifndef RUN_UPTO
#define RUN_UPTO NPHASE
#endif
    for (int p = 0; p <= RUN_UPTO; ++p) { a.ph_lo = p; a.ph_hi = p + 1; hipLaunchKernelGGL(trunk_fwd, dim3(grid), dim3(512), LDS_BYTES, stream, a); }
#endif
}
```

```cpp
#include <hip/hip_runtime.h>
#include <hip/hip_cooperative_groups.h>
#include <cstdio>
#include <cstdint>
namespace cg = cooperative_groups;
#ifndef MK_N_LAUNCHES
#define MK_N_LAUNCHES 1
#endif
namespace pg8 {
#define PG8_LAS __attribute__((address_space(3)))
typedef unsigned short bf16_t;
typedef short bf16x8 __attribute__((ext_vector_type(8)));
typedef float f32x4 __attribute__((ext_vector_type(4)));
typedef unsigned u32x4 __attribute__((ext_vector_type(4)));
constexpr int BM = 256, BK = 64, HALF = 128, HTB = HALF * BK * 2  , STAGE_BYTES = 8 * HTB, NXCD = 8, WGM = 8;

__host__ __device__ __forceinline__ int lds_byte(int r, int c) { const int st = (r >> 4) * 2 + (c >> 5), rr = r & 15, cc = c & 31, ob = rr * 64 + cc * 2; return st * 1024 + (ob ^ (((ob >> 9) & 1) << 5)); }
__host__ __device__ __forceinline__ void stage_rc(int b, int& R, int& C) { const int st = b / 1024, sb = b % 1024, swz = sb ^ (((sb >> 9) & 1) << 5); R = (st >> 1) * 16 + swz / 64; C = (st & 1) * 32 + (swz % 64) / 2; }
__host__ __device__ __forceinline__ int perm32(int rho) { const int n = rho >> 4, i = rho & 15; return 8 * (i >> 2) + 4 * n + (i & 3); }

struct Unit { int pm, pn; };
struct Gemm { const bf16_t* A; const bf16_t* Bt; int M, N, K, ld, nNr; };

struct StaticOrder {
    int nM, nN, nwg, G, c;
    __host__ __device__ void init(int M, int N, int G_, int c_) { nM = M / BM; nN = N / BM; nwg = nM * nN; G = G_; c = c_; }
    __host__ __device__ bool next(int i, Unit& u) const {
        const long L = (long)i * G + c; if (L >= nwg) return false;
        int wgid = (int)L; { const int q = nwg / NXCD, r = nwg % NXCD, xcd = wgid % NXCD, off = wgid / NXCD; wgid = (xcd < r ? xcd * (q + 1) : r * (q + 1) + (xcd - r) * q) + off; }
        const int nig = WGM * nN, gid = wgid / nig, fm = gid * WGM, gsz = (nM - fm) < WGM ? (nM - fm) : WGM;
        u.pm = fm + ((wgid % nig) % gsz); u.pn = (wgid % nig) / gsz; return true;
    }
    __device__ __forceinline__ void a_ready(const Unit&) const {}
    __device__ __forceinline__ void done(const Unit&) const {}
};

template <class Epi, class Sched, bool STAMP = false>
__device__ __forceinline__ void gemm_phase(PG8_LAS unsigned char* lds, const Gemm g, const Sched& S, const Epi& E, unsigned long long* stamps) {
    const int tid = threadIdx.x, wid = __builtin_amdgcn_readfirstlane(tid >> 6), lane = tid & 63, wr = wid >> 2, wc = wid & 3, fr = lane & 15, fq = lane >> 4;
    const int K = g.K, nt = K / BK;
    int ts_lo = 0, ts_hi = 0, nts = 0; const unsigned long long rt_entry = 0ull;
#define PG8_STAMP() do { if (STAMP && wid == 0 && nts < 64) { const unsigned long long _c = (unsigned long long)clock64(); \
        ts_lo = (lane == nts) ? (int)(unsigned)_c : ts_lo; ts_hi = (lane == nts) ? (int)(unsigned)(_c >> 32) : ts_hi; ++nts; } } while (0)
    PG8_STAMP();
    unsigned voffA[2], voffB[2];
#pragma unroll
    for (int i = 0; i < 2; ++i) { int R, C; stage_rc(tid * 16 + i * 8192, R, C); const int Rb = Epi::PERM ? ((R & ~31) + perm32(R & 31)) : R;
        voffA[i] = (unsigned)(R * g.ld + C) * 2u; voffB[i] = (unsigned)(Rb * g.ld + C) * 2u; }
    const size_t kstep = (size_t)(BK * 2);
    const size_t hstep = (size_t)HALF * g.ld * 2;
    const size_t tstep = 2 * hstep;
    const unsigned ldsw = (unsigned)wid * 1024u;
    const int aoff = lds_byte(wr * 64 + fr, fq * 8), boff = lds_byte(wc * 32 + fr, fq * 8);
#define PG8_SA(b, h) (((b) * 2 + (h)) * HTB)
#define PG8_SB(b, h) ((4 + (b) * 2 + (h)) * HTB)
#define PG8_STAGE(bufoff, gbase, voff) do { _Pragma("unroll") for (int _i = 0; _i < 2; ++_i) \
        __builtin_amdgcn_global_load_lds((const unsigned*)((const char*)(gbase) + (voff)[_i]), (PG8_LAS unsigned*)(lds + (bufoff) + ldsw + _i * 8192), 16, 0, 0); } while (0)
#define PG8_LDA(dst, b, h) do { _Pragma("unroll") for (int m = 0; m < 4; ++m) _Pragma("unroll") for (int k = 0; k < 2; ++k) dst[m][k] = *(const PG8_LAS bf16x8*)(lds + PG8_SA(b, h) + aoff + m * 2048 + k * 1024); } while (0)
#define PG8_LDB(dst, b, h) do { _Pragma("unroll") for (int n = 0; n < 2; ++n) _Pragma("unroll") for (int k = 0; k < 2; ++k) dst[n][k] = *(const PG8_LAS bf16x8*)(lds + PG8_SB(b, h) + boff + n * 2048 + k * 1024); } while (0)
#define PG8_MMA(ai, bj, At, Bt) do { __builtin_amdgcn_s_setprio(1); _Pragma("unroll") for (int m = 0; m < 4; ++m) _Pragma("unroll") for (int n = 0; n < 2; ++n) _Pragma("unroll") for (int k = 0; k < 2; ++k) \
        acc[ai][bj][m][n] = __builtin_amdgcn_mfma_f32_16x16x32_bf16(Bt[n][k], At[m][k], acc[ai][bj][m][n], 0, 0, 0); __builtin_amdgcn_s_setprio(0); } while (0)
#define PG8_WAIT_V(n) asm volatile("s_waitcnt vmcnt(" #n ")" ::: "memory")
#define PG8_WAIT_L(n) asm volatile("s_waitcnt lgkmcnt(" #n ")" ::: "memory")
#define PG8_BAR __builtin_amdgcn_s_barrier()
#define PG8_SCHED __builtin_amdgcn_sched_barrier(0)
    Unit cur, nxt; int ui = 0;
    if (!S.next(0, cur)) return;
    f32x4 acc[2][2][4][2];
#pragma unroll
    for (int a = 0; a < 2; ++a)
#pragma unroll
        for (int b = 0; b < 2; ++b)
#pragma unroll
            for (int m = 0; m < 4; ++m)
#pragma unroll
                for (int n = 0; n < 2; ++n) acc[a][b][m][n] = (f32x4){0.f, 0.f, 0.f, 0.f};
    bf16x8 At[4][2], B0[2][2], B1[2][2];
    const char* cA = (const char*)g.A + (size_t)cur.pm * tstep + (size_t)(cur.pn / g.nNr) * K * 2; const char* cB = (const char*)g.Bt + (size_t)(cur.pn % g.nNr) * tstep + (size_t)(cur.pn / g.nNr) * K * 2;
    S.a_ready(cur);
    PG8_STAGE(PG8_SB(0, 0), cB, voffB); PG8_STAGE(PG8_SA(0, 0), cA, voffA); PG8_STAGE(PG8_SB(0, 1), cB + hstep, voffB); PG8_STAGE(PG8_SA(0, 1), cA + hstep, voffA);
    if (wr == 1) PG8_BAR;
    PG8_WAIT_V(4); PG8_BAR;
    PG8_STAGE(PG8_SB(1, 0), cB + kstep, voffB); PG8_STAGE(PG8_SA(1, 0), cA + kstep, voffA); PG8_STAGE(PG8_SB(1, 1), cB + hstep + kstep, voffB);
    PG8_WAIT_V(6); PG8_BAR;
    PG8_STAMP();
    for (;;) {
        const bool has_next = S.next(ui + 1, nxt);
        const char* nA = has_next ? (const char*)g.A + (size_t)nxt.pm * tstep + (size_t)(nxt.pn / g.nNr) * K * 2 : cA; const char* nB = has_next ? (const char*)g.Bt + (size_t)(nxt.pn % g.nNr) * tstep + (size_t)(nxt.pn / g.nNr) * K * 2 : cB;
        for (int t = 0; t < nt; t += 2) {
            const bool last = (t == nt - 2);
            const char* a1 = cA + (size_t)(t + 1) * kstep;
            const char* a2 = last ? nA : cA + (size_t)(t + 2) * kstep; const char* b2 = last ? nB : cB + (size_t)(t + 2) * kstep;
            const char* a3 = a2 + kstep; const char* b3 = b2 + kstep;
            if (last && has_next) S.a_ready(nxt);
            PG8_LDB(B0, 0, 0); PG8_SCHED; PG8_LDA(At, 0, 0); PG8_STAGE(PG8_SA(1, 1), a1 + hstep, voffA);
            PG8_WAIT_L(8); PG8_BAR; PG8_WAIT_L(0); PG8_MMA(0, 0, At, B0); PG8_BAR; PG8_SCHED;
            PG8_LDB(B1, 0, 1); PG8_STAGE(PG8_SB(0, 0), b2, voffB);
            PG8_BAR; PG8_WAIT_L(0); PG8_MMA(0, 1, At, B1); PG8_BAR;
            PG8_LDA(At, 0, 1); PG8_STAGE(PG8_SA(0, 0), a2, voffA);
            PG8_BAR; PG8_WAIT_L(0); PG8_MMA(1, 0, At, B0); PG8_BAR; PG8_SCHED;
            PG8_STAGE(PG8_SB(0, 1), b2 + hstep, voffB);
            PG8_WAIT_V(6); PG8_BAR; PG8_MMA(1, 1, At, B1); PG8_BAR;
            PG8_LDB(B0, 1, 0); PG8_SCHED; PG8_LDA(At, 1, 0); PG8_STAGE(PG8_SA(0, 1), a2 + hstep, voffA);
            PG8_WAIT_L(8); PG8_BAR; PG8_WAIT_L(0); PG8_MMA(0, 0, At, B0); PG8_BAR; PG8_SCHED;
            PG8_LDB(B1, 1, 1); PG8_STAGE(PG8_SB(1, 0), b3, voffB);
            PG8_BAR; PG8_WAIT_L(0); PG8_MMA(0, 1, At, B1); PG8_BAR;
            PG8_LDA(At, 1, 1); PG8_STAGE(PG8_SA(1, 0), a3, voffA);
            PG8_BAR; PG8_WAIT_L(0); PG8_MMA(1, 0, At, B0); PG8_BAR; PG8_SCHED;
            PG8_STAGE(PG8_SB(1, 1), b3 + hstep, voffB);
            PG8_WAIT_V(6); PG8_BAR; PG8_MMA(1, 1, At, B1); PG8_BAR;
        }
        PG8_STAMP();
        if constexpr (!Epi::AFTER_DRAIN) { E(acc, cur, wr, wc, fr, fq); S.done(cur); }
        PG8_STAMP();
        if (!has_next) break;
#pragma unroll
        for (int a = 0; a < 2; ++a)
#pragma unroll
            for (int b = 0; b < 2; ++b)
#pragma unroll
                for (int m = 0; m < 4; ++m)
#pragma unroll
                    for (int n = 0; n < 2; ++n) acc[a][b][m][n] = (f32x4){0.f, 0.f, 0.f, 0.f};
        cur = nxt; cA = nA; cB = nB; ++ui;
    }
    PG8_WAIT_V(0);
    if (wr == 0) PG8_BAR;
    PG8_BAR;
    if constexpr (Epi::AFTER_DRAIN) { E.fused(acc, cur, wr, wc, fr, fq, lds, wid, lane); S.done(cur); }
    PG8_STAMP();
    if (STAMP && wid == 0) { stamps[lane] = lane < nts ? (((unsigned long long)(unsigned)ts_hi << 32) | (unsigned)ts_lo) : 0ull;
        if (lane == 62) stamps[62] = rt_entry; }
#undef PG8_STAMP
#undef PG8_SA
#undef PG8_SB
#undef PG8_STAGE
#undef PG8_LDA
#undef PG8_LDB
#undef PG8_MMA
#undef PG8_WAIT_V
#undef PG8_WAIT_L
#undef PG8_BAR
#undef PG8_SCHED
}
}

using pg8::f32x4; using pg8::bf16x8;
typedef unsigned short bf16;
typedef unsigned u32x4 __attribute__((ext_vector_type(4)));
typedef unsigned u32x2 __attribute__((ext_vector_type(2)));
typedef float f32x2 __attribute__((ext_vector_type(2)));

constexpr size_t MiB = 1ull << 20;
constexpr int NTOK = 8192, NCTX = 4096, DM = 1024, DFF = 2816;
constexpr size_t WS_MOD = 0, WS_LAM = 256 * 1024, WS_LB = 256 * 1024 + 256, WS_QCTR = 256 * 1024 + 8192;
constexpr size_t WS_ODIN = 1 * MiB, WS_ODOUT = 10 * MiB, WS_UP1 = 12 * MiB, WS_DOWN1 = 23 * MiB, WS_LORA = 28 * MiB + 512 * 1024;
constexpr size_t WS_EVIN = 30 * MiB, WS_EVOUT = 34 * MiB + 512 * 1024, WS_UP0 = 36 * MiB + 512 * 1024, WS_DOWN0 = 47 * MiB + 512 * 1024;
constexpr size_t WS_H = 53 * MiB;
constexpr size_t WS_PROJ = 69 * MiB, WS_QA = 141 * MiB, WS_QB = 149 * MiB, WS_KAC = 157 * MiB, WS_VATC = 161 * MiB, WS_KBC = 165 * MiB, WS_VBTC = 166 * MiB,
                 WS_KAS = 167 * MiB, WS_VATS = 173 * MiB, WS_KBS = 179 * MiB, WS_VBTS = 180 * MiB + 512 * 1024, WS_CAT = 182 * MiB;
constexpr size_t WS_U = 69 * MiB, WS_ACT = 157 * MiB, WS_TMP = 69 * MiB;
constexpr size_t WS_KK = 53 * MiB, WS_KKA = 61 * MiB, WS_HG = 69 * MiB, WS_PR = 149 * MiB, WS_K1 = 178 * MiB,
                 WS_OCF = 149 * MiB, WS_OCB = 157 * MiB, WS_ODF = 165 * MiB, WS_ODB = 173 * MiB,
                 WS_KT = 186 * MiB, WS_WF = 194 * MiB, WS_WB = 210 * MiB, WS_G = 226 * MiB, WS_CAT2 = 234 * MiB,
                 WS_R = 30 * MiB, WS_V1 = 38 * MiB, WS_AP = 46 * MiB;
constexpr size_t O_AK = 8388608, O_AV = 10485760, O_BK = 12582912, O_BV = 13107200, O_SH = 13631488, O_SR = 15728640;

struct Args { const float* in[40]; float* out; unsigned char* ws; int ph_lo, ph_hi; };

typedef __bf16 bf16x2_t __attribute__((ext_vector_type(2)));
__device__ __forceinline__ unsigned pk2(float lo, float hi) { f32x2 v = {lo, hi}; bf16x2_t r = __builtin_convertvector(v, bf16x2_t); return __builtin_bit_cast(unsigned, r); }
__device__ __forceinline__ float bflo(unsigned w) { return __uint_as_float(w << 16); }
__device__ __forceinline__ float bfhi(unsigned w) { return __uint_as_float(w & 0xffff0000u); }
__device__ __forceinline__ float bf2f(bf16 b) { return __uint_as_float(((unsigned)b) << 16); }
__device__ __forceinline__ bf16 f2bf(float f) { return (bf16)(pk2(f, 0.f) & 0xffffu); }
__device__ __forceinline__ float sigm(float x) { return __builtin_amdgcn_rcpf(1.f + __expf(-x)); }
__device__ __forceinline__ float silu(float x) { return x * __builtin_amdgcn_rcpf(1.f + __expf(-x)); }
__device__ __forceinline__ float wave_sum(float v) {
#pragma unroll
    for (int o = 1; o < 64; o <<= 1) v += __shfl_xor(v, o);
    return v;
}
__device__ __forceinline__ int cond_of(int t) { return t < NCTX ? 0 : 1 + ((t - NCTX) >> 10); }
__device__ __forceinline__ int opq(int x) { asm volatile("" : "+v"(x)); return x; }
#define LDSWAIT() asm volatile("s_waitcnt lgkmcnt(0)" ::: "memory")

__device__ __forceinline__ void tr_item(const float* W, int ldw, bf16* WT, int ldo, float* scr, int lane) {
#pragma unroll 8
    for (int i = 0; i < 32; ++i) { const int kk = 2 * i + (lane >> 5); scr[kk * 33 + (lane & 31)] = W[(size_t)kk * ldw + (lane & 31)]; }
    LDSWAIT();
    const int c = lane & 7;
#pragma unroll
    for (int j = 0; j < 4; ++j) { const int n = (lane >> 3) + 8 * j; const float* s = scr + (8 * c) * 33 + n;
        u32x4 o; o.x = pk2(s[0 * 33], s[1 * 33]); o.y = pk2(s[2 * 33], s[3 * 33]); o.z = pk2(s[4 * 33], s[5 * 33]); o.w = pk2(s[6 * 33], s[7 * 33]);
        *(u32x4*)(WT + (size_t)n * ldo + 8 * c) = o; }
    LDSWAIT();
}
__device__ __forceinline__ void tr_mat(const float* W, int N, bf16* WT, int ldo, int r, float* scr, int lane) {
    const int nblk = N / 32, kb = r / nblk, nb = r % nblk;
    tr_item(W + (size_t)kb * 64 * N + nb * 32, N, WT + (size_t)nb * 32 * ldo + kb * 64, ldo, scr, lane);
}

__device__ __forceinline__ void tr_range(const Args& a, unsigned char* ldsbase, int lo, int hi, int w, int nw) {
    unsigned char* ws = a.ws; const int lane = opq((int)threadIdx.x) & 63, wave = opq((int)threadIdx.x) >> 6;
    float* scr = (float*)(ldsbase + wave * 8448);
    constexpr int I_EVIN = 16 * 72, I_EVOUT = 16 * 32, I_UP = 16 * 176, I_DOWN = 44 * 32, I_ODIN = 16 * 138, I_ODOUT = 16 * 32, I_CAV = 16 * 32;
    for (int it = lo + w; it < hi; it += nw) {
        int r = it;
        if (r < I_EVIN) { tr_mat(a.in[15], 2304, (bf16*)(ws + WS_EVIN), 1024, r, scr, lane); continue; } r -= I_EVIN;
        if (r < I_EVOUT) { tr_mat(a.in[16], 1024, (bf16*)(ws + WS_EVOUT), 1024, r, scr, lane); continue; } r -= I_EVOUT;
        if (r < I_UP) { tr_mat(a.in[36], 5632, (bf16*)(ws + WS_UP0), 1024, r, scr, lane); continue; } r -= I_UP;
        if (r < I_UP) { tr_mat(a.in[36] + (size_t)1024 * 5632, 5632, (bf16*)(ws + WS_UP1), 1024, r, scr, lane); continue; } r -= I_UP;
        if (r < I_DOWN) { tr_mat(a.in[39], 1024, (bf16*)(ws + WS_DOWN0), 2816, r, scr, lane); continue; } r -= I_DOWN;
        if (r < I_DOWN) { tr_mat(a.in[39] + (size_t)2816 * 1024, 1024, (bf16*)(ws + WS_DOWN1), 2816, r, scr, lane); continue; } r -= I_DOWN;
        if (r < I_ODIN) { tr_mat(a.in[21], 4416, (bf16*)(ws + WS_ODIN), 1024, r, scr, lane); continue; } r -= I_ODIN;
        if (r < I_ODOUT) { tr_mat(a.in[22], 1024, (bf16*)(ws + WS_ODOUT), 1024, r, scr, lane); continue; } r -= I_ODOUT;
        if (r < I_CAV) { const int bh = r / 32, rr = r % 32; tr_mat(a.in[3] + (size_t)bh * 512 * 128, 128, (bf16*)(ws + WS_VATS) + (size_t)bh * 128 * 1536, 1536, rr, scr, lane); continue; } r -= I_CAV;
        { const int bg = r / 16, rr = r % 16; tr_mat(a.in[5] + (size_t)bg * 512 * 64, 64, (bf16*)(ws + WS_VBTS) + (size_t)bg * 64 * 1536, 1536, rr, scr, lane); }
    }
}
__device__ __forceinline__ void fill_l1_small(const Args& a, int t, int nt) {
    unsigned char* ws = a.ws;
    u32x4* z = (u32x4*)((bf16*)(ws + WS_ODIN) + (size_t)4416 * 1024);
    for (int i = t; i < 192 * 1024 / 8; i += nt) z[i] = (u32x4){0u, 0u, 0u, 0u};
    bf16* L = (bf16*)(ws + WS_LORA);
    for (int i = t; i < 2048 * 384; i += nt) { const int n = i / 384, k = i % 384; float v = 0.f;
        if (n < 512) { if (k < 64) v = a.in[27][(size_t)k * 512 + n]; }
        else if (n < 1024) { if (k >= 64 && k < 128) v = a.in[27][(size_t)(64 + (k - 64)) * 512 + (n - 512)]; }
        else if (n < 1536) { if (k >= 128 && k < 192) v = a.in[29][(size_t)(k - 128) * 512 + (n - 1024)]; }
        else { if (k >= 192 && k < 320) v = a.in[30][(size_t)(k - 192) * 512 + (n - 1536)]; }
        L[i] = f2bf(v); }
}

__device__ __forceinline__ void phase0(const Args& a, unsigned char* lds) {
    const int tid = opq((int)threadIdx.x), lane = tid & 63, wave = tid >> 6;
    const int gw = blockIdx.x * 8 + wave, NGW = gridDim.x * 8, gt = blockIdx.x * 512 + tid, NGT = gridDim.x * 512;
    unsigned char* ws = a.ws;
    {
        float* cs = (float*)lds;
        float* red = cs + 5120;
        float* MOD = (float*)(ws + WS_MOD);
        if (blockIdx.x < 384) {
            for (int i = tid; i < 5120; i += 512) { const int cb = i >> 10, k = i & 1023; const float x = cb == 0 ? a.in[9][k] : a.in[8][(cb - 1) * 1024 + k]; cs[i] = silu(x); }
        }
        __syncthreads();
        for (int it = blockIdx.x; it < 768; it += gridDim.x) {
            const int l = it / 384, cgp = it % 384, col = cgp * 16 + (lane & 15), kp = wave * 4 + (lane >> 4);
            const float* W = a.in[10] + (size_t)l * 1024 * 6144 + col;
            float acc0 = 0.f, acc1 = 0.f, acc2 = 0.f, acc3 = 0.f, acc4 = 0.f;
#pragma unroll 8
            for (int kk = 0; kk < 32; ++kk) { const int k = kp * 32 + kk; const float w = W[(size_t)k * 6144];
                acc0 += cs[k] * w; acc1 += cs[1024 + k] * w; acc2 += cs[2048 + k] * w; acc3 += cs[3072 + k] * w; acc4 += cs[4096 + k] * w; }
            red[(kp * 5 + 0) * 16 + (lane & 15)] = acc0; red[(kp * 5 + 1) * 16 + (lane & 15)] = acc1; red[(kp * 5 + 2) * 16 + (lane & 15)] = acc2;
            red[(kp * 5 + 3) * 16 + (lane & 15)] = acc3; red[(kp * 5 + 4) * 16 + (lane & 15)] = acc4;
            __syncthreads();
            if (tid < 80) { const int cb = tid >> 4, c = tid & 15; float s = 0.f;
#pragma unroll
                for (int p = 0; p < 32; ++p) s += red[(p * 5 + cb) * 16 + c];
                MOD[(size_t)(l * 5 + cb) * 6144 + cgp * 16 + c] = s + a.in[11][l * 6144 + cgp * 16 + c]; }
            __syncthreads();
        }
    }
    tr_range(a, lds + 32768, 0, 1664, gw, NGW);
    tr_range(a, lds + 32768, 12832, 13472, gw, NGW);
    {
        const f32x4* s = (const f32x4*)a.in[2]; bf16* KA = (bf16*)(ws + WS_KAS);
        for (int i = gt; i < 4 * 4 * 512 * 128 / 4; i += NGT) { const int e0 = i * 4, bh = e0 >> 16, rem = e0 & 65535; const f32x4 v = s[i];
            u32x2 o; o.x = pk2(v.x, v.y); o.y = pk2(v.z, v.w); *(u32x2*)(KA + (size_t)bh * 1536 * 128 + rem) = o; }
        const f32x4* s2 = (const f32x4*)a.in[4]; bf16* KB = (bf16*)(ws + WS_KBS);
        for (int i = gt; i < 4 * 2 * 512 * 64 / 4; i += NGT) { const int e0 = i * 4, bg = e0 >> 15, rem = e0 & 32767; const f32x4 v = s2[i];
            u32x2 o; o.x = pk2(v.x, v.y); o.y = pk2(v.z, v.w); *(u32x2*)(KB + (size_t)bg * 1536 * 64 + rem) = o; }
    }
#if defined(RUN_UPTO) && RUN_UPTO < 14
    for (int i = gt; i < 3145728; i += NGT) a.out[O_SH + i] = 0.f;
#endif
    if (blockIdx.x == 0) {
        if (wave == 0) {
            const float* L = a.in[17];
            const float s1 = wave_sum(L[lane] * L[64 + lane]), s2 = wave_sum(L[128 + lane] * L[192 + lane]);
            if (lane == 0) { *(float*)(ws + WS_LAM) = __expf(s1) - __expf(s2) + 0.2f; ((unsigned*)(ws + WS_QCTR))[0] = 0u; ((unsigned*)(ws + WS_QCTR))[1] = 0u; }
        }
        float* LB = (float*)(ws + WS_LB);
        for (int i = tid; i < 1024; i += 512) { const int dr = i >> 9, c = i & 511; const float l0 = a.in[23][(dr * 2 + 0) * 512 + c], l1 = a.in[23][(dr * 2 + 1) * 512 + c];
            const float m = fmaxf(l0, l1), e0 = __expf(l0 - m), e1 = __expf(l1 - m), s0 = e0 / (e0 + e1), s1 = e1 / (e0 + e1); LB[i] = (s0 + s1) - s0; }
    }
}

template <int MODE, bool TMPF>
__device__ __forceinline__ void norm_phase(const Args& a, const float* g, int l, int shoff, int scoff) {
    const int lane = opq((int)threadIdx.x) & 63, wave = opq((int)threadIdx.x) >> 6, gw = blockIdx.x * 8 + wave, NGW = gridDim.x * 8;
    float* X = a.out; bf16* H = (bf16*)(a.ws + WS_H); const float* MOD = (const float*)(a.ws + WS_MOD) + (size_t)l * 5 * 6144;
    f32x4 gg[4];
#pragma unroll
    for (int j = 0; j < 4; ++j) gg[j] = *(const f32x4*)(g + 256 * j + lane * 4);
    for (int tb = gw; tb < NTOK / 4; tb += NGW) {
        f32x4 v[4][4]; float ss[4];
#pragma unroll
        for (int r = 0; r < 4; ++r) { const int t = tb * 4 + r;
            const float* src = MODE == 0 ? (t < NCTX ? a.in[0] + (size_t)t * DM : a.in[1] + (size_t)(t - NCTX) * DM) : X + (size_t)t * DM;
#pragma unroll
            for (int j = 0; j < 4; ++j) { v[r][j] = *(const f32x4*)(src + 256 * j + lane * 4);
                if (TMPF) v[r][j] += *(const f32x4*)((const float*)(a.ws + WS_TMP) + (size_t)t * DM + 256 * j + lane * 4); } }
#pragma unroll
        for (int r = 0; r < 4; ++r) { float q = 0.f;
#pragma unroll
            for (int j = 0; j < 4; ++j) q += (v[r][j].x * v[r][j].x + v[r][j].y * v[r][j].y) + (v[r][j].z * v[r][j].z + v[r][j].w * v[r][j].w);
            ss[r] = q; }
#pragma unroll
        for (int o = 1; o < 64; o <<= 1) {
#pragma unroll
            for (int r = 0; r < 4; ++r) ss[r] += __shfl_xor(ss[r], o); }
        const float* md = MOD + (size_t)cond_of(tb * 4) * 6144;
#pragma unroll
        for (int r = 0; r < 4; ++r) { const int t = tb * 4 + r; const float rstd = rsqrtf(ss[r] * (1.f / DM) + 1e-6f);
#pragma unroll
            for (int j = 0; j < 4; ++j) { const int col = 256 * j + lane * 4;
                if (MODE == 2) { *(f32x4*)(X + (size_t)t * DM + col) = v[r][j] * rstd * gg[j]; }
                else { const f32x4 sc = *(const f32x4*)(md + scoff + col), sh = *(const f32x4*)(md + shoff + col);
                    const f32x4 h = (v[r][j] * rstd * gg[j]) * (sc + 1.f) + sh;
                    u32x2 o; o.x = pk2(h.x, h.y); o.y = pk2(h.z, h.w); *(u32x2*)(H + (size_t)t * DM + col) = o;
                    if (TMPF) *(f32x4*)(X + (size_t)t * DM + col) = v[r][j]; } } }
    }
}

#define EPI_LOOP(...) \
    _Pragma("unroll") for (int ai = 0; ai < 2; ++ai) _Pragma("unroll") for (int m = 0; m < 4; ++m) { const int row = u.pm * 256 + ai * 128 + wr * 64 + m * 16 + fr; \
    _Pragma("unroll") for (int bj = 0; bj < 2; ++bj) _Pragma("unroll") for (int n = 0; n < 2; ++n) { const int cl = bj * 128 + wc * 32 + n * 16 + 4 * fq; const f32x4 v = acc[ai][bj][m][n]; __VA_ARGS__ } asm volatile("" ::: "memory"); }

struct EpiF32 {
    static constexpr bool PERM = false, AFTER_DRAIN = false;
    float* C; int ldc;
    __device__ __forceinline__ void operator()(const f32x4 (&acc)[2][2][4][2], const pg8::Unit& u, int wr, int wc, int fr, int fq) const {
        EPI_LOOP({ *(f32x4*)(C + (size_t)row * ldc + u.pn * 256 + cl) = v; })
    }
};
struct EpiBf16 {
    static constexpr bool PERM = false, AFTER_DRAIN = false;
    bf16* O; int ldc;
    __device__ __forceinline__ void operator()(const f32x4 (&acc)[2][2][4][2], const pg8::Unit& u, int wr, int wc, int fr, int fq) const {
        EPI_LOOP({ u32x2 o; o.x = pk2(v.x, v.y); o.y = pk2(v.z, v.w); *(u32x2*)(O + (size_t)row * ldc + u.pn * 256 + cl) = o; })
    }
};
struct EpiResid {
    static constexpr bool PERM = false, AFTER_DRAIN = false;
    float* X; const float* gate; float* TMP; const float* B0; const float* B1;
    __device__ __forceinline__ void operator()(const f32x4 (&acc)[2][2][4][2], const pg8::Unit& u, int wr, int wc, int fr, int fq) const {
        const float* gt_ = gate + (size_t)cond_of(u.pm * 256) * 6144; const int pn = u.pn & 3;
        const float* rb_ = u.pm < 16 ? B0 : B1 - (size_t)NCTX * DM;
        EPI_LOOP({ const int col = pn * 256 + cl; const f32x4 gg = *(const f32x4*)(gt_ + col); float* p = X + (size_t)row * DM + col;
            if (u.pn < 4) { const f32x4 x = *(const f32x4*)(rb_ + (size_t)row * DM + col); *(f32x4*)p = x + gg * v; }
            else { *(f32x4*)(TMP + (size_t)row * DM + col) = gg * v; } })
    }
};
struct EpiOdIn {
    static constexpr bool PERM = false, AFTER_DRAIN = false;
    float* HG; bf16* PR; const float* LB;
    __device__ __forceinline__ void operator()(const f32x4 (&acc)[2][2][4][2], const pg8::Unit& u, int wr, int wc, int fr, int fq) const {
        const int pn = u.pn;
        if (pn < 10) { const int kind = pn >> 1;
            EPI_LOOP({ const int col = pn * 256 + cl; f32x4 o = v;
                if (kind == 0) { o.x = silu(v.x); o.y = silu(v.y); o.z = silu(v.z); o.w = silu(v.w); }
                else if (kind <= 2) { const f32x4 lb = *(const f32x4*)(LB + (col - 512));
                    o.x = lb.x + (1.f - lb.x) * sigm(v.x); o.y = lb.y + (1.f - lb.y) * sigm(v.y); o.z = lb.z + (1.f - lb.z) * sigm(v.z); o.w = lb.w + (1.f - lb.w) * sigm(v.w); }
                *(f32x4*)(HG + (size_t)row * 2560 + col) = o; })
        } else {
            EPI_LOOP({ const int col = (pn - 10) * 256 + cl; if (col < 1856) { u32x2 o; o.x = pk2(v.x, v.y); o.y = pk2(v.z, v.w); *(u32x2*)(PR + (size_t)row * 1856 + col) = o; } })
        }
    }
};
struct EpiLora {
    static constexpr bool PERM = false, AFTER_DRAIN = false;
    float* WF; float* WB; const bf16* KK; const bf16* K1; bf16* KKA; bf16* KT; bf16* G; const float* w0; const float* a0; const float* k_a;
    __device__ __forceinline__ void operator()(const f32x4 (&acc)[2][2][4][2], const pg8::Unit& u, int wr, int wc, int fr, int fq) const {
        const int pn = u.pn, kind = pn >> 1;
        if (kind <= 1) { float* W = kind == 0 ? WF : WB;
            EPI_LOOP({ const int c = (pn & 1) * 256 + cl; const f32x4 z0 = *(const f32x4*)(w0 + kind * 512 + c); f32x4 o;
                o.x = __expf(-0.60653066f * sigm(v.x + z0.x)); o.y = __expf(-0.60653066f * sigm(v.y + z0.y)); o.z = __expf(-0.60653066f * sigm(v.z + z0.z)); o.w = __expf(-0.60653066f * sigm(v.w + z0.w));
                *(f32x4*)(W + (size_t)row * 512 + c) = o; })
        } else if (kind == 2) {
            EPI_LOOP({ const int c = (pn & 1) * 256 + cl; const f32x4 z0 = *(const f32x4*)(a0 + c), ka = *(const f32x4*)(k_a + c);
                const u32x2 kkw = *(const u32x2*)(KK + (size_t)row * 512 + c), k1w = *(const u32x2*)(K1 + (size_t)row * 512 + c);
                const float a0_ = sigm(v.x + z0.x), a1_ = sigm(v.y + z0.y), a2_ = sigm(v.z + z0.z), a3_ = sigm(v.w + z0.w);
                u32x2 o1; o1.x = pk2(bflo(kkw.x) * a0_, bfhi(kkw.x) * a1_); o1.y = pk2(bflo(kkw.y) * a2_, bfhi(kkw.y) * a3_);
                u32x2 o2; o2.x = pk2(bflo(k1w.x) * (1.f + (a0_ - 1.f) * ka.x), bfhi(k1w.x) * (1.f + (a1_ - 1.f) * ka.y)); o2.y = pk2(bflo(k1w.y) * (1.f + (a2_ - 1.f) * ka.z), bfhi(k1w.y) * (1.f + (a3_ - 1.f) * ka.w));
                *(u32x2*)(KKA + (size_t)row * 512 + c) = o1; *(u32x2*)(KT + (size_t)row * 512 + c) = o2; })
        } else {
            EPI_LOOP({ const int c = (pn & 1) * 256 + cl; u32x2 o; o.x = pk2(v.x, v.y); o.y = pk2(v.z, v.w); *(u32x2*)(G + (size_t)row * 512 + c) = o; })
        }
    }
};
template <class Epi>
__device__ __forceinline__ void run_gemm(unsigned char* lds, const bf16* A, const bf16* Bt, int Nunits256, int K, int ld, int nNr, const Epi& E) {
    pg8::Gemm g{A, Bt, NTOK, Nunits256 * 256, K, ld, nNr};
    pg8::StaticOrder S; S.init(NTOK, Nunits256 * 256, (int)gridDim.x, (int)blockIdx.x);
    pg8::gemm_phase<Epi, pg8::StaticOrder, false>((PG8_LAS unsigned char*)lds, g, S, E, nullptr);
}

__device__ __forceinline__ void rope4(f32x4& v, const float (&cs)[4], const float (&sn)[4], int lane) {
    float p[4], o[4]; const float x[4] = {v.x, v.y, v.z, v.w};
#pragma unroll
    for (int j = 0; j < 4; ++j) p[j] = __shfl_xor(x[j], 4);
#pragma unroll
    for (int j = 0; j < 4; ++j) o[j] = (lane & 4) ? (p[j] * sn[j] + x[j] * cs[j]) : (x[j] * cs[j] - p[j] * sn[j]);
    v = (f32x4){o[0], o[1], o[2], o[3]};
}
__device__ __forceinline__ void qkv_post(const Args& a, unsigned char* lds) {
    const int tid = opq((int)threadIdx.x), lane = tid & 63, wave = tid >> 6, gw = blockIdx.x * 8 + wave, NGW = gridDim.x * 8;
    unsigned char* ws = a.ws; const float* PROJ = (const float*)(ws + WS_PROJ);
    bf16* QA = (bf16*)(ws + WS_QA); bf16* QB = (bf16*)(ws + WS_QB);
    for (int t = gw; t < NTOK; t += NGW) {
        const float* row = PROJ + (size_t)t * 2304;
        const bool smp = t >= NCTX; const int b = smp ? ((t - NCTX) >> 10) : (t >> 8), s = smp ? ((t - NCTX) & 1023) : (t & 255);
        const int T = smp ? 1536 : 256, tpos = smp ? 512 + s : s;
        float cs[4], sn[4];
        { const float pos = (float)((lane & 8) ? (s & 63) : (s >> 6));
#pragma unroll
          for (int j = 0; j < 4; ++j) { const float fr_ = __expf(-(float)(4 * (lane & 3) + j) * (9.210340372f / 16.f)); const float ang = pos * fr_; cs[j] = __cosf(ang); sn[j] = __sinf(ang); } }
        const int hh = lane >> 4, cc4 = (lane & 15) * 4;
        f32x4 vin[9];
#pragma unroll
        for (int c = 0; c < 9; ++c) vin[c] = *(const f32x4*)(row + c * 256 + lane * 4);
#pragma unroll
        for (int c = 0; c < 9; ++c) {
            f32x4 v = vin[c];
            if (c < 2) {
                if (smp) rope4(v, cs, sn, lane);
                v = v * 0.18033688f; u32x2 o; o.x = pk2(v.x, v.y); o.y = pk2(v.z, v.w); *(u32x2*)(QA + (size_t)t * 512 + c * 256 + lane * 4) = o;
            } else if (c < 4) {
                if (smp) rope4(v, cs, sn, lane);
                const int col = (c - 2) * 256 + lane * 4, h = col >> 7, cc = col & 127;
                bf16* KA = (bf16*)(ws + (smp ? WS_KAS : WS_KAC));
                u32x2 o; o.x = pk2(v.x, v.y); o.y = pk2(v.z, v.w); *(u32x2*)(KA + ((size_t)(b * 4 + h) * T + tpos) * 128 + cc) = o;
                if (!smp) *(f32x4*)(a.out + O_AK + ((size_t)(b * 4 + h) * 256 + s) * 128 + cc) = v;
            } else if (c < 6) {
                const int col = (c - 4) * 256 + lane * 4, h = col >> 7, cc = col & 127;
                if (!smp) *(f32x4*)(a.out + O_AV + ((size_t)(b * 4 + h) * 256 + s) * 128 + cc) = v;
            } else {
                float ss = (v.x * v.x + v.y * v.y) + (v.z * v.z + v.w * v.w);
                ss += __shfl_xor(ss, 1); ss += __shfl_xor(ss, 2); ss += __shfl_xor(ss, 4); ss += __shfl_xor(ss, 8);
                const float rs = rsqrtf(ss * (1.f / 64.f) + 1e-6f);
                const f32x4 gg = *(const f32x4*)((c < 8 ? a.in[19] : a.in[20]) + cc4);
                f32x4 nv = v * rs * gg;
                if (smp) rope4(nv, cs, sn, lane);
                if (c < 8) { nv = nv * 0.18033688f; u32x2 o; o.x = pk2(nv.x, nv.y); o.y = pk2(nv.z, nv.w); *(u32x2*)(QB + (size_t)t * 512 + (c - 6) * 256 + lane * 4) = o; }
                else if (hh < 2) {
                    bf16* KB = (bf16*)(ws + (smp ? WS_KBS : WS_KBC));
                    u32x2 o; o.x = pk2(nv.x, nv.y); o.y = pk2(nv.z, nv.w); *(u32x2*)(KB + ((size_t)(b * 2 + hh) * T + tpos) * 64 + cc4) = o;
                    if (!smp) *(f32x4*)(a.out + O_BK + ((size_t)(b * 2 + hh) * 256 + s) * 64 + cc4) = nv;
                } else {
                    if (!smp) *(f32x4*)(a.out + O_BV + ((size_t)(b * 2 + (hh - 2)) * 256 + s) * 64 + cc4) = v;
                }
            }
        }
    }
    float* scr = (float*)(lds + wave * 8448);
    for (int it = gw; it < 128 * 20; it += NGW) {
        const int tb = it / 20, nb = it % 20; const bool smp = tb >= 64;
        const int b = smp ? ((tb - 64) >> 4) : (tb >> 2), s0 = smp ? ((tb - 64) & 15) * 64 : (tb & 3) * 64, T = smp ? 1536 : 256, tpos = smp ? 512 + s0 : s0;
        if (nb < 16) { const int h = nb >> 2, e0 = (nb & 3) * 32;
            bf16* dst = (bf16*)(ws + (smp ? WS_VATS : WS_VATC)) + ((size_t)(b * 4 + h) * 128 + e0) * T + tpos;
            tr_item(PROJ + (size_t)tb * 64 * 2304 + 1024 + nb * 32, 2304, dst, T, scr, lane);
        } else { const int n2 = nb - 16, g = n2 >> 1, e0 = (n2 & 1) * 32;
            bf16* dst = (bf16*)(ws + (smp ? WS_VBTS : WS_VBTC)) + ((size_t)(b * 2 + g) * 64 + e0) * T + tpos;
            tr_item(PROJ + (size_t)tb * 64 * 2304 + 2176 + n2 * 32, 2304, dst, T, scr, lane);
        }
    }
}

template <int DV, int LDK, bool SHK>
__device__ __forceinline__ void attn_core(unsigned char* ldsb, const bf16* Qw, int qc0, int qc1, const bf16* Kg, const bf16* VTg, int T, f32x4 (&O)[2][DV / 16], float (&linv)[2]) {
    constexpr int KSTR = LDK * 2 + 16, VSTR = 144, VOFF = 64 * KSTR, BUFB = VOFF + DV * VSTR, NKC = 64 * LDK / 8 / 512, NVC = DV * 8 / 512, KCPR = LDK / 8;
    const int tid = opq((int)threadIdx.x), lane = tid & 63, fr = lane & 15, fq = lane >> 4;
    bf16x8 qf[2][2];
#pragma unroll
    for (int ks = 0; ks < 2; ++ks) { qf[0][ks] = *(const bf16x8*)(Qw + (size_t)fr * 512 + qc0 + ks * 32 + fq * 8); qf[1][ks] = *(const bf16x8*)(Qw + (size_t)fr * 512 + qc1 + ks * 32 + fq * 8); }
#pragma unroll
    for (int s = 0; s < 2; ++s)
#pragma unroll
        for (int e = 0; e < DV / 16; ++e) O[s][e] = (f32x4){0.f, 0.f, 0.f, 0.f};
    float mrun[2] = {-1e30f, -1e30f}, lsum[2] = {0.f, 0.f};
    u32x4 kreg[NKC], vreg[NVC];
    const int ntile = T / 64;
#define ATT_LOAD(t0) do { _Pragma("unroll") for (int i = 0; i < NKC; ++i) { const int c = tid + i * 512, r = c / KCPR, cc = c % KCPR; kreg[i] = *(const u32x4*)(Kg + (size_t)((t0) + r) * LDK + cc * 8); } \
        _Pragma("unroll") for (int i = 0; i < NVC; ++i) { const int c = tid + i * 512, e = c >> 3, cc = c & 7; vreg[i] = *(const u32x4*)(VTg + (size_t)e * T + (t0) + cc * 8); } } while (0)
#define ATT_PUT(base) do { _Pragma("unroll") for (int i = 0; i < NKC; ++i) { const int c = tid + i * 512, r = c / KCPR, cc = c % KCPR; *(u32x4*)((base) + r * KSTR + cc * 16) = kreg[i]; } \
        _Pragma("unroll") for (int i = 0; i < NVC; ++i) { const int c = tid + i * 512, e = c >> 3, cc = c & 7; *(u32x4*)((base) + VOFF + e * VSTR + cc * 16) = vreg[i]; } } while (0)
    ATT_LOAD(0);
    __syncthreads();
    ATT_PUT(ldsb);
    if (ntile > 1) ATT_LOAD(64);
    __syncthreads();
    for (int it = 0; it < ntile; ++it) {
        unsigned char* lds = ldsb + (it & 1) * BUFB;
        if (it + 1 < ntile) { ATT_PUT(ldsb + ((it + 1) & 1) * BUFB); if (it + 2 < ntile) ATT_LOAD((it + 2) * 64); }
        f32x4 sc[2][4];
#pragma unroll
        for (int kt = 0; kt < 4; ++kt) {
            sc[0][kt] = (f32x4){0.f, 0.f, 0.f, 0.f}; sc[1][kt] = (f32x4){0.f, 0.f, 0.f, 0.f};
#pragma unroll
            for (int ks = 0; ks < 2; ++ks) {
                const bf16x8 a0 = *(const bf16x8*)(lds + (kt * 16 + fr) * KSTR + (ks * 32 + fq * 8) * 2);
                sc[0][kt] = __builtin_amdgcn_mfma_f32_16x16x32_bf16(a0, qf[0][ks], sc[0][kt], 0, 0, 0);
                if (SHK) sc[1][kt] = __builtin_amdgcn_mfma_f32_16x16x32_bf16(a0, qf[1][ks], sc[1][kt], 0, 0, 0);
                else { const bf16x8 a1 = *(const bf16x8*)(lds + (kt * 16 + fr) * KSTR + (64 + ks * 32 + fq * 8) * 2);
                    sc[1][kt] = __builtin_amdgcn_mfma_f32_16x16x32_bf16(a1, qf[1][ks], sc[1][kt], 0, 0, 0); }
            }
        }
        bf16x8 pb[2][2];
#pragma unroll
        for (int s = 0; s < 2; ++s) {
            float mt = -1e30f;
#pragma unroll
            for (int kt = 0; kt < 4; ++kt) mt = fmaxf(fmaxf(fmaxf(sc[s][kt].x, sc[s][kt].y), fmaxf(sc[s][kt].z, sc[s][kt].w)), mt);
            mt = fmaxf(mt, __shfl_xor(mt, 16)); mt = fmaxf(mt, __shfl_xor(mt, 32));
            const float mnew = fmaxf(mrun[s], mt), alpha = __builtin_amdgcn_exp2f(mrun[s] - mnew); mrun[s] = mnew;
            float ps = 0.f;
#pragma unroll
            for (int kt = 0; kt < 4; ++kt) { sc[s][kt].x = __builtin_amdgcn_exp2f(sc[s][kt].x - mnew); sc[s][kt].y = __builtin_amdgcn_exp2f(sc[s][kt].y - mnew); sc[s][kt].z = __builtin_amdgcn_exp2f(sc[s][kt].z - mnew); sc[s][kt].w = __builtin_amdgcn_exp2f(sc[s][kt].w - mnew);
                ps += (sc[s][kt].x + sc[s][kt].y) + (sc[s][kt].z + sc[s][kt].w); }
            lsum[s] = lsum[s] * alpha + ps;
            if (__builtin_amdgcn_ballot_w64(alpha != 1.f) != 0ull) {
#pragma unroll
                for (int e = 0; e < DV / 16; ++e) O[s][e] = O[s][e] * alpha; }
#pragma unroll
            for (int k2 = 0; k2 < 2; ++k2) { u32x4 w; w.x = pk2(sc[s][2 * k2].x, sc[s][2 * k2].y); w.y = pk2(sc[s][2 * k2].z, sc[s][2 * k2].w); w.z = pk2(sc[s][2 * k2 + 1].x, sc[s][2 * k2 + 1].y); w.w = pk2(sc[s][2 * k2 + 1].z, sc[s][2 * k2 + 1].w);
                pb[s][k2] = __builtin_bit_cast(bf16x8, w); }
        }
#pragma unroll
        for (int e = 0; e < DV / 16; ++e)
#pragma unroll
            for (int k2 = 0; k2 < 2; ++k2) {
                const unsigned char* vp = lds + VOFF + (e * 16 + fr) * VSTR + (k2 * 32 + fq * 4) * 2;
                const u32x2 lo = *(const u32x2*)vp, hi = *(const u32x2*)(vp + 32);
                const u32x4 w = {lo.x, lo.y, hi.x, hi.y}; const bf16x8 av = __builtin_bit_cast(bf16x8, w);
                O[0][e] = __builtin_amdgcn_mfma_f32_16x16x32_bf16(av, pb[0][k2], O[0][e], 0, 0, 0);
                O[1][e] = __builtin_amdgcn_mfma_f32_16x16x32_bf16(av, pb[1][k2], O[1][e], 0, 0, 0);
            }
        __syncthreads();
    }
#undef ATT_PUT
#undef ATT_LOAD
#pragma unroll
    for (int s = 0; s < 2; ++s) { float l = lsum[s]; l += __shfl_xor(l, 16); l += __shfl_xor(l, 32); linv[s] = __builtin_amdgcn_rcpf(l); }
}
__device__ __forceinline__ void attn_phase(const Args& a, unsigned char* lds) {
    unsigned char* ws = a.ws; const int tid = opq((int)threadIdx.x), lane = tid & 63, wave = tid >> 6, fr = lane & 15, fq = lane >> 4;
    const bf16* QA = (const bf16*)(ws + WS_QA); const bf16* QB = (const bf16*)(ws + WS_QB); bf16* CAT = (bf16*)(ws + WS_CAT);
    const float lam = *(const float*)(ws + WS_LAM);
    const bool bal = gridDim.x == 256;
    for (int it = 0; ; ++it) {
        int u;
        if (bal) { if (it == 0) u = (int)blockIdx.x; else if (blockIdx.x >= 128 && it < 3) u = 128 + it * 128 + ((int)blockIdx.x - 128); else break; }
        else { u = (int)blockIdx.x + it * (int)gridDim.x; if (u >= 512) break; }
        const bool isA = (u < 128) || (u >= 384), smp = u < 256;
        int idx = u < 128 ? u : (u < 256 ? u - 128 : (u < 384 ? u - 256 : u - 384));
        const int T = smp ? 1536 : 256;
        int b, hx, pair = 0, qb;
        if (smp) { b = idx >> 5; qb = idx & 7; if (isA) hx = (idx >> 3) & 3; else { hx = (idx >> 4) & 1; pair = (idx >> 3) & 1; } }
        else { b = idx >> 3; if (isA) { hx = (idx >> 1) & 3; qb = idx & 1; } else { hx = (idx >> 2) & 1; pair = (idx >> 1) & 1; qb = idx & 1; } }
        const int tok0 = (smp ? NCTX + b * 1024 : b * 256) + qb * 128 + wave * 16;
        if (isA) {
            const bf16* Kg = (const bf16*)(ws + (smp ? WS_KAS : WS_KAC)) + (size_t)(b * 4 + hx) * T * 128;
            const bf16* Vg = (const bf16*)(ws + (smp ? WS_VATS : WS_VATC)) + (size_t)(b * 4 + hx) * 128 * T;
            f32x4 O[2][8]; float li[2];
            attn_core<128, 128, false>(lds, QA + (size_t)tok0 * 512, hx * 128, hx * 128 + 64, Kg, Vg, T, O, li);
            float ss = 0.f;
#pragma unroll
            for (int e = 0; e < 8; ++e) { O[0][e] = O[0][e] * li[0] - (O[1][e] * li[1]) * lam; ss += (O[0][e].x * O[0][e].x + O[0][e].y * O[0][e].y) + (O[0][e].z * O[0][e].z + O[0][e].w * O[0][e].w); }
            ss += __shfl_xor(ss, 16); ss += __shfl_xor(ss, 32);
            const float rs = rsqrtf(ss * (1.f / 128.f) + 1e-6f) * 0.8f;
#pragma unroll
            for (int e = 0; e < 8; ++e) { const int ec = e * 16 + fq * 4; const f32x4 gg = *(const f32x4*)(a.in[18] + ec); const f32x4 y = O[0][e] * rs * gg;
                u32x2 o; o.x = pk2(y.x, y.y); o.y = pk2(y.z, y.w); *(u32x2*)(CAT + (size_t)(tok0 + fr) * 1024 + hx * 128 + ec) = o; }
        } else {
            const bf16* Kg = (const bf16*)(ws + (smp ? WS_KBS : WS_KBC)) + (size_t)(b * 2 + hx) * T * 64;
            const bf16* Vg = (const bf16*)(ws + (smp ? WS_VBTS : WS_VBTC)) + (size_t)(b * 2 + hx) * 64 * T;
            const int hq0 = hx * 4 + pair * 2;
            f32x4 O[2][4]; float li[2];
#if defined(DBG_SKIP_B)
            if (DBG_SKIP_B == 1 ? smp : !smp) {
#pragma unroll
            for (int s = 0; s < 2; ++s) { li[s] = 0.f;
#pragma unroll
                for (int e = 0; e < 4; ++e) O[s][e] = (f32x4){0.f, 0.f, 0.f, 0.f}; }
            } else
#endif
            attn_core<64, 64, true>(lds, QB + (size_t)tok0 * 512, hq0 * 64, (hq0 + 1) * 64, Kg, Vg, T, O, li);
#pragma unroll
            for (int s = 0; s < 2; ++s)
#pragma unroll
                for (int e = 0; e < 4; ++e) { const f32x4 y = O[s][e] * li[s]; u32x2 o; o.x = pk2(y.x, y.y); o.y = pk2(y.z, y.w);
                    *(u32x2*)(CAT + (size_t)(tok0 + fr) * 1024 + 512 + (hq0 + s) * 64 + e * 16 + fq * 4) = o; }
        }
    }
}

__device__ __forceinline__ void conv_phase(const Args& a, int l) {
    const int gt = blockIdx.x * 512 + opq((int)threadIdx.x), NGT = gridDim.x * 512;
    const bf16* U = (const bf16*)(a.ws + WS_U); bf16* ACT = (bf16*)(a.ws + WS_ACT);
    const float* cw = a.in[37] + (size_t)l * 3 * 5632; const float* cb = a.in[38] + (size_t)l * 5632;
    const int nrw = NGT / 352;
    if (gt < nrw * 352) {
        const int ch = gt % 352, r0 = gt / 352, j0 = ch * 8;
        float w0v[8], w1v[8], w2v[8], bv[8], w0g[8], w1g[8], w2g[8], bg[8];
#pragma unroll
        for (int k = 0; k < 8; ++k) { w0v[k] = cw[j0 + k]; w1v[k] = cw[5632 + j0 + k]; w2v[k] = cw[2 * 5632 + j0 + k]; bv[k] = cb[j0 + k];
            w0g[k] = cw[DFF + j0 + k]; w1g[k] = cw[5632 + DFF + j0 + k]; w2g[k] = cw[2 * 5632 + DFF + j0 + k]; bg[k] = cb[DFF + j0 + k]; }
        for (int run = r0; run < 1024; run += nrw) {
            const int t0 = run * 8;
            const int S = t0 < NCTX ? 256 : 1024, s0 = t0 < NCTX ? (t0 & 255) : ((t0 - NCTX) & 1023);
            const u32x4 zero = {0u, 0u, 0u, 0u};
            u32x4 rv[10], rg[10];
#pragma unroll
            for (int i = 0; i < 10; ++i) { const int sp = s0 - 1 + i; const bool ok = sp >= 0 && sp < S; const size_t off = (size_t)(t0 - 1 + i) * 5632 + j0;
                rv[i] = ok ? *(const u32x4*)(U + off) : zero; rg[i] = ok ? *(const u32x4*)(U + off + DFF) : zero; }
#pragma unroll
            for (int i = 0; i < 8; ++i) {
                float o[8];
#pragma unroll
                for (int k = 0; k < 4; ++k) {
                    const float vl = w0v[2 * k] * bflo(rv[i][k]) + w1v[2 * k] * bflo(rv[i + 1][k]) + w2v[2 * k] * bflo(rv[i + 2][k]) + bv[2 * k];
                    const float vh = w0v[2 * k + 1] * bfhi(rv[i][k]) + w1v[2 * k + 1] * bfhi(rv[i + 1][k]) + w2v[2 * k + 1] * bfhi(rv[i + 2][k]) + bv[2 * k + 1];
                    const float gl = w0g[2 * k] * bflo(rg[i][k]) + w1g[2 * k] * bflo(rg[i + 1][k]) + w2g[2 * k] * bflo(rg[i + 2][k]) + bg[2 * k];
                    const float gh = w0g[2 * k + 1] * bfhi(rg[i][k]) + w1g[2 * k + 1] * bfhi(rg[i + 1][k]) + w2g[2 * k + 1] * bfhi(rg[i + 2][k]) + bg[2 * k + 1];
                    o[2 * k] = silu(gl) * vl; o[2 * k + 1] = silu(gh) * vh; }
                u32x4 w; w.x = pk2(o[0], o[1]); w.y = pk2(o[2], o[3]); w.z = pk2(o[4], o[5]); w.w = pk2(o[6], o[7]);
                *(u32x4*)(ACT + (size_t)(t0 + i) * DFF + j0) = w;
            }
        }
    }
}

__device__ __forceinline__ void prep1_phase(const Args& a) {
    const int lane = opq((int)threadIdx.x) & 63, wave = opq((int)threadIdx.x) >> 6, gw = blockIdx.x * 8 + wave, NGW = gridDim.x * 8;
    unsigned char* ws = a.ws; const bf16* PR = (const bf16*)(ws + WS_PR);
    bf16* R = (bf16*)(ws + WS_R); bf16* K1 = (bf16*)(ws + WS_K1); bf16* V1 = (bf16*)(ws + WS_V1); bf16* KK = (bf16*)(ws + WS_KK); bf16* AP = (bf16*)(ws + WS_AP);
    const float* mu = a.in[25]; const float* k_k = a.in[31];
    for (int t = gw; t < NTOK; t += NGW) {
        const int S = t < NCTX ? 256 : 1024, s = t < NCTX ? (t & 255) : ((t - NCTX) & 1023);
        const bool hp = s > 0, hn = s + 1 < S;
        u32x4 xin[4], xpin[4], xnin[4];
#pragma unroll
        for (int it = 0; it < 4; ++it) { const int c = it * 64 + lane, col = (c < 232 ? c : 0) * 8; const u32x4 zero = {0u, 0u, 0u, 0u};
            xin[it] = *(const u32x4*)(PR + (size_t)t * 1856 + col);
            xpin[it] = hp ? *(const u32x4*)(PR + (size_t)(t - 1) * 1856 + col) : zero;
            xnin[it] = hn ? *(const u32x4*)(PR + (size_t)(t + 1) * 1856 + col) : zero; }
#pragma unroll
        for (int it = 0; it < 4; ++it) {
            const int c = it * 64 + lane; if (c >= 232) break;
            const int col = c * 8;
            const u32x4 x = xin[it], xp = xpin[it], xn = xnin[it];
            float pd[8];
#pragma unroll
            for (int k = 0; k < 4; ++k) { const float m0 = mu[col + 2 * k], m1 = mu[col + 2 * k + 1];
                const float c0 = bflo(x[k]), c1 = bfhi(x[k]);
                pd[2 * k] = c0 + m0 * (0.5f * (bflo(xp[k]) + bflo(xn[k])) - c0); pd[2 * k + 1] = c1 + m1 * (0.5f * (bfhi(xp[k]) + bfhi(xn[k])) - c1); }
            u32x4 w; w.x = pk2(pd[0], pd[1]); w.y = pk2(pd[2], pd[3]); w.z = pk2(pd[4], pd[5]); w.w = pk2(pd[6], pd[7]);
            if (it == 0) { *(u32x4*)(R + (size_t)t * 512 + col) = w; }
            else if (it == 1) { const int kc = col - 512; *(u32x4*)(K1 + (size_t)t * 512 + kc) = w;
                float q[8], ss = 0.f;
#pragma unroll
                for (int k = 0; k < 8; ++k) { q[k] = pd[k] * k_k[kc + k]; ss += q[k] * q[k]; }
                ss += __shfl_xor(ss, 1); ss += __shfl_xor(ss, 2); ss += __shfl_xor(ss, 4);
                const float inv = __builtin_amdgcn_rsqf(fmaxf(ss, 1e-24f));
                u32x4 o; o.x = pk2(q[0] * inv, q[1] * inv); o.y = pk2(q[2] * inv, q[3] * inv); o.z = pk2(q[4] * inv, q[5] * inv); o.w = pk2(q[6] * inv, q[7] * inv);
                *(u32x4*)(KK + (size_t)t * 512 + kc) = o; }
            else if (it == 2) { *(u32x4*)(V1 + (size_t)t * 512 + (col - 1024)) = w; }
            else { const int ac = col - 1536;
                float o[8];
#pragma unroll
                for (int k = 0; k < 8; ++k) { const float x_ = pd[k]; o[k] = ac < 128 ? (1.f - 2.f * __builtin_amdgcn_rcpf(1.f + __expf(2.f * x_))) : (ac < 192 ? x_ : sigm(x_)); }
                u32x4 ow; ow.x = pk2(o[0], o[1]); ow.y = pk2(o[2], o[3]); ow.z = pk2(o[4], o[5]); ow.w = pk2(o[6], o[7]);
                *(u32x4*)(AP + (size_t)t * 384 + ac) = ow; }
        }
        if (lane < 8) *(u32x4*)(AP + (size_t)t * 384 + 320 + lane * 8) = (u32x4){0u, 0u, 0u, 0u};
    }
}

template <int CTRL> __device__ __forceinline__ float dppf(float x) { return __builtin_bit_cast(float, __builtin_amdgcn_update_dpp(0, __builtin_bit_cast(int, x), CTRL, 0xF, 0xF, true)); }
__device__ __forceinline__ float red8(float x) { x += dppf<0xB1>(x); x += dppf<0x4E>(x); x += dppf<0x141>(x); return x; }
__device__ __forceinline__ float red16(float x) { x = red8(x); x += dppf<0x140>(x); return x; }

template <int R> __device__ __forceinline__ void hgrn_step(const f32x4 (&X)[4], const float (&vv)[R], f32x2 (&St)[R][4], float (&oo)[R]) {
    const f32x2 f2[4] = {{X[0].x, X[0].y}, {X[0].z, X[0].w}, {X[1].x, X[1].y}, {X[1].z, X[1].w}}, q2[4] = {{X[2].x, X[2].y}, {X[2].z, X[2].w}, {X[3].x, X[3].y}, {X[3].z, X[3].w}};
#pragma unroll
    for (int c = 0; c < R; ++c) { const f32x2 v2 = {vv[c], vv[c]}; f32x2 o2 = {0.f, 0.f};
#pragma unroll
        for (int i = 0; i < 4; ++i) { const f32x2 d = St[c][i] - v2; St[c][i] = f2[i] * d + v2; o2 = q2[i] * St[c][i] + o2; }
        oo[c] = o2.x + o2.y; }
#pragma unroll
    for (int c = 0; c < R; ++c) oo[c] = red16(oo[c]);
}
template <int R> __device__ __forceinline__ void rwkv_step(const f32x4 (&X)[10], const float (&vv)[R], f32x2 (&St)[R][4], float (&oo)[R]) {
    const f32x2 kk2[4] = {{X[0].x, X[0].y}, {X[0].z, X[0].w}, {X[1].x, X[1].y}, {X[1].z, X[1].w}}, w2[4] = {{X[2].x, X[2].y}, {X[2].z, X[2].w}, {X[3].x, X[3].y}, {X[3].z, X[3].w}};
    const f32x2 ka2[4] = {{X[4].x, X[4].y}, {X[4].z, X[4].w}, {X[5].x, X[5].y}, {X[5].z, X[5].w}}, kt2[4] = {{X[6].x, X[6].y}, {X[6].z, X[6].w}, {X[7].x, X[7].y}, {X[7].z, X[7].w}};
    const f32x2 r2[4] = {{X[8].x, X[8].y}, {X[8].z, X[8].w}, {X[9].x, X[9].y}, {X[9].z, X[9].w}};
    float sa[R];
#pragma unroll
    for (int c = 0; c < R; ++c) { f32x2 s2 = {0.f, 0.f};
#pragma unroll
        for (int i = 0; i < 4; ++i) s2 = St[c][i] * kk2[i] + s2;
        sa[c] = s2.x + s2.y; }
#pragma unroll
    for (int c = 0; c < R; ++c) sa[c] = -red8(sa[c]);
#pragma unroll
    for (int c = 0; c < R; ++c) { const f32x2 v2 = {vv[c], vv[c]}, sa2 = {sa[c], sa[c]}; f32x2 o2 = {0.f, 0.f};
#pragma unroll
        for (int i = 0; i < 4; ++i) { const f32x2 t2 = sa2 * ka2[i] + v2 * kt2[i]; St[c][i] = St[c][i] * w2[i] + t2; o2 = St[c][i] * r2[i] + o2; }
        oo[c] = o2.x + o2.y; }
}
template <int R>
__device__ __forceinline__ void hgrn_wjob(const Args& a, unsigned char* wl, bool smp, int j, int lane) {
    unsigned char* ws = a.ws;
    constexpr int NCG = 32 / R;
    const int chain = j / NCG, cg = j % NCG, b = chain >> 3, h = (chain >> 1) & 3, dir = chain & 1;
    const int tok0 = smp ? NCTX + b * 1024 : b * 256, S = smp ? 1024 : 256;
    const int eg = lane >> 4, ksl = lane & 15, cb = cg * 4 * R, c0 = cb + eg * R;
    const float* HG = (const float*)(ws + WS_HG); bf16* OC = (bf16*)(ws + (dir ? WS_OCB : WS_OCF));
    f32x2 St[R][4];
#pragma unroll
    for (int c = 0; c < R; ++c)
#pragma unroll
        for (int i = 0; i < 4; ++i) {
            if (smp) { const float* sp = a.in[6] + ((size_t)((b * 2 + dir) * 4 + h) * 128 + (i < 2 ? 4 * ksl + 2 * i : 64 + 4 * ksl + 2 * (i - 2))) * 128 + c0 + c; St[c][i] = (f32x2){sp[0], sp[128]}; }
            else St[c][i] = (f32x2){0.f, 0.f}; }
    float* sF = (float*)wl; float* sQ = sF + 1024; float* sV = sQ + 1024; float* sO = sV + 64;
    f32x4 rf[4], rq[4], rv;
#define HGW_TOK(ch, st) (tok0 + (dir ? S - 1 - ((ch) * 8 + (st)) : ((ch) * 8 + (st))))
#define HGW_LOAD(ch) do { _Pragma("unroll") for (int m = 0; m < 4; ++m) { const int i_ = lane + 64 * m, st_ = i_ >> 5, c_ = i_ & 31; const float* r_ = HG + (size_t)HGW_TOK(ch, st_) * 2560 + h * 128 + c_ * 4; \
        rf[m] = *(const f32x4*)(r_ + 512 + dir * 512); rq[m] = *(const f32x4*)r_; } \
        if (lane < 8 * R) rv = *(const f32x4*)(HG + (size_t)HGW_TOK(ch, lane / R) * 2560 + 1536 + h * 128 + cb + (lane % R) * 4); } while (0)
    HGW_LOAD(0);
    const int nch = S / 8;
    for (int ch = 0; ch < nch; ++ch) {
#pragma unroll
        for (int m = 0; m < 4; ++m) { const int i_ = lane + 64 * m; *(f32x4*)(sF + i_ * 4) = rf[m]; *(f32x4*)(sQ + i_ * 4) = rq[m]; }
        if (lane < 8 * R) *(f32x4*)(sV + lane * 4) = rv;
        if (ch + 1 < nch) HGW_LOAD(ch + 1);
        float ob[8][R];
#pragma unroll
        for (int st = 0; st < 8; ++st) {
            f32x4 X[4]; float V[R];
            X[0] = *(const f32x4*)(sF + st * 128 + 4 * ksl); X[1] = *(const f32x4*)(sF + st * 128 + 64 + 4 * ksl); X[2] = *(const f32x4*)(sQ + st * 128 + 4 * ksl); X[3] = *(const f32x4*)(sQ + st * 128 + 64 + 4 * ksl);
#pragma unroll
            for (int c = 0; c < R; ++c) V[c] = sV[st * 4 * R + eg * R + c];
            hgrn_step<R>(X, V, St, ob[st]);
        }
        if (ksl == 0) {
#pragma unroll
            for (int st = 0; st < 8; ++st)
#pragma unroll
                for (int c = 0; c < R; ++c) sO[st * 4 * R + eg * R + c] = ob[st][c]; }
        if (lane < 8) {
            if (R == 2) { const f32x4 o0 = *(const f32x4*)(sO + lane * 8), o1 = *(const f32x4*)(sO + lane * 8 + 4);
                u32x4 w; w.x = pk2(o0.x, o0.y); w.y = pk2(o0.z, o0.w); w.z = pk2(o1.x, o1.y); w.w = pk2(o1.z, o1.w);
                *(u32x4*)(OC + (size_t)HGW_TOK(ch, lane) * 512 + h * 128 + cb) = w; }
            else { const f32x4 o0 = *(const f32x4*)(sO + lane * 4); u32x2 w; w.x = pk2(o0.x, o0.y); w.y = pk2(o0.z, o0.w);
                *(u32x2*)(OC + (size_t)HGW_TOK(ch, lane) * 512 + h * 128 + cb) = w; }
        }
    }
#undef HGW_LOAD
#undef HGW_TOK
    if (!smp) {
#pragma unroll
        for (int c = 0; c < R; ++c)
#pragma unroll
            for (int i = 0; i < 4; ++i) { float* dp = a.out + O_SH + ((size_t)((b * 2 + dir) * 4 + h) * 128 + (i < 2 ? 4 * ksl + 2 * i : 64 + 4 * ksl + 2 * (i - 2))) * 128 + c0 + c; dp[0] = St[c][i].x; dp[128] = St[c][i].y; }
    }
}
template <int R>
__device__ __forceinline__ void rwkv_wjob(const Args& a, unsigned char* wl, bool smp, int j, int lane) {
    unsigned char* ws = a.ws;
    constexpr int NRG = 8 / R;
    const int chain = j / NRG, rg = j % NRG, b = chain >> 4, h = (chain >> 1) & 7, dir = chain & 1;
    const int tok0 = smp ? NCTX + b * 1024 : b * 256, S = smp ? 1024 : 256;
    const int rp = lane >> 3, ksl = lane & 7, k0 = ksl * 8, rb = rg * 8 * R, r0 = rb + rp * R;
    const bf16* KK = (const bf16*)(ws + WS_KK); const bf16* KKA = (const bf16*)(ws + WS_KKA); const bf16* KT = (const bf16*)(ws + WS_KT);
    const bf16* Rr = (const bf16*)(ws + WS_R); const bf16* V1 = (const bf16*)(ws + WS_V1); const float* W = (const float*)(ws + (dir ? WS_WB : WS_WF));
    bf16* OD = (bf16*)(ws + (dir ? WS_ODB : WS_ODF));
    f32x2 St[R][4];
#pragma unroll
    for (int c = 0; c < R; ++c)
#pragma unroll
        for (int i = 0; i < 4; ++i) {
            if (smp) St[c][i] = *(const f32x2*)(a.in[7] + ((size_t)((b * 2 + dir) * 8 + h) * 64 + r0 + c) * 64 + k0 + 2 * i);
            else St[c][i] = (f32x2){0.f, 0.f}; }
    float* sX = (float*)wl;
    float* sV = sX + 2560; float* sO = sV + 128; float* sP = sO + 128;
    u32x4 rkk0, rka0, rkt0, rr0, rv0, rkk1, rka1, rkt1, rr1, rv1; f32x4 rw0[2], rw1[2];
#define RWW_TOK(ch, st) (tok0 + (dir ? S - 1 - ((ch) * 8 + (st)) : ((ch) * 8 + (st))))
#define RWW_LOAD(ch, Z) do { const size_t o_ = (size_t)RWW_TOK(ch, lane >> 3) * 512 + h * 64 + (lane & 7) * 8; \
        rkk##Z = *(const u32x4*)(KK + o_); rka##Z = *(const u32x4*)(KKA + o_); rkt##Z = *(const u32x4*)(KT + o_); rr##Z = *(const u32x4*)(Rr + o_); \
        _Pragma("unroll") for (int m = 0; m < 2; ++m) { const int i_ = lane + 64 * m; rw##Z[m] = *(const f32x4*)(W + (size_t)RWW_TOK(ch, i_ >> 4) * 512 + h * 64 + (i_ & 15) * 4); } \
        if (lane < 8 * R) rv##Z = *(const u32x4*)(V1 + (size_t)RWW_TOK(ch, lane / R) * 512 + h * 64 + rb + (lane % R) * 8); } while (0)
#define RWW_PUT(slot, reg) do { float* d_ = sX + (lane >> 3) * 320 + (slot) * 64 + (lane & 7) * 8; \
        *(f32x4*)d_ = (f32x4){bflo(reg.x), bfhi(reg.x), bflo(reg.y), bfhi(reg.y)}; *(f32x4*)(d_ + 4) = (f32x4){bflo(reg.z), bfhi(reg.z), bflo(reg.w), bfhi(reg.w)}; } while (0)
#define RWW_CHUNK(ch, Z) do { \
        RWW_PUT(0, rkk##Z); RWW_PUT(2, rka##Z); RWW_PUT(3, rkt##Z); RWW_PUT(4, rr##Z); \
        _Pragma("unroll") for (int m = 0; m < 2; ++m) { const int i_ = lane + 64 * m; *(f32x4*)(sX + (i_ >> 4) * 320 + 64 + (i_ & 15) * 4) = rw##Z[m]; } \
        if (lane < 8 * R) { float* d_ = sV + lane * 8; *(f32x4*)d_ = (f32x4){bflo(rv##Z.x), bfhi(rv##Z.x), bflo(rv##Z.y), bfhi(rv##Z.y)}; *(f32x4*)(d_ + 4) = (f32x4){bflo(rv##Z.z), bfhi(rv##Z.z), bflo(rv##Z.w), bfhi(rv##Z.w)}; } \
        if ((ch) + 2 < nch) RWW_LOAD((ch) + 2, Z); \
        float ob[8][R]; \
        _Pragma("unroll") for (int st = 0; st < 8; ++st) { \
            f32x4 X[10]; float V[R]; \
            const float* x_ = sX + st * 320 + k0; \
            _Pragma("unroll") for (int q = 0; q < 5; ++q) { X[2 * q] = *(const f32x4*)(x_ + 64 * q); X[2 * q + 1] = *(const f32x4*)(x_ + 64 * q + 4); } \
            _Pragma("unroll") for (int c = 0; c < R; ++c) V[c] = sV[st * 8 * R + rp * R + c]; \
            rwkv_step<R>(X, V, St, ob[st]); } \
        _Pragma("unroll") for (int st = 0; st < 8; ++st) _Pragma("unroll") for (int c = 0; c < R; ++c) sP[((st * 8 + rp) * R + c) * 8 + ksl] = ob[st][c]; \
        _Pragma("unroll") for (int m = 0; m < R; ++m) { const int q_ = lane + 64 * m; const f32x4 p0_ = *(const f32x4*)(sP + q_ * 8), p1_ = *(const f32x4*)(sP + q_ * 8 + 4); \
            sO[q_] = ((p0_.x + p0_.y) + (p0_.z + p0_.w)) + ((p1_.x + p1_.y) + (p1_.z + p1_.w)); } \
        if (lane < 8 * R) { const float* o_ = sO + lane * 8; const f32x4 o0 = *(const f32x4*)o_, o1 = *(const f32x4*)(o_ + 4); \
            u32x4 w; w.x = pk2(o0.x, o0.y); w.y = pk2(o0.z, o0.w); w.z = pk2(o1.x, o1.y); w.w = pk2(o1.z, o1.w); \
            *(u32x4*)(OD + (size_t)RWW_TOK(ch, lane / R) * 512 + h * 64 + rb + (lane % R) * 8) = w; } } while (0)
    const int nch = S / 8;
    RWW_LOAD(0, 0); RWW_LOAD(1, 1);
    for (int ch = 0; ch < nch; ch += 2) { RWW_CHUNK(ch, 0); RWW_CHUNK(ch + 1, 1); }
#undef RWW_CHUNK
#undef RWW_LOAD
#undef RWW_PUT
#undef RWW_TOK
    if (!smp) {
#pragma unroll
        for (int c = 0; c < R; ++c)
#pragma unroll
            for (int i = 0; i < 4; ++i) *(f32x2*)(a.out + O_SR + ((size_t)((b * 2 + dir) * 8 + h) * 64 + r0 + c) * 64 + k0 + 2 * i) = St[c][i];
    }
}
__device__ __forceinline__ void hgrn_chain(const Args& a, unsigned char* lds, bool smp, int chain) {
    unsigned char* ws = a.ws;
    const int tid = opq((int)threadIdx.x), lane = tid & 63, wave = tid >> 6, fr = lane & 15, fq = lane >> 4;
    const int b = chain >> 3, h = (chain >> 1) & 3, dir = chain & 1;
    const int tok0 = smp ? NCTX + b * 1024 : b * 256, S = smp ? 1024 : 256;
    const float* HG = (const float*)(ws + WS_HG); bf16* OC = (bf16*)(ws + (dir ? WS_OCB : WS_OCF));
    float* sFr = (float*)lds; float* sQr = sFr + 2048;
    bf16* sVT = (bf16*)(lds + 16384);
    bf16* sQs = (bf16*)(lds + 22528);
    bf16* sKn = (bf16*)(lds + 26880);
    bf16* sKeT = (bf16*)(lds + 31232);
    float* sDec = (float*)(lds + 37376);
    bf16* sPm = (bf16*)(lds + 37888);
    float* sPart = (float*)(lds + 38912);
    const int e = wave * 16 + fr;
    f32x4 acc[8];
#pragma unroll
    for (int kt = 0; kt < 8; ++kt) {
        if (smp) { const float* sp = a.in[6] + ((size_t)((b * 2 + dir) * 4 + h) * 128 + kt * 16 + fq * 4) * 128 + e; acc[kt] = (f32x4){sp[0], sp[128], sp[256], sp[384]}; }
        else acc[kt] = (f32x4){0.f, 0.f, 0.f, 0.f}; }
    const int tl = tid >> 5, c4 = (tid & 31) * 4;
    f32x4 rf, rq, rv;
#define HC_TOK(ch, t) (tok0 + (dir ? S - 1 - ((ch) * 16 + (t)) : ((ch) * 16 + (t))))
#define HC_LOAD(ch) do { const float* r_ = HG + (size_t)HC_TOK(ch, tl) * 2560 + h * 128 + c4; rq = *(const f32x4*)r_; rf = *(const f32x4*)(r_ + 512 + dir * 512); rv = *(const f32x4*)(r_ + 1536); } while (0)
    HC_LOAD(0);
    const int nch = S / 16;
    for (int ch = 0; ch < nch; ++ch) {
        __syncthreads();
        *(f32x4*)(sFr + tl * 128 + c4) = rf; *(f32x4*)(sQr + tl * 128 + c4) = rq;
        sVT[(c4 + 0) * 24 + tl] = f2bf(rv.x); sVT[(c4 + 1) * 24 + tl] = f2bf(rv.y); sVT[(c4 + 2) * 24 + tl] = f2bf(rv.z); sVT[(c4 + 3) * 24 + tl] = f2bf(rv.w);
        __syncthreads();
        if (ch + 1 < nch) HC_LOAD(ch + 1);
        {
            const int k = tid & 127, part = tid >> 7; float lf[4], fv[4], cs = 0.f;
#pragma unroll
            for (int i = 0; i < 4; ++i) { fv[i] = sFr[(part * 4 + i) * 128 + k]; lf[i] = __logf(fv[i]); cs += lf[i]; }
            sPart[part * 128 + k] = cs;
            __syncthreads();
            const float p0 = sPart[k], p1 = sPart[128 + k], p2 = sPart[256 + k], p3 = sPart[384 + k];
            float cum = part > 0 ? p0 : 0.f; cum += part > 1 ? p1 : 0.f; cum += part > 2 ? p2 : 0.f;
            const float dec = __expf((p0 + p1) + (p2 + p3)); if (part == 0) sDec[k] = dec;
            float kd[4];
#pragma unroll
            for (int i = 0; i < 4; ++i) { const int t = part * 4 + i; cum += lf[i]; const float e1 = __expf(cum), e2 = __builtin_amdgcn_rcpf(e1), kn = (1.f - fv[i]) * e2;
                sQs[t * 136 + k] = f2bf(sQr[t * 128 + k] * e1); sKn[t * 136 + k] = f2bf(kn); kd[i] = kn * dec; }
            *(u32x2*)(sKeT + k * 24 + part * 4) = (u32x2){pk2(kd[0], kd[1]), pk2(kd[2], kd[3])};
        }
        __syncthreads();
        if (wave == 7) {
            f32x4 pc = {0.f, 0.f, 0.f, 0.f};
#pragma unroll
            for (int m = 0; m < 4; ++m) { const bf16x8 aa = *(const bf16x8*)(sQs + fr * 136 + 32 * m + 8 * fq), bb = *(const bf16x8*)(sKn + fr * 136 + 32 * m + 8 * fq);
                pc = __builtin_amdgcn_mfma_f32_16x16x32_bf16(aa, bb, pc, 0, 0, 0); }
            const float pv[4] = {pc.x, pc.y, pc.z, pc.w};
#pragma unroll
            for (int j = 0; j < 4; ++j) { const int t = fq * 4 + j; sPm[t * 24 + fr] = f2bf(fr <= t ? pv[j] : 0.f); }
        }
        f32x4 O = {0.f, 0.f, 0.f, 0.f};
#pragma unroll
        for (int m = 0; m < 4; ++m) {
            const u32x2 lo = *(const u32x2*)(sQs + fr * 136 + 32 * m + 4 * fq), hi = *(const u32x2*)(sQs + fr * 136 + 32 * m + 16 + 4 * fq);
            const u32x4 aw = {lo.x, lo.y, hi.x, hi.y};
            u32x4 bw; bw.x = pk2(acc[2 * m].x, acc[2 * m].y); bw.y = pk2(acc[2 * m].z, acc[2 * m].w); bw.z = pk2(acc[2 * m + 1].x, acc[2 * m + 1].y); bw.w = pk2(acc[2 * m + 1].z, acc[2 * m + 1].w);
            O = __builtin_amdgcn_mfma_f32_16x16x32_bf16(__builtin_bit_cast(bf16x8, aw), __builtin_bit_cast(bf16x8, bw), O, 0, 0, 0);
        }
        __syncthreads();
        const u32x4 zero4 = {0u, 0u, 0u, 0u};
        const u32x4 bvw = fq < 2 ? *(const u32x4*)(sVT + e * 24 + fq * 8) : zero4; const bf16x8 bV = __builtin_bit_cast(bf16x8, bvw);
        { const u32x4 aw = fq < 2 ? *(const u32x4*)(sPm + fr * 24 + fq * 8) : zero4;
          O = __builtin_amdgcn_mfma_f32_16x16x32_bf16(__builtin_bit_cast(bf16x8, aw), bV, O, 0, 0, 0); }
#pragma unroll
        for (int kt = 0; kt < 8; ++kt) {
            const f32x4 dc = *(const f32x4*)(sDec + kt * 16 + fq * 4);
            acc[kt] = acc[kt] * dc;
            const u32x4 aw = fq < 2 ? *(const u32x4*)(sKeT + (kt * 16 + fr) * 24 + fq * 8) : zero4;
            acc[kt] = __builtin_amdgcn_mfma_f32_16x16x32_bf16(__builtin_bit_cast(bf16x8, aw), bV, acc[kt], 0, 0, 0);
        }
        { const float ov[4] = {O.x, O.y, O.z, O.w};
#pragma unroll
          for (int j = 0; j < 4; ++j) OC[(size_t)HC_TOK(ch, fq * 4 + j) * 512 + h * 128 + e] = f2bf(ov[j]); }
    }
#undef HC_LOAD
#undef HC_TOK
    if (!smp) {
#pragma unroll
        for (int kt = 0; kt < 8; ++kt) { float* dp = a.out + O_SH + ((size_t)((b * 2 + dir) * 4 + h) * 128 + kt * 16 + fq * 4) * 128 + e; dp[0] = acc[kt].x; dp[128] = acc[kt].y; dp[256] = acc[kt].z; dp[384] = acc[kt].w; }
    }
    __syncthreads();
}
__device__ __forceinline__ void scan_phase(const Args& a, unsigned char* lds) {
    const int tid = opq((int)threadIdx.x), lane = tid & 63, wave = __builtin_amdgcn_readfirstlane(tid >> 6);
    unsigned* qc = (unsigned*)(a.ws + WS_QCTR);
    if (gridDim.x != 256) {
        int* sj = (int*)(lds + 65536);
        for (;;) {
            if (tid == 0) *sj = (int)atomicAdd(qc + 1, 1u);
            __syncthreads();
            const int job = *sj;
            __syncthreads();
            if (job >= 160) break;
            if (job < 32) hgrn_chain(a, lds, true, job); else hgrn_chain(a, lds, false, job - 32);
        }
        unsigned char* wl = lds + wave * 16384;
        for (;;) {
            int j = 0;
            if (lane == 0) j = (int)atomicAdd(qc, 1u);
            j = __builtin_amdgcn_readfirstlane(j);
            if (j >= 1536) break;
            if (j < 512) rwkv_wjob<1>(a, wl, true, j, lane); else rwkv_wjob<2>(a, wl, false, j - 512, lane);
        }
        return;
    }
    if (blockIdx.x < 32 || blockIdx.x >= 160) {
#ifdef PROBE_LONG
        const unsigned long long th0_ = wall_clock64();
#endif
        if (blockIdx.x < 32) hgrn_chain(a, lds, true, (int)blockIdx.x);
#ifdef PROBE_LONG
        if (PROBE_LONG == 2 && blockIdx.x == 0 && tid == 0) a.out[0] += (float)(wall_clock64() - th0_) * 1e-4f;
#endif
        int* sj = (int*)(lds + 65536);
        for (;;) {
            if (tid == 0) *sj = (int)atomicAdd(qc + 1, 1u);
            __syncthreads();
            const int job = *sj;
            __syncthreads();
            if (job >= 128) break;
            hgrn_chain(a, lds, false, job);
        }
#ifdef PROBE_LONG
        if (PROBE_LONG == 3 && blockIdx.x == 160 && tid == 0) a.out[0] += (float)(wall_clock64() - th0_) * 1e-4f;
#endif
    } else if (wave < 4) {
#ifdef PROBE_LONG
        const unsigned long long tl0_ = wall_clock64();
#endif
        __builtin_amdgcn_s_setprio(3);
        rwkv_wjob<1>(a, lds + wave * 16384, true, ((int)blockIdx.x - 32) * 4 + wave, lane);
        __builtin_amdgcn_s_setprio(0);
#ifdef PROBE_LONG
        if (PROBE_LONG == 1 && blockIdx.x == 32 && wave == 0 && lane == 0) a.out[0] += (float)(wall_clock64() - tl0_) * 1e-4f;
#endif
    } else return;
    unsigned char* wl = lds + wave * 16384;
    for (;;) {
        int j = 0;
        if (lane == 0) j = (int)atomicAdd(qc, 1u);
        j = __builtin_amdgcn_readfirstlane(j);
        if (j >= 1024) break;
        rwkv_wjob<2>(a, wl, false, j, lane);
    }
}

__device__ __forceinline__ void post1_phase(const Args& a) {
    const int lane = opq((int)threadIdx.x) & 63, wave = opq((int)threadIdx.x) >> 6, gw = blockIdx.x * 8 + wave, NGW = gridDim.x * 8;
    unsigned char* ws = a.ws;
    const bf16* OCF = (const bf16*)(ws + WS_OCF); const bf16* OCB = (const bf16*)(ws + WS_OCB); const bf16* ODF = (const bf16*)(ws + WS_ODF); const bf16* ODB = (const bf16*)(ws + WS_ODB);
    const float* HG = (const float*)(ws + WS_HG); const bf16* R = (const bf16*)(ws + WS_R); const bf16* KT = (const bf16*)(ws + WS_KT); const bf16* V1 = (const bf16*)(ws + WS_V1); const bf16* G = (const bf16*)(ws + WS_G);
    bf16* CAT = (bf16*)(ws + WS_CAT2);
    const int col = lane * 8;
    for (int t = gw; t < NTOK; t += NGW) {
        {
            const u32x4 xa = *(const u32x4*)(OCF + (size_t)t * 512 + col), xb = *(const u32x4*)(OCB + (size_t)t * 512 + col);
            float x[8], ss = 0.f;
#pragma unroll
            for (int k = 0; k < 4; ++k) { x[2 * k] = bflo(xa[k]) + bflo(xb[k]); x[2 * k + 1] = bfhi(xa[k]) + bfhi(xb[k]); }
#pragma unroll
            for (int k = 0; k < 8; ++k) ss += x[k] * x[k];
            ss += __shfl_xor(ss, 1); ss += __shfl_xor(ss, 2); ss += __shfl_xor(ss, 4); ss += __shfl_xor(ss, 8);
            const float rs = rsqrtf(ss * (1.f / 128.f) + 1e-6f);
            const float* gn = a.in[24] + (col & 127); const float* gc = HG + (size_t)t * 2560 + 2048 + col;
            float y[8];
#pragma unroll
            for (int k = 0; k < 8; ++k) y[k] = x[k] * rs * gn[k] * silu(gc[k]);
            u32x4 w; w.x = pk2(y[0], y[1]); w.y = pk2(y[2], y[3]); w.z = pk2(y[4], y[5]); w.w = pk2(y[6], y[7]);
            *(u32x4*)(CAT + (size_t)t * 1024 + col) = w;
        }
        {
            const u32x4 xa = *(const u32x4*)(ODF + (size_t)t * 512 + col), xb = *(const u32x4*)(ODB + (size_t)t * 512 + col);
            const u32x4 rw = *(const u32x4*)(R + (size_t)t * 512 + col), kw = *(const u32x4*)(KT + (size_t)t * 512 + col), vw = *(const u32x4*)(V1 + (size_t)t * 512 + col), gw_ = *(const u32x4*)(G + (size_t)t * 512 + col);
            float x[8], r[8], kt[8], v[8], g[8], sm = 0.f, bs = 0.f;
#pragma unroll
            for (int k = 0; k < 4; ++k) { x[2 * k] = bflo(xa[k]) + bflo(xb[k]); x[2 * k + 1] = bfhi(xa[k]) + bfhi(xb[k]); r[2 * k] = bflo(rw[k]); r[2 * k + 1] = bfhi(rw[k]);
                kt[2 * k] = bflo(kw[k]); kt[2 * k + 1] = bfhi(kw[k]); v[2 * k] = bflo(vw[k]); v[2 * k + 1] = bfhi(vw[k]); g[2 * k] = bflo(gw_[k]); g[2 * k + 1] = bfhi(gw_[k]); }
            const float* rk = a.in[33] + col; const float* lg = a.in[34] + col; const float* lbb = a.in[35] + col;
#pragma unroll
            for (int k = 0; k < 8; ++k) { sm += x[k]; bs += r[k] * kt[k] * rk[k]; }
            sm += __shfl_xor(sm, 1); sm += __shfl_xor(sm, 2); sm += __shfl_xor(sm, 4);
            bs += __shfl_xor(bs, 1); bs += __shfl_xor(bs, 2); bs += __shfl_xor(bs, 4);
            const float mean = sm * (1.f / 64.f); float vs = 0.f;
#pragma unroll
            for (int k = 0; k < 8; ++k) { const float d = x[k] - mean; vs += d * d; }
            vs += __shfl_xor(vs, 1); vs += __shfl_xor(vs, 2); vs += __shfl_xor(vs, 4);
            const float rs = rsqrtf(vs * (1.f / 64.f) + 64e-5f);
            float y[8];
#pragma unroll
            for (int k = 0; k < 8; ++k) y[k] = ((x[k] - mean) * rs * lg[k] + lbb[k] + bs * v[k]) * g[k];
            u32x4 w; w.x = pk2(y[0], y[1]); w.y = pk2(y[2], y[3]); w.z = pk2(y[4], y[5]); w.w = pk2(y[6], y[7]);
            *(u32x4*)(CAT + (size_t)t * 1024 + 512 + col) = w;
        }
    }
}

#define LAS __attribute__((address_space(3)))
#define XB_TMO      128
#define XB_XCNT(j)  (256  + 64 * (j))
#define XB_XSUB(j)  (1280 + 64 * (j))
#define XB_XGEN(j)  (2304 + 64 * (j))
#define XB_TOP      3328
#define XB_TOPGEN   3392
#define XCD_BAR_WORDS 3456
#define XB_SPIN_CAP (1u << 18)

__device__ __forceinline__ unsigned xb_ld(unsigned* p)              { return __hip_atomic_load(p, __ATOMIC_RELAXED, __HIP_MEMORY_SCOPE_AGENT); }
__device__ __forceinline__ unsigned xb_add(unsigned* p, unsigned v) { return __hip_atomic_fetch_add(p, v, __ATOMIC_RELAXED, __HIP_MEMORY_SCOPE_AGENT); }
__device__ __forceinline__ unsigned xb_xcc_id() { return (unsigned)__builtin_amdgcn_s_getreg((3 << 11) | 20) & 0xFu; }
#define XB_SPIN(cond, bar) do { unsigned _sp = 0; while (cond) { __builtin_amdgcn_s_sleep(1); \
    if ((++_sp & 255u) == 0u) { if (xb_ld(&(bar)[XB_TMO])) break; if (_sp > XB_SPIN_CAP) { atomicAdd(&(bar)[XB_TMO], 1u); break; } } } } while (0)

struct XcdBarrier {
    unsigned* bar; unsigned x;
    volatile LAS unsigned* st;
};

__device__ __forceinline__ XcdBarrier xcd_barrier_post(unsigned* bar, volatile LAS unsigned* st) {
    XcdBarrier b; b.bar = bar; b.x = xb_xcc_id(); b.st = st;
    if (threadIdx.x == 0) (void)xb_add(&bar[XB_XCNT(b.x)], 1u);
    return b;
}
__device__ __forceinline__ void xcd_barrier_complete(unsigned* bar, unsigned x, unsigned& nloc, unsigned& nx) {
    const unsigned G = gridDim.x * gridDim.y * gridDim.z;
    unsigned sum, cnt, mine, sp = 0u;
    for (;;) {
        sum = 0u; cnt = 0u; mine = 0u;
#pragma unroll
        for (unsigned j = 0; j < 16; ++j) { const unsigned c = xb_ld(&bar[XB_XCNT(j)]); sum += c; cnt += (c > 0u) ? 1u : 0u; mine = (j == x) ? c : mine; }
        if (sum == G) break;
        __builtin_amdgcn_s_sleep(1);
        if ((++sp & 255u) == 0u) { if (xb_ld(&bar[XB_TMO])) break; if (sp > XB_SPIN_CAP) { atomicAdd(&bar[XB_TMO], 1u); break; } }
    }
    nloc = mine > 0u ? mine : 1u; nx = cnt > 0u ? cnt : 1u;
}

__device__ __forceinline__ void xcd_barrier(const XcdBarrier& b) {
    asm volatile("s_waitcnt vmcnt(0)" ::: "memory");
    __syncthreads();
    if (threadIdx.x == 0) {
        unsigned* bar = b.bar;
        __builtin_amdgcn_s_waitcnt(0);
        unsigned nloc = b.st[0], nx = b.st[1];
        if (nloc == 0u) { xcd_barrier_complete(bar, b.x, nloc, nx); b.st[0] = nloc; b.st[1] = nx; }
        const unsigned old = xb_add(&bar[XB_XSUB(b.x)], 1u);
        const unsigned gen = old / nloc;
        if (old + 1u == (gen + 1u) * nloc) {
            __builtin_amdgcn_fence(__ATOMIC_RELEASE, "agent");
            asm volatile("s_waitcnt vmcnt(0)" ::: "memory");
            const unsigned og = xb_add(&bar[XB_TOP], 1u);
            const unsigned tg = og / nx;
            if (og + 1u == (tg + 1u) * nx) xb_add(&bar[XB_TOPGEN], 1u);
            else XB_SPIN(xb_ld(&bar[XB_TOPGEN]) == tg, bar);
            __builtin_amdgcn_fence(__ATOMIC_ACQUIRE, "agent");
            xb_add(&bar[XB_XGEN(b.x)], 1u);
            asm volatile("s_waitcnt vmcnt(0)" ::: "memory");
        } else {
            XB_SPIN(xb_ld(&bar[XB_XGEN(b.x)]) == gen, bar);
            __builtin_amdgcn_fence(__ATOMIC_ACQUIRE, "agent");
            asm volatile("s_waitcnt vmcnt(0)" ::: "memory");
        }
    }
    __syncthreads();
}

constexpr int LDS_BYTES = 131072 + 256, NPHASE = 21;
constexpr size_t WS_BAR = 512 * 1024;
#ifdef DBG_USE_H
#define DBG_A5 H
#else
#define DBG_A5 (const bf16*)(ws + WS_CAT)
#endif
__global__ void __launch_bounds__(512, 2) trunk_fwd(Args a) {
    extern __shared__ __attribute__((aligned(16))) unsigned char lds[];
    cg::grid_group grid = cg::this_grid();
    unsigned char* ws = a.ws;
    const float* MOD = (const float*)(ws + WS_MOD);
    bf16* H = (bf16*)(ws + WS_H);
    XcdBarrier bar; bar.bar = (unsigned*)(ws + WS_BAR); bar.x = 0; bar.st = nullptr;
    if (a.ph_hi - a.ph_lo > 1) {
        volatile LAS unsigned* st = (volatile LAS unsigned*)((LAS unsigned char*)lds + 131072);
        if (opq((int)threadIdx.x) < 2) st[opq((int)threadIdx.x)] = 0u;
        __syncthreads();
        bar = xcd_barrier_post((unsigned*)(ws + WS_BAR), st);
    }
    if (a.ph_hi == 0x7fffffff) grid.sync();
#define GBAR() xcd_barrier(bar)
#ifdef ONLY_PHASE
#define PH(k) if ((k) == ONLY_PHASE)
#else
#define PH(k) if (a.ph_lo <= (k) && (k) < a.ph_hi)
#endif
#ifdef PROBE_MASK
#ifndef PROBE_SCALE
#define PROBE_SCALE 1e-4f
#endif
    unsigned long long tacc = 0, tprev = wall_clock64();
#define SEAM(k) { if (a.ph_lo <= (k) && (k) + 1 < a.ph_hi) GBAR(); const unsigned long long tn_ = wall_clock64(); if ((PROBE_MASK >> (k)) & 1) tacc += tn_ - tprev; tprev = tn_; }
#else
#define SEAM(k) if (a.ph_lo <= (k) && (k) + 1 < a.ph_hi) GBAR();
#endif
    PH(0) { phase0(a, lds); } SEAM(0)
    PH(1) { norm_phase<0, false>(a, a.in[12], 0, 0, 1024); } SEAM(1)
    PH(2) { EpiF32 E{(float*)(ws + WS_PROJ), 2304}; run_gemm(lds, H, (const bf16*)(ws + WS_EVIN), 9, 1024, 1024, 9, E);
            if (blockIdx.x >= 32) {
                const int w_ = ((int)blockIdx.x - 32) * 8 + (opq((int)threadIdx.x) >> 6), nw_ = ((int)gridDim.x - 32) * 8;
                tr_range(a, lds, 10112, 12832, w_, nw_); fill_l1_small(a, ((int)blockIdx.x - 32) * 512 + opq((int)threadIdx.x), ((int)gridDim.x - 32) * 512); } } SEAM(2)
    PH(3) { qkv_post(a, lds); } SEAM(3)
    PH(4) { attn_phase(a, lds); } SEAM(4)
#ifdef DBG_COPY_CAT
    PH(5) { const bf16* C_ = (const bf16*)(ws + WS_CAT); for (int i = blockIdx.x * 512 + opq((int)threadIdx.x); i < NTOK * 1024; i += gridDim.x * 512) {
#if DBG_COPY_CAT == 2
        const int t_ = i >> 10, c_ = i & 1023; a.out[i] = bf2f(c_ < 512 ? ((const bf16*)(ws + WS_QB))[t_ * 512 + c_] : ((const bf16*)(ws + WS_KBS))[(size_t)t_ * 96 + (c_ - 512) % 96]);
#elif DBG_COPY_CAT == 3
        const int t_ = i >> 10, c_ = i & 1023; a.out[i] = bf2f(c_ < 512 ? ((const bf16*)(ws + WS_VBTS))[t_ * 96 + c_ % 96] : ((const bf16*)(ws + WS_KBC))[(size_t)t_ * 64 + (c_ - 512) % 64]) + bf2f(((const bf16*)(ws + WS_VBTC))[(size_t)t_ * 64 + c_ % 64]);
#else
        a.out[i] = bf2f(C_[i]);
#endif
    } } SEAM(5)
#else
    PH(5) { EpiResid E{a.out, MOD + 2048,(float*)(ws + WS_TMP), a.in[0], a.in[1]}; run_gemm(lds, DBG_A5, (const bf16*)(ws + WS_EVOUT), 4, 1024, 1024, 4, E);
            if (blockIdx.x >= 128) {
                const int w_ = ((int)blockIdx.x - 128) * 8 + (opq((int)threadIdx.x) >> 6), nw_ = ((int)gridDim.x - 128) * 8;
                tr_range(a, lds, 1664, 4480, w_, nw_); tr_range(a, lds, 7296, 8704, w_, nw_); } } SEAM(5)
#endif
    PH(6) { norm_phase<1, false>(a, a.in[13], 0, 3072, 4096); } SEAM(6)
    PH(7) { EpiBf16 E{(bf16*)(ws + WS_U), 5632}; run_gemm(lds, H, (const bf16*)(ws + WS_UP0), 22, 1024, 1024, 22, E); } SEAM(7)
    PH(8) { conv_phase(a, 0); } SEAM(8)
    PH(9) { EpiResid E{a.out, MOD + 5120,(float*)(ws + WS_TMP), a.out, a.out + (size_t)NCTX * DM}; run_gemm(lds, (const bf16*)(ws + WS_ACT), (const bf16*)(ws + WS_DOWN0), 8, 1408, 2816, 4, E); } SEAM(9)
    PH(10) { norm_phase<1, true>(a, a.in[12] + 1024, 1, 0, 1024); } SEAM(10)
    PH(11) { EpiOdIn E{(float*)(ws + WS_HG), (bf16*)(ws + WS_PR), (const float*)(ws + WS_LB)}; run_gemm(lds, H, (const bf16*)(ws + WS_ODIN), 18, 1024, 1024, 18, E);
            if (blockIdx.x >= 64) {
                const int w_ = ((int)blockIdx.x - 64) * 8 + (opq((int)threadIdx.x) >> 6), nw_ = ((int)gridDim.x - 64) * 8;
                tr_range(a, lds, 4480, 7296, w_, nw_); tr_range(a, lds, 8704, 10112, w_, nw_); } } SEAM(11)
    PH(12) { prep1_phase(a); } SEAM(12)
    PH(13) { EpiLora E{(float*)(ws + WS_WF), (float*)(ws + WS_WB), (const bf16*)(ws + WS_KK), (const bf16*)(ws + WS_K1), (bf16*)(ws + WS_KKA), (bf16*)(ws + WS_KT), (bf16*)(ws + WS_G), a.in[26], a.in[28], a.in[32]};
             run_gemm(lds, (const bf16*)(ws + WS_AP), (const bf16*)(ws + WS_LORA), 8, 384, 384, 8, E); } SEAM(13)
    PH(14) { scan_phase(a, lds); } SEAM(14)
    PH(15) { post1_phase(a); } SEAM(15)
    PH(16) { EpiResid E{a.out, MOD + 5 * 6144 + 2048,(float*)(ws + WS_TMP), a.out, a.out + (size_t)NCTX * DM}; run_gemm(lds, (const bf16*)(ws + WS_CAT2), (const bf16*)(ws + WS_ODOUT), 4, 1024, 1024, 4, E); } SEAM(16)
    PH(17) { norm_phase<1, false>(a, a.in[13] + 1024, 1, 3072, 4096); } SEAM(17)
    PH(18) { EpiBf16 E{(bf16*)(ws + WS_U), 5632}; run_gemm(lds, H, (const bf16*)(ws + WS_UP1), 22, 1024, 1024, 22, E); } SEAM(18)
    PH(19) { conv_phase(a, 1); } SEAM(19)
    PH(20) { EpiResid E{a.out, MOD + 5 * 6144 + 5120,(float*)(ws + WS_TMP), a.out, a.out + (size_t)NCTX * DM}; run_gemm(lds, (const bf16*)(ws + WS_ACT), (const bf16*)(ws + WS_DOWN1), 8, 1408, 2816, 4, E); } SEAM(20)
    PH(21) { norm_phase<2, true>(a, a.in[14], 0, 0, 0); }
#ifdef PROBE_MASK
    { unsigned long long tn_ = wall_clock64(); if ((PROBE_MASK >> 21) & 1) tacc += tn_ - tprev;
#ifdef PROBE_SYNCS
      for (int i_ = 0; i_ < 20; ++i_) GBAR();
      tacc = wall_clock64() - tn_;
#endif
#ifdef PROBE_LONG
      __syncthreads(); if (blockIdx.x == PROBE_LONG / 4 && opq((int)threadIdx.x) == 0) a.out[0] += (float)(*(unsigned*)(lds + 131072 + 64)) * PROBE_SCALE;
#else
      if (blockIdx.x == 0 && opq((int)threadIdx.x) == 0) a.out[0] += (float)tacc * PROBE_SCALE;
#endif
    }
#endif
#undef PH
#undef SEAM
}

extern "C" void kernel_launch(void* const* d_in, const int* in_sizes, int n_in, void* d_out, int out_size, void* d_ws, size_t ws_size, hipStream_t stream) {
    static int grid = 0;
    if (grid == 0) {
        int dev = 0, cus = 0, per_cu = 0;
        if (n_in != 40 || out_size != 16777216 || ws_size < 256 * MiB) { fprintf(stderr, "kernel_launch: unexpected shapes n_in %d out %d ws %zu\n", n_in, out_size, ws_size); grid = -1; return; }
        (void)hipGetDevice(&dev); (void)hipDeviceGetAttribute(&cus, hipDeviceAttributeMultiprocessorCount, dev);
        if (hipFuncSetAttribute((const void*)trunk_fwd, hipFuncAttributeMaxDynamicSharedMemorySize, LDS_BYTES) != hipSuccess) { fprintf(stderr, "kernel_launch: hipFuncSetAttribute failed\n"); grid = -1; return; }
        if (hipOccupancyMaxActiveBlocksPerMultiprocessor(&per_cu, (const void*)trunk_fwd, 512, LDS_BYTES) != hipSuccess || per_cu < 1) { fprintf(stderr, "kernel_launch: occupancy query says %d\n", per_cu); per_cu = 1; }
        (void)hipGetLastError();
        grid = cus * (per_cu > 1 ? 1 : per_cu);
        if (grid <= 0) grid = 256;
    }
    if (grid < 0) return;
    Args a{};
    for (int i = 0; i < 40; ++i) a.in[i] = (const float*)d_in[i];
    a.out = (float*)d_out; a.ws = (unsigned char*)d_ws;
#if MK_N_LAUNCHES == 1
    if (hipMemsetAsync((unsigned char*)d_ws + WS_BAR, 0, XCD_BAR_WORDS * sizeof(unsigned), stream) != hipSuccess) { fprintf(stderr, "kernel_launch: memset of the barrier words failed\n"); return; }
    a.ph_lo = 0; a.ph_hi = NPHASE + 1;
    void* args[] = {&a};
    hipError_t e = hipLaunchCooperativeKernel((const void*)trunk_fwd, dim3(grid), dim3(512), args, LDS_BYTES, stream);
    if (e != hipSuccess) fprintf(stderr, "kernel_launch: cooperative launch failed: %s (grid %d)\n", hipGetErrorString(e), grid);
#else
#ifndef RUN_UPTO
#define RUN_UPTO NPHASE
#endif
    for (int p = 0; p <= RUN_UPTO; ++p) { a.ph_lo = p; a.ph_hi = p + 1; hipLaunchKernelGGL(trunk_fwd, dim3(grid), dim3(512), LDS_BYTES, stream, a); }
#endif
}
```
